# Optimizing an MI355X kernel written in HIP

```python
import math
import jax, jax.numpy as jnp
from jax import lax
import numpy as np

D_MODEL = 2048
BATCH = 4
SEQ = 4096
DEPTH = 2

GRID_W = 64
CTX_LEN = 256
CONV_W = 4

ATT_HEADS = 8
ATT_QK_DIM = 64
ATT_V_DIM = 128
ATT_WIDTH = ATT_HEADS * ATT_V_DIM
Q_BLOCK = 128
ROPE_THETA = 10000.0

SSD_HEADS = 16
SSD_HEAD_DIM = 64
SSD_WIDTH = SSD_HEADS * SSD_HEAD_DIM
SSD_GROUPS = 4
SSD_STATE = 128
SSD_CHUNK = 128
SSD_XBC = SSD_WIDTH + 2 * SSD_GROUPS * SSD_STATE

LRU_WIDTH = 1024
LRU_BLOCKS = 8
LRU_BLOCK_DIM = LRU_WIDTH // LRU_BLOCKS
LRU_C = 8.0

N_BRANCHES = 3
BRANCH_WIDTH = 1024

N_EXPERTS = 16
N_EXPERT_GROUPS = 4
EXPERTS_PER_GROUP = N_EXPERTS // N_EXPERT_GROUPS
TOP_K = 2
D_EXPERT = 1408

DN_ALPHA = (2 * DEPTH) ** 0.25
DN_BETA = (8 * DEPTH) ** -0.25
LN_EPS = 1e-6

IN_SPLITS = (LRU_WIDTH, LRU_WIDTH, SSD_WIDTH, SSD_XBC, 2 * SSD_HEADS,
             ATT_HEADS * 2 * ATT_QK_DIM, ATT_HEADS * 2 * ATT_QK_DIM, ATT_WIDTH,
             N_BRANCHES * D_MODEL)
D_IN = sum(IN_SPLITS)

kernel_name = "hybrid_lru_ssd_diffattn_moe_dit_block"


def _layernorm(x, g=None, b=None):
    xf = x.astype(jnp.float32)
    mu = jnp.mean(xf, axis=-1, keepdims=True)
    var = jnp.mean(jnp.square(xf - mu), axis=-1, keepdims=True)
    y = (xf - mu) * lax.rsqrt(var + LN_EPS)
    if g is not None:
        y = y * g.astype(jnp.float32) + b.astype(jnp.float32)
    return y.astype(x.dtype)


def _rmsnorm(x, w):
    xf = x.astype(jnp.float32)
    y = xf * lax.rsqrt(jnp.mean(xf * xf, axis=-1, keepdims=True) + LN_EPS)
    return (y * w.astype(jnp.float32)).astype(x.dtype)


def _split_cols(p):
    idx = [int(i) for i in np.cumsum(IN_SPLITS)[:-1]]
    return jnp.split(p, idx, axis=-1)


def _dwconv(x, w, b):
    y = lax.conv_general_dilated(
        x, w[:, None, :].astype(x.dtype), window_strides=(1,),
        padding=[(CONV_W // 2, CONV_W - 1 - CONV_W // 2)],
        dimension_numbers=('NWC', 'WIO', 'NWC'), feature_group_count=x.shape[-1])
    return y + b.astype(x.dtype)


def _axial_rope_tables(rows):
    row = jnp.repeat(jnp.arange(rows, dtype=jnp.float32), GRID_W)
    col = jnp.tile(jnp.arange(GRID_W, dtype=jnp.float32), rows)
    axis_dim = ATT_QK_DIM // 2
    freqs = ROPE_THETA ** (-jnp.arange(0, axis_dim, 2, dtype=jnp.float32) / axis_dim)
    ang = jnp.stack([row[:, None] * freqs, col[:, None] * freqs], axis=1)
    return jnp.cos(ang), jnp.sin(ang)


def _apply_axial_rope(x, cos, sin):
    xa = x.reshape(x.shape[:-1] + (2, ATT_QK_DIM // 2))
    half = ATT_QK_DIM // 4
    x1, x2 = xa[..., :half], xa[..., half:]
    c = cos[None, :, None, None].astype(x.dtype)
    s = sin[None, :, None, None].astype(x.dtype)
    out = jnp.concatenate([x1 * c - x2 * s, x1 * s + x2 * c], axis=-1)
    return out.reshape(x.shape)


def _linear_combine(left, right):
    a_l, b_l = left
    a_r, b_r = right
    return a_l * a_r, a_r * b_l + b_r


def _rglru_scan(x, w_rg, b_rg, lam, h0, reverse):
    Bsz, L, W = x.shape
    xb = x.reshape(Bsz, L, LRU_BLOCKS, LRU_BLOCK_DIM)
    gl = jnp.einsum('blnc,gncd->gblnd', xb, w_rg.astype(x.dtype)).reshape(2, Bsz, L, W)
    gl = gl.astype(jnp.float32) + b_rg.astype(jnp.float32)[:, None, None, :]
    r_gate = jax.nn.sigmoid(gl[0])
    i_gate = jax.nn.sigmoid(gl[1])
    log_a = -LRU_C * r_gate * jax.nn.softplus(-lam.astype(jnp.float32))
    a = jnp.exp(log_a)
    b = jnp.sqrt(-jnp.expm1(2.0 * log_a)) * (i_gate * x.astype(jnp.float32))
    if reverse:
        a, b = jnp.flip(a, 1), jnp.flip(b, 1)
    if h0 is not None:
        b = b.at[:, 0].add(a[:, 0] * h0)
    _, h = lax.associative_scan(_linear_combine, (a, b), axis=1)
    h_last = h[:, -1]
    if reverse:
        h = jnp.flip(h, 1)
    return h.astype(x.dtype), h_last


def _rglru_branch(x_c, g_c, x_l, g_l, conv_w, conv_b, gate_w, gate_b, lam, need_ctx):
    xc = _dwconv(x_c, conv_w, conv_b)
    xl = _dwconv(x_l, conv_w, conv_b)
    y_c = jnp.zeros_like(xc)
    y_l = jnp.zeros_like(xl)
    for d in range(2):
        rev = d == 1
        h_c, s_c = _rglru_scan(xc, gate_w[d], gate_b[d], lam[d], None, rev)
        h_l, _ = _rglru_scan(xl, gate_w[d], gate_b[d], lam[d], s_c, rev)
        y_c = y_c + h_c
        y_l = y_l + h_l
    out_l = y_l * jax.nn.gelu(g_l)
    out_c = y_c * jax.nn.gelu(g_c) if need_ctx else None
    return out_c, out_l


def _segsum(a):
    cs = jnp.cumsum(a, axis=-1)
    diff = cs[..., :, None] - cs[..., None, :]
    T = a.shape[-1]
    mask = jnp.tril(jnp.ones((T, T), dtype=bool))
    return jnp.where(mask, diff, -jnp.inf)


def _ssd_scan(x, dt, A, Bm, Cm, h0):
    Bsz, L, H, P = x.shape
    G, N = Bm.shape[2], Bm.shape[3]
    R = H // G
    T = SSD_CHUNK
    nc = L // T
    x = x.reshape(Bsz, nc, T, G, R, P)
    dt = dt.reshape(Bsz, nc, T, G, R)
    Bm = Bm.reshape(Bsz, nc, T, G, N)
    Cm = Cm.reshape(Bsz, nc, T, G, N)
    xdt = x * dt[..., None]
    a = jnp.transpose(dt * A.reshape(G, R), (0, 3, 4, 1, 2))
    a_cs = jnp.cumsum(a, axis=-1)
    cb = jnp.einsum('bclgn,bcsgn->bgcls', Cm, Bm)
    w_diag = cb[:, :, None] * jnp.exp(_segsum(a))
    y_diag = jnp.einsum('bgrcls,bcsgrp->bclgrp', w_diag, xdt)
    decay_states = jnp.exp(a_cs[..., -1:] - a_cs)
    states = jnp.einsum('bcsgn,bgrcs,bcsgrp->bcgrpn', Bm, decay_states, xdt)
    states = jnp.concatenate([h0.reshape(Bsz, 1, G, R, P, N), states], axis=1)
    chunk_tot = jnp.pad(a_cs[..., -1], ((0, 0), (0, 0), (0, 0), (1, 0)))
    decay_chunk = jnp.exp(_segsum(chunk_tot))
    states = jnp.einsum('bgrzc,bcgrpn->bzgrpn', decay_chunk, states)
    prev_states, final = states[:, :-1], states[:, -1]
    y_off = jnp.einsum('bclgn,bcgrpn,bgrcl->bclgrp', Cm, prev_states, jnp.exp(a_cs))
    y = (y_diag + y_off).reshape(Bsz, L, H, P)
    return y, final.reshape(Bsz, H, P, N)


def _ssd_direction(xs, dt, A, Bm, Cm, h0, reverse):
    if reverse:
        xs, dt, Bm, Cm = jnp.flip(xs, 1), jnp.flip(dt, 1), jnp.flip(Bm, 1), jnp.flip(Cm, 1)
    y, h_last = _ssd_scan(xs, dt, A, Bm, Cm, h0)
    if reverse:
        y = jnp.flip(y, 1)
    return y, h_last


def _ssd_branch(z_c, xbc_c, dt_c, z_l, xbc_l, dt_l, conv_w, conv_b, a_log, dt_bias, d_skip,
                norm_w, need_ctx):
    def prep(xbc, dt_raw):
        xbc = jax.nn.silu(_dwconv(xbc, conv_w, conv_b)).astype(jnp.float32)
        xs, Bm, Cm = jnp.split(xbc, [SSD_WIDTH, SSD_WIDTH + SSD_GROUPS * SSD_STATE], axis=-1)
        Bsz, L = xs.shape[:2]
        xs = xs.reshape(Bsz, L, SSD_HEADS, SSD_HEAD_DIM)
        Bm = Bm.reshape(Bsz, L, SSD_GROUPS, SSD_STATE)
        Cm = Cm.reshape(Bsz, L, SSD_GROUPS, SSD_STATE)
        dt = jax.nn.softplus(dt_raw.astype(jnp.float32).reshape(Bsz, L, 2, SSD_HEADS)
                             + dt_bias.astype(jnp.float32))
        return xs, Bm, Cm, dt
    xs_c, B_c, C_c, dtd_c = prep(xbc_c, dt_c)
    xs_l, B_l, C_l, dtd_l = prep(xbc_l, dt_l)
    dsk = d_skip.astype(jnp.float32)[:, None]
    y_c = dsk * xs_c
    y_l = dsk * xs_l
    h0 = jnp.zeros((xs_c.shape[0], SSD_HEADS, SSD_HEAD_DIM, SSD_STATE), jnp.float32)
    for d in range(2):
        rev = d == 1
        A = -jnp.exp(a_log[d].astype(jnp.float32))
        yc, s_c = _ssd_direction(xs_c, dtd_c[:, :, d], A, B_c, C_c, h0, rev)
        yl, _ = _ssd_direction(xs_l, dtd_l[:, :, d], A, B_l, C_l, s_c, rev)
        y_c = y_c + yc
        y_l = y_l + yl

    def gate_out(y, z):
        y = y.reshape(y.shape[:2] + (SSD_WIDTH,)).astype(z.dtype)
        return _rmsnorm(y * jax.nn.silu(z), norm_w)
    out_l = gate_out(y_l, z_l)
    out_c = gate_out(y_c, z_c) if need_ctx else None
    return out_c, out_l


def _diff_attn_branch(q_c, k_c, v_c, q_l, k_l, v_l, rope_cos, rope_sin, lam_vecs, lam_init,
                      norm_w, need_ctx):
    def heads_qk(t):
        return t.reshape(t.shape[:2] + (ATT_HEADS, 2, ATT_QK_DIM))

    def heads_v(t):
        return t.reshape(t.shape[:2] + (ATT_HEADS, ATT_V_DIM))
    q_c, k_c, v_c = heads_qk(q_c), heads_qk(k_c), heads_v(v_c)
    q_l = _apply_axial_rope(heads_qk(q_l), rope_cos, rope_sin)
    k_l = _apply_axial_rope(heads_qk(k_l), rope_cos, rope_sin)
    v_l = heads_v(v_l)
    lv = lam_vecs.astype(jnp.float32)
    lam = jnp.exp(jnp.sum(lv[0] * lv[1])) - jnp.exp(jnp.sum(lv[2] * lv[3])) + lam_init
    k_all = jnp.concatenate([k_c, k_l], axis=1)
    v_all = jnp.concatenate([v_c, v_l], axis=1)
    scale = ATT_QK_DIM ** -0.5

    def attend(q, k, v):
        s = jnp.einsum('bqhmd,bkhmd->bhmqk', q, k, preferred_element_type=jnp.float32) * scale
        p = jax.nn.softmax(s, axis=-1)
        w = (p[:, :, 0] - lam * p[:, :, 1]).astype(v.dtype)
        return jnp.einsum('bhqk,bkhd->bqhd', w, v)

    def finish(o):
        o = _rmsnorm(o, norm_w) * (1.0 - lam_init)
        return o.reshape(o.shape[:2] + (ATT_WIDTH,))
    Bsz, S = q_l.shape[:2]
    n_blocks = S // Q_BLOCK
    q_blocks = jnp.moveaxis(q_l.reshape(Bsz, n_blocks, Q_BLOCK, ATT_HEADS, 2, ATT_QK_DIM), 1, 0)
    o_l = lax.map(lambda qb: attend(qb, k_all, v_all), q_blocks)
    o_l = jnp.moveaxis(o_l, 0, 1).reshape(Bsz, S, ATT_HEADS, ATT_V_DIM)
    out_c = finish(attend(q_c, k_c, v_c)) if need_ctx else None
    return out_c, finish(o_l)


def _mixer_sublayer(h_c, h_l, rope_cos, rope_sin, lam_init, need_ctx, w_in, lru_conv_w,
                    lru_conv_b, lru_gate_w, lru_gate_b, lru_lambda, ssd_conv_w, ssd_conv_b,
                    ssd_a_log, ssd_dt_bias, ssd_d, ssd_norm_w, att_lambda, att_norm_w,
                    w_branch, w_out):
    pc = _split_cols(h_c @ w_in)
    pl = _split_cols(h_l @ w_in)
    lru_c, lru_l = _rglru_branch(pc[0], pc[1], pl[0], pl[1], lru_conv_w, lru_conv_b,
                                 lru_gate_w, lru_gate_b, lru_lambda, need_ctx)
    ssd_c, ssd_l = _ssd_branch(pc[2], pc[3], pc[4], pl[2], pl[3], pl[4], ssd_conv_w, ssd_conv_b,
                               ssd_a_log, ssd_dt_bias, ssd_d, ssd_norm_w, need_ctx)
    att_c, att_l = _diff_attn_branch(pc[5], pc[6], pc[7], pl[5], pl[6], pl[7], rope_cos,
                                     rope_sin, att_lambda, lam_init, att_norm_w, need_ctx)

    def merge(branches, gate_cols):
        g = jax.nn.sigmoid(gate_cols.astype(jnp.float32)).astype(gate_cols.dtype)
        g = g.reshape(g.shape[:-1] + (N_BRANCHES, D_MODEL))
        m = g[..., 0, :] * (branches[0] @ w_branch[0])
        for k in range(1, N_BRANCHES):
            m = m + g[..., k, :] * (branches[k] @ w_branch[k])
        return m @ w_out
    out_l = merge([lru_l, ssd_l, att_l], pl[8])
    out_c = merge([lru_c, ssd_c, att_c], pc[8]) if need_ctx else None
    return out_c, out_l


def _moe(h, w_router, router_bias, w_gate, w_up, w_down):
    T = h.shape[0]
    scores = jax.nn.softmax((h @ w_router).astype(jnp.float32), axis=-1)
    sel = (scores + router_bias.astype(jnp.float32)).reshape(T, N_EXPERT_GROUPS, EXPERTS_PER_GROUP)
    group_score = lax.top_k(sel, TOP_K)[0].sum(-1)
    g_idx = jnp.argmax(group_score, axis=-1)
    in_group = jnp.take_along_axis(sel, g_idx[:, None, None], axis=1)[:, 0]
    _, local = lax.top_k(in_group, TOP_K)
    e_idx = g_idx[:, None] * EXPERTS_PER_GROUP + local
    w = jnp.take_along_axis(scores, e_idx, axis=1)
    w = w / jnp.sum(w, axis=-1, keepdims=True)
    combine = jnp.sum(jax.nn.one_hot(e_idx, N_EXPERTS, dtype=jnp.float32) * w[..., None],
                      axis=1).astype(h.dtype)
    out = jnp.zeros_like(h)
    for e in range(N_EXPERTS):
        act = jax.nn.silu(h @ w_gate[e]) * (h @ w_up[e])
        out = out + combine[:, e:e + 1] * (act @ w_down[e])
    return out


def setup_inputs(seed: int = 0) -> dict:
    key = jax.random.key(seed)
    ks = jax.random.split(key, 32)
    f32 = jnp.float32
    D = D_MODEL

    def nrm(k, shape, scale):
        return jax.random.normal(k, shape, f32) * scale
    a0 = jax.random.uniform(ks[11], (DEPTH, 2, LRU_WIDTH), f32, 0.9, 0.999)
    a_root = a0 ** (1.0 / LRU_C)
    dt0 = jnp.exp(jax.random.uniform(ks[15], (DEPTH, 2, SSD_HEADS), f32,
                                     math.log(1e-3), math.log(1e-1)))
    return {
        "x": nrm(ks[0], (BATCH, SEQ, D), 1.0),
        "c": nrm(ks[1], (BATCH, D), 1.0),
        "ctx": nrm(ks[2], (BATCH, CTX_LEN, D), 1.0),
        "c_ctx": nrm(ks[3], (D,), 1.0),
        "w_ada": nrm(ks[4], (DEPTH, D, 6 * D), 0.5 * D ** -0.5),
        "b_ada": nrm(ks[5], (DEPTH, 6 * D), 0.02),
        "w_in": nrm(ks[6], (DEPTH, D, D_IN), D ** -0.5),
        "lru_conv_w": nrm(ks[7], (DEPTH, CONV_W, LRU_WIDTH), CONV_W ** -0.5),
        "lru_conv_b": nrm(ks[8], (DEPTH, LRU_WIDTH), 0.01),
        "lru_gate_w": nrm(ks[9], (DEPTH, 2, 2, LRU_BLOCKS, LRU_BLOCK_DIM, LRU_BLOCK_DIM),
                          LRU_BLOCK_DIM ** -0.5),
        "lru_gate_b": nrm(ks[10], (DEPTH, 2, 2, LRU_WIDTH), 0.01),
        "lru_lambda": jnp.log(a_root) - jnp.log1p(-a_root),
        "ssd_conv_w": nrm(ks[12], (DEPTH, CONV_W, SSD_XBC), CONV_W ** -0.5),
        "ssd_conv_b": nrm(ks[13], (DEPTH, SSD_XBC), 0.01),
        "ssd_a_log": jnp.log(jax.random.uniform(ks[14], (DEPTH, 2, SSD_HEADS), f32, 1.0, 16.0)),
        "ssd_dt_bias": dt0 + jnp.log(-jnp.expm1(-dt0)),
        "ssd_d": 1.0 + nrm(ks[16], (DEPTH, SSD_HEADS), 0.1),
        "ssd_norm_w": 1.0 + nrm(ks[17], (DEPTH, SSD_WIDTH), 0.01),
        "att_lambda": nrm(ks[18], (DEPTH, 4, ATT_QK_DIM), 0.1),
        "att_norm_w": 1.0 + nrm(ks[19], (DEPTH, ATT_V_DIM), 0.01),
        "w_branch": nrm(ks[20], (DEPTH, N_BRANCHES, BRANCH_WIDTH, D), BRANCH_WIDTH ** -0.5),
        "w_out": nrm(ks[21], (DEPTH, D, D), DN_BETA * D ** -0.5),
        "ln_g": 1.0 + nrm(ks[22], (DEPTH, 2, D), 0.01),
        "ln_b": nrm(ks[23], (DEPTH, 2, D), 0.01),
        "w_router": nrm(ks[24], (D, N_EXPERTS), D ** -0.5),
        "router_bias": nrm(ks[25], (N_EXPERTS,), 0.01),
        "w_gate_e": nrm(ks[26], (DEPTH, N_EXPERTS, D, D_EXPERT), D ** -0.5),
        "w_up_e": nrm(ks[27], (DEPTH, N_EXPERTS, D, D_EXPERT), D ** -0.5),
        "w_down_e": nrm(ks[28], (DEPTH, N_EXPERTS, D_EXPERT, D), DN_BETA * D_EXPERT ** -0.5),
    }


def reference(x, c, ctx, c_ctx, w_ada, b_ada, w_in, lru_conv_w, lru_conv_b, lru_gate_w,
              lru_gate_b, lru_lambda, ssd_conv_w, ssd_conv_b, ssd_a_log, ssd_dt_bias, ssd_d,
              ssd_norm_w, att_lambda, att_norm_w, w_branch, w_out, ln_g, ln_b, w_router,
              router_bias, w_gate_e, w_up_e, w_down_e):
    S = x.shape[1]
    rows = S // GRID_W
    rope_cos, rope_sin = _axial_rope_tables(rows)
    xc = ctx
    for l in range(DEPTH):
        need_ctx = l < DEPTH - 1
        lam_init = 0.8 - 0.6 * math.exp(-0.3 * l)
        mod_l = jnp.split(jax.nn.silu(c) @ w_ada[l] + b_ada[l], 6, axis=-1)
        mod_c = jnp.split(jax.nn.silu(c_ctx) @ w_ada[l] + b_ada[l], 6, axis=-1)
        sh1, sc1, g1, sh2, sc2, g2 = [m[:, None, :] for m in mod_l]
        csh1, csc1, cg1, csh2, csc2, cg2 = mod_c
        h_l = _layernorm(x) * (1.0 + sc1) + sh1
        h_c = _layernorm(xc) * (1.0 + csc1) + csh1
        m_c, m_l = _mixer_sublayer(h_c, h_l, rope_cos, rope_sin, lam_init, need_ctx, w_in[l],
                                   lru_conv_w[l], lru_conv_b[l], lru_gate_w[l], lru_gate_b[l],
                                   lru_lambda[l], ssd_conv_w[l], ssd_conv_b[l], ssd_a_log[l],
                                   ssd_dt_bias[l], ssd_d[l], ssd_norm_w[l], att_lambda[l],
                                   att_norm_w[l], w_branch[l], w_out[l])
        x = _layernorm(DN_ALPHA * x + g1 * m_l, ln_g[l, 0], ln_b[l, 0])
        h_l = _layernorm(x) * (1.0 + sc2) + sh2
        if need_ctx:
            xc = _layernorm(DN_ALPHA * xc + cg1 * m_c, ln_g[l, 0], ln_b[l, 0])
            h_c = _layernorm(xc) * (1.0 + csc2) + csh2
            n_ctx_tok = xc.shape[0] * xc.shape[1]
            tokens = jnp.concatenate([h_c.reshape(-1, D_MODEL), h_l.reshape(-1, D_MODEL)], axis=0)
        else:
            n_ctx_tok = 0
            tokens = h_l.reshape(-1, D_MODEL)
        f = _moe(tokens, w_router, router_bias, w_gate_e[l], w_up_e[l], w_down_e[l])
        x = _layernorm(DN_ALPHA * x + g2 * f[n_ctx_tok:].reshape(x.shape), ln_g[l, 1], ln_b[l, 1])
        if need_ctx:
            xc = _layernorm(DN_ALPHA * xc + cg2 * f[:n_ctx_tok].reshape(xc.shape),
                            ln_g[l, 1], ln_b[l, 1])
    return x
```

```cpp
#include <hip/hip_runtime.h>
#include <cstdio>
#include <cstdint>

#define GAS __attribute__((address_space(1)))
#define LAS __attribute__((address_space(3)))
typedef unsigned short bf16;
typedef unsigned v4u __attribute__((ext_vector_type(4)));
typedef unsigned v2u __attribute__((ext_vector_type(2)));
typedef float f32x4 __attribute__((ext_vector_type(4)));
typedef float f32x2 __attribute__((ext_vector_type(2)));
typedef short bf16x8 __attribute__((ext_vector_type(8)));
typedef GAS unsigned gu32;

#ifndef MK_N_LAUNCHES
#define MK_N_LAUNCHES 1
#endif

constexpr int NB = 4, LC = 256, LL = 4096, LT = LC + LL, M = NB * LT;
constexpr int D = 2048, NADA = 6 * D, DEPTH = 2;
constexpr int DIN = 14368, NP = 14592;
constexpr int P_LRUX = 0, P_LRUG = 1024, P_Z = 2048, P_XBC = 3072, P_Q = 5120, P_K = 6144, P_V = 7168, P_G = 8192, P_DT = 14336;
constexpr int NE = 16, DE = 1408, MOE_ROWS = 39168, MOE_TILES = MOE_ROWS / 128;
constexpr float LN_EPS = 1e-6f;
constexpr float DN_ALPHA = 1.4142135623730951f;
constexpr float QSCALE = 0.125f * 1.4426950408889634f;
constexpr float WSC_GU = 64.f, WSC_D = 128.f;
constexpr int DEP = 1536;
constexpr int NCH = 136;

constexpr size_t MiB = 1u << 20;
constexpr size_t WS_CTL = 0, CTL_ZERO_BYTES = 1 * MiB;
constexpr size_t WS_MODP = 1 * MiB, WS_MOD = 9 * MiB, WS_ROUTE = 10 * MiB, WS_XSCTX = 11 * MiB;
constexpr size_t WS_WIN = 19 * MiB, WS_WBR = 76 * MiB, WS_WOUT = 88 * MiB, WS_WG = 96 * MiB;
constexpr size_t WS_P = 98 * MiB;
constexpr size_t WS_XG = WS_P, WS_ACT = WS_P + 153 * MiB, WS_FS = WS_P + 259 * MiB;
constexpr size_t WS_H = 583 * MiB, WS_BR = 651 * MiB, WS_T = 753 * MiB;
constexpr size_t T_XC = WS_T, T_XBC = WS_T + 34 * MiB, T_DT = WS_T + 102 * MiB, T_QR = WS_T + 105 * MiB, T_KR = WS_T + 139 * MiB;
constexpr size_t T_LA = WS_T + 173 * MiB, T_BB = WS_T + 241 * MiB, T_AGGA = WS_T + 309 * MiB, T_AGGB = WS_T + 314 * MiB, T_CIN = WS_T + 319 * MiB;
constexpr size_t T_SSDY = WS_T + 324 * MiB, T_OTMP = WS_T + 392 * MiB;
constexpr size_t T_MACC = WS_T, T_MB = WS_T + 136 * MiB;
constexpr size_t WS_EGU = WS_T + 468 * MiB, WS_ED = WS_EGU + 176 * MiB;
constexpr size_t WS_END = WS_ED + 88 * MiB;
static_assert(WS_WIN + (size_t)NP * D * 2 <= WS_WBR && WS_WBR + (size_t)3 * D * 1024 * 2 <= WS_WOUT && WS_WOUT + (size_t)D * D * 2 <= WS_WG && WS_WG + (size_t)4096 * 256 * 2 <= WS_P, "A-set map");
static_assert(WS_P + (size_t)M * NP * 2 <= WS_H && WS_FS + (size_t)MOE_ROWS * D * 2 <= WS_H && WS_XG + (size_t)MOE_ROWS * D * 2 <= WS_ACT && WS_ACT + (size_t)MOE_ROWS * DE * 2 <= WS_FS, "p map");
static_assert(WS_H + (size_t)M * D * 2 <= WS_BR && WS_BR + (size_t)3 * M * 1024 * 2 <= WS_T, "h/br map");
static_assert(T_OTMP + (size_t)M * D * 2 <= WS_EGU && WS_EGU + (size_t)NE * 2816 * D * 2 <= WS_ED && WS_ED + (size_t)NE * D * DE * 2 <= WS_END && T_MACC + (size_t)M * D * 4 <= T_MB && T_MB + (size_t)M * D * 2 <= WS_EGU, "T map");
static_assert(T_AGGA + (size_t)2 * NB * NCH * 1024 * 4 <= T_AGGB && T_AGGB + (size_t)2 * NB * NCH * 1024 * 4 <= T_CIN && T_CIN + (size_t)2 * NB * NCH * 1024 * 4 <= T_SSDY, "agg map");
constexpr int CW_TMO = 0, CW_BAR = 4096, CW_GCNT = 16384  , CW_NMT = 16384 + 64  , CW_TILEE = 20480  , CW_ATTQ = 16384 + 1024  ;

constexpr int RING_BYTES = 155648, MISC_OFF = RING_BYTES + 320, LDS_BYTES = 163840;
constexpr int NWAVES = 8, NTHR = 512;

#define LDS_WAIT() asm volatile("s_waitcnt lgkmcnt(0)" ::: "memory")
#define VM_WAIT() asm volatile("s_waitcnt vmcnt(0)" ::: "memory")
#define RLX_AGENT __ATOMIC_RELAXED, __HIP_MEMORY_SCOPE_AGENT
__device__ __forceinline__ unsigned f2bf(float f) { unsigned u = __builtin_bit_cast(unsigned, f); return (u + 0x7fffu + ((u >> 16) & 1u)) >> 16; }
__device__ __forceinline__ unsigned pk2(float lo, float hi) { return f2bf(lo) | (f2bf(hi) << 16); }
__device__ __forceinline__ float bflo(unsigned w) { return __builtin_bit_cast(float, w << 16); }
__device__ __forceinline__ float bfhi(unsigned w) { return __builtin_bit_cast(float, w & 0xffff0000u); }
__device__ __forceinline__ void unpack8(v4u w, float (&o)[8]) { o[0] = bflo(w.x); o[1] = bfhi(w.x); o[2] = bflo(w.y); o[3] = bfhi(w.y); o[4] = bflo(w.z); o[5] = bfhi(w.z); o[6] = bflo(w.w); o[7] = bfhi(w.w); }
__device__ __forceinline__ v4u pack8(const float (&o)[8]) { v4u w; w.x = pk2(o[0], o[1]); w.y = pk2(o[2], o[3]); w.z = pk2(o[4], o[5]); w.w = pk2(o[6], o[7]); return w; }
__device__ __forceinline__ float clamp8(float v) { return fminf(fmaxf(v, -448.f), 448.f); }
__device__ __forceinline__ v2u pack8_fp8(const float (&o)[8]) {
    int w0 = 0, w1 = 0;
    w0 = __builtin_amdgcn_cvt_pk_fp8_f32(clamp8(o[0]), clamp8(o[1]), w0, false); w0 = __builtin_amdgcn_cvt_pk_fp8_f32(clamp8(o[2]), clamp8(o[3]), w0, true);
    w1 = __builtin_amdgcn_cvt_pk_fp8_f32(clamp8(o[4]), clamp8(o[5]), w1, false); w1 = __builtin_amdgcn_cvt_pk_fp8_f32(clamp8(o[6]), clamp8(o[7]), w1, true);
    return (v2u){(unsigned)w0, (unsigned)w1}; }
#define DPP_ADD(v, ctrl) v += __int_as_float(__builtin_amdgcn_update_dpp(0, __float_as_int(v), ctrl, 0xF, 0xF, true))
__device__ __forceinline__ float wave_sum(float v) {
    DPP_ADD(v, 0xB1); DPP_ADD(v, 0x4E); DPP_ADD(v, 0x141); DPP_ADD(v, 0x140);
    { const auto r = __builtin_amdgcn_permlane16_swap(__float_as_uint(v), __float_as_uint(v), false, false); const unsigned r0 = r[0], r1 = r[1]; v = __uint_as_float(r0) + __uint_as_float(r1); }
    { const auto r = __builtin_amdgcn_permlane32_swap(__float_as_uint(v), __float_as_uint(v), false, false); const unsigned r0 = r[0], r1 = r[1]; v = __uint_as_float(r0) + __uint_as_float(r1); }
    return v;
}
__device__ __forceinline__ float sum8(float v) { DPP_ADD(v, 0xB1); DPP_ADD(v, 0x4E); DPP_ADD(v, 0x141); return v; }
__device__ __forceinline__ float sigmoidf_(float x) { return 1.f / (1.f + __expf(-x)); }
__device__ __forceinline__ float siluf_(float x) { return x / (1.f + __expf(-x)); }
__device__ __forceinline__ float softplusf_(float x) { return x > 20.f ? x : log1pf(__expf(x)); }
__device__ __forceinline__ float gelu_tanh(float x) { const float u = 0.7978845608028654f * (x + 0.044715f * x * x * x); const float e = __expf(2.f * u); const float t = 1.f - 2.f / (e + 1.f); return 0.5f * x * (1.f + t); }

namespace pg8 {
constexpr int BM = 256, BK = 64, HALF = 128, HTB = HALF * BK * 2, STAGE_BYTES = 8 * HTB;
__host__ __device__ __forceinline__ int lds_byte(int r, int c) { const int st = (r >> 4) * 2 + (c >> 5), rr = r & 15, cc = c & 31, ob = rr * 64 + cc * 2; return st * 1024 + (ob ^ (((ob >> 9) & 1) << 5)); }
__host__ __device__ __forceinline__ void stage_rc(int b, int& R, int& C) { const int st = b / 1024, sb = b % 1024, swz = sb ^ (((sb >> 9) & 1) << 5); R = (st >> 1) * 16 + swz / 64; C = (st & 1) * 32 + (swz % 64) / 2; }
__host__ __device__ __forceinline__ int perm32(int rho) { const int n = rho >> 4, i = rho & 15; return 8 * (i >> 2) + 4 * n + (i & 3); }

struct Unit { int pm, pn, aux; const char* a; const char* b; };
struct Gemm { int K, lda, ldb; };

__device__ __forceinline__ bool tile_of(long L, int nM, int nN, int& pm, int& pn) {
    const int nwg = nM * nN; if (L >= nwg) return false;
    int wgid = (int)L; { const int q = nwg / 8, r = nwg % 8, xcd = wgid % 8, off = wgid / 8; wgid = (xcd < r ? xcd * (q + 1) : r * (q + 1) + (xcd - r) * q) + off; }
    const int nig = 8 * nN, gid = wgid / nig, fm = gid * 8, gsz = (nM - fm) < 8 ? (nM - fm) : 8;
    pm = fm + ((wgid % nig) % gsz); pn = (wgid % nig) / gsz; return true;
}

__device__ __forceinline__ unsigned cvt_pk_bf16(float lo, float hi) { unsigned r; asm volatile("v_cvt_pk_bf16_f32 %0, %1, %2" : "=v"(r) : "v"(lo), "v"(hi)); return r; }

typedef int v8i __attribute__((ext_vector_type(8)));
typedef int v4i __attribute__((ext_vector_type(4)));
template <class Epi, class Sched, bool ALIGN_EPI = false, bool SP2 = false, bool FP8 = false, bool HALFM = false>
__device__ __forceinline__ void gemm_phase(LAS unsigned char* lds, const int tid, const Gemm g, const Sched& S, const Epi& E) {
    const int wid = __builtin_amdgcn_readfirstlane(tid >> 6), lane = tid & 63, wr = wid >> 2, wc = wid & 3, fr = lane & 15, fq = lane >> 4;
    const int K = g.K, nt = K / BK;
    unsigned voffA[2], voffB[2];
#pragma unroll
    for (int i = 0; i < 2; ++i) { int R, C; stage_rc(tid * 16 + i * 8192, R, C); const int Rb = Epi::PERM ? ((R & ~31) + perm32(R & 31)) : R;
        voffA[i] = (unsigned)(R * g.lda + C) * 2u; voffB[i] = (unsigned)(Rb * g.ldb + C) * 2u; }
    const size_t kstep = (size_t)(BK * 2);
    static_assert(!HALFM || SP2, "HALFM is written for the SP2 loop");
    const size_t hstepA = HALFM ? (size_t)0 : (size_t)HALF * g.lda * 2, hstepB = (size_t)HALF * g.ldb * 2;
    const unsigned ldsw = (unsigned)wid * 1024u;
    const int aoff = lds_byte(wr * 64 + fr, fq * 8), boff = lds_byte(wc * 32 + fr, fq * 8);
#define PG8_SA(b, h) (((b) * 2 + (h)) * HTB)
#define PG8_SB(b, h) ((4 + (b) * 2 + (h)) * HTB)
#define PG8_STAGE(bufoff, gbase, voff) do { _Pragma("unroll") for (int _i = 0; _i < 2; ++_i) \
        __builtin_amdgcn_global_load_lds((const unsigned*)((const char*)(gbase) + (voff)[_i]), (LAS unsigned*)(lds + (bufoff) + ldsw + _i * 8192), 16, 0, 0); } while (0)
#define PG8_LDA(dst, b, h) do { _Pragma("unroll") for (int m = 0; m < 4; ++m) { if constexpr (FP8) { const v4i lo_ = *(const LAS v4i*)(lds + PG8_SA(b, h) + aoff + m * 2048), hi_ = *(const LAS v4i*)(lds + PG8_SA(b, h) + aoff + m * 2048 + 1024); dst##8[m] = __builtin_shufflevector(lo_, hi_, 0, 1, 2, 3, 4, 5, 6, 7); } \
        else { _Pragma("unroll") for (int k = 0; k < 2; ++k) dst[m][k] = *(const LAS bf16x8*)(lds + PG8_SA(b, h) + aoff + m * 2048 + k * 1024); } } } while (0)
#define PG8_LDB(dst, b, h) do { _Pragma("unroll") for (int n = 0; n < 2; ++n) { if constexpr (FP8) { const v4i lo_ = *(const LAS v4i*)(lds + PG8_SB(b, h) + boff + n * 2048), hi_ = *(const LAS v4i*)(lds + PG8_SB(b, h) + boff + n * 2048 + 1024); dst##8[n] = __builtin_shufflevector(lo_, hi_, 0, 1, 2, 3, 4, 5, 6, 7); } \
        else { _Pragma("unroll") for (int k = 0; k < 2; ++k) dst[n][k] = *(const LAS bf16x8*)(lds + PG8_SB(b, h) + boff + n * 2048 + k * 1024); } } } while (0)
#define PG8_MMA(ai, bj, At, Bt) do { __builtin_amdgcn_s_setprio(1); _Pragma("unroll") for (int m = 0; m < 4; ++m) _Pragma("unroll") for (int n = 0; n < 2; ++n) { \
        if constexpr (FP8) acc[ai][bj][m][n] = __builtin_amdgcn_mfma_scale_f32_16x16x128_f8f6f4(Bt##8[n], At##8[m], acc[ai][bj][m][n], 0, 0, 0, 0x7f7f7f7f, 0, 0x7f7f7f7f); \
        else { _Pragma("unroll") for (int k = 0; k < 2; ++k) acc[ai][bj][m][n] = __builtin_amdgcn_mfma_f32_16x16x32_bf16(Bt[n][k], At[m][k], acc[ai][bj][m][n], 0, 0, 0); } } \
        __builtin_amdgcn_s_setprio(0); } while (0)
#define PG8_WAIT_V(n) asm volatile("s_waitcnt vmcnt(" #n ")" ::: "memory")
#define PG8_WAIT_L(n) asm volatile("s_waitcnt lgkmcnt(" #n ")" ::: "memory")
#define PG8_BAR __builtin_amdgcn_s_barrier()
#define PG8_SCHED __builtin_amdgcn_sched_barrier(0)
    Unit cur, nxt; int ui = 0;
    if (!S.next(0, cur)) return;
    f32x4 acc[2][2][4][2];
#pragma unroll
    for (int a = 0; a < 2; ++a)
#pragma unroll
        for (int b = 0; b < 2; ++b)
#pragma unroll
            for (int m = 0; m < 4; ++m)
#pragma unroll
                for (int n = 0; n < 2; ++n) acc[a][b][m][n] = (f32x4){0.f, 0.f, 0.f, 0.f};
    bf16x8 At[4][2], B0[2][2], B1[2][2]; v8i At8[4], B08[2], B18[2];
    const char* cA = cur.a; const char* cB = cur.b;
    S.a_ready(cur);
    if constexpr (SP2) {
        PG8_STAGE(PG8_SB(0, 0), cB, voffB); PG8_STAGE(PG8_SB(0, 1), cB + hstepB, voffB); PG8_STAGE(PG8_SA(0, 0), cA, voffA); PG8_STAGE(PG8_SA(0, 1), cA + hstepA, voffA);
        if (wr == 1) PG8_BAR;
        PG8_WAIT_V(2); PG8_BAR;
        PG8_STAGE(PG8_SB(1, 0), cB + kstep, voffB); PG8_STAGE(PG8_SA(1, 0), cA + kstep, voffA); PG8_STAGE(PG8_SB(1, 1), cB + hstepB + kstep, voffB);
        PG8_WAIT_V(6); PG8_BAR;
    } else {
        PG8_STAGE(PG8_SB(0, 0), cB, voffB); PG8_STAGE(PG8_SA(0, 0), cA, voffA); PG8_STAGE(PG8_SB(0, 1), cB + hstepB, voffB); PG8_STAGE(PG8_SA(0, 1), cA + hstepA, voffA);
        if (wr == 1) PG8_BAR;
        PG8_WAIT_V(4); PG8_BAR;
        PG8_STAGE(PG8_SB(1, 0), cB + kstep, voffB); PG8_STAGE(PG8_SA(1, 0), cA + kstep, voffA); PG8_STAGE(PG8_SB(1, 1), cB + hstepB + kstep, voffB);
        PG8_WAIT_V(6); PG8_BAR;
    }
    for (;;) {
        const bool has_next = S.next(ui + 1, nxt);
        const char* nA = has_next ? nxt.a : cA; const char* nB = has_next ? nxt.b : cB;
#pragma unroll 1
        for (int t = 0; t < nt; t += 2) {
            const bool last = (t == nt - 2);
            const char* a1 = cA + (size_t)(t + 1) * kstep;
            const char* a2 = last ? nA : cA + (size_t)(t + 2) * kstep; const char* b2 = last ? nB : cB + (size_t)(t + 2) * kstep;
            const char* a3 = a2 + kstep; const char* b3 = b2 + kstep;
            if (last && has_next) S.a_ready(nxt);
            if constexpr (SP2) {
            PG8_LDB(B0, 0, 0); PG8_LDB(B1, 0, 1); PG8_SCHED; PG8_LDA(At, 0, 0); PG8_STAGE(PG8_SA(1, 1), a1 + hstepA, voffA);
            PG8_WAIT_V(8); PG8_WAIT_L(0); PG8_BAR; PG8_MMA(0, 0, At, B0); PG8_MMA(0, 1, At, B1); PG8_BAR; PG8_SCHED;
            if constexpr (!HALFM) PG8_LDA(At, 0, 1);
            PG8_STAGE(PG8_SB(0, 0), b2, voffB); PG8_STAGE(PG8_SB(0, 1), b2 + hstepB, voffB); PG8_STAGE(PG8_SA(0, 0), a2, voffA);
            PG8_WAIT_V(8); PG8_WAIT_L(0); PG8_BAR; if constexpr (!HALFM) { PG8_MMA(1, 0, At, B0); PG8_MMA(1, 1, At, B1); } PG8_BAR; PG8_SCHED;
            PG8_LDB(B0, 1, 0); PG8_LDB(B1, 1, 1); PG8_SCHED; PG8_LDA(At, 1, 0); PG8_STAGE(PG8_SA(0, 1), a2 + hstepA, voffA);
            PG8_WAIT_V(8); PG8_WAIT_L(0); PG8_BAR; PG8_MMA(0, 0, At, B0); PG8_MMA(0, 1, At, B1); PG8_BAR; PG8_SCHED;
            if constexpr (!HALFM) PG8_LDA(At, 1, 1);
            PG8_STAGE(PG8_SB(1, 0), b3, voffB); PG8_STAGE(PG8_SB(1, 1), b3 + hstepB, voffB); PG8_STAGE(PG8_SA(1, 0), a3, voffA);
            PG8_WAIT_V(8); PG8_WAIT_L(0); PG8_BAR; if constexpr (!HALFM) { PG8_MMA(1, 0, At, B0); PG8_MMA(1, 1, At, B1); } PG8_BAR; PG8_SCHED;
            } else {
            PG8_LDB(B0, 0, 0); PG8_SCHED; PG8_LDA(At, 0, 0); PG8_STAGE(PG8_SA(1, 1), a1 + hstepA, voffA);
            PG8_WAIT_L(8); PG8_BAR; PG8_WAIT_L(0); PG8_MMA(0, 0, At, B0); PG8_BAR; PG8_SCHED;
            PG8_LDB(B1, 0, 1); PG8_STAGE(PG8_SB(0, 0), b2, voffB);
            PG8_BAR; PG8_WAIT_L(0); PG8_MMA(0, 1, At, B1); PG8_BAR;
            PG8_LDA(At, 0, 1); PG8_STAGE(PG8_SA(0, 0), a2, voffA);
            PG8_BAR; PG8_WAIT_L(0); PG8_MMA(1, 0, At, B0); PG8_BAR; PG8_SCHED;
            PG8_STAGE(PG8_SB(0, 1), b2 + hstepB, voffB);
            PG8_WAIT_V(6); PG8_BAR; PG8_MMA(1, 1, At, B1); PG8_BAR;
            PG8_LDB(B0, 1, 0); PG8_SCHED; PG8_LDA(At, 1, 0); PG8_STAGE(PG8_SA(0, 1), a2 + hstepA, voffA);
            PG8_WAIT_L(8); PG8_BAR; PG8_WAIT_L(0); PG8_MMA(0, 0, At, B0); PG8_BAR; PG8_SCHED;
            PG8_LDB(B1, 1, 1); PG8_STAGE(PG8_SB(1, 0), b3, voffB);
            PG8_BAR; PG8_WAIT_L(0); PG8_MMA(0, 1, At, B1); PG8_BAR;
            PG8_LDA(At, 1, 1); PG8_STAGE(PG8_SA(1, 0), a3, voffA);
            PG8_BAR; PG8_WAIT_L(0); PG8_MMA(1, 0, At, B0); PG8_BAR; PG8_SCHED;
            PG8_STAGE(PG8_SB(1, 1), b3 + hstepB, voffB);
            PG8_WAIT_V(6); PG8_BAR; PG8_MMA(1, 1, At, B1); PG8_BAR;
            }
        }
        if constexpr (ALIGN_EPI) { if (wr == 0) PG8_BAR; }
        const bool carry = E(acc, cur, wr, wc, fr, fq); S.done(cur);
        if (!has_next) break;
        if (!carry)
#pragma unroll
        for (int a = 0; a < 2; ++a)
#pragma unroll
            for (int b = 0; b < 2; ++b)
#pragma unroll
                for (int m = 0; m < 4; ++m)
#pragma unroll
                    for (int n = 0; n < 2; ++n) acc[a][b][m][n] = (f32x4){0.f, 0.f, 0.f, 0.f};
        cur = nxt; cA = nA; cB = nB; ++ui;
        if constexpr (ALIGN_EPI) { if (wr == 1) PG8_BAR; }
    }
    PG8_WAIT_V(0);
    if constexpr (!ALIGN_EPI) { if (wr == 0) PG8_BAR; }
    PG8_BAR;
#undef PG8_SA
#undef PG8_SB
#undef PG8_STAGE
#undef PG8_LDA
#undef PG8_LDB
#undef PG8_MMA
#undef PG8_WAIT_V
#undef PG8_WAIT_L
#undef PG8_BAR
#undef PG8_SCHED
}
}

struct SchedPlain {
    int nM, nN, G, c; const char* A; const char* B; size_t a_tile, b_tile; int skipctx;
    __device__ __forceinline__ bool next(int i, pg8::Unit& u) const {
        if (!pg8::tile_of((long)i * G + c, nM, nN, u.pm, u.pn)) return false;
        if (skipctx) u.pm = (u.pm >> 4) * 17 + 1 + (u.pm & 15);
        u.aux = 0; u.a = A + (size_t)u.pm * a_tile; u.b = B + (size_t)u.pn * b_tile; return true; }
    __device__ __forceinline__ void a_ready(const pg8::Unit&) const {}
    __device__ __forceinline__ void done(const pg8::Unit&) const {}
};
struct SchedIn {
    int G, c, last; const char* A; const char* B;
    __device__ __forceinline__ bool next(int i, pg8::Unit& u) const {
        const long L = (long)i * G + c;
        if (!last) { if (!pg8::tile_of(L, M / 256, NP / 256, u.pm, u.pn)) return false; }
        else if (L < 64 * 57) { pg8::tile_of(L, 64, NP / 256, u.pm, u.pn); u.pm = (u.pm >> 4) * 17 + 1 + (u.pm & 15); }
        else { const int r = (int)(L - 64 * 57); if (r >= 4 * 21) return false; const int k = r % 21; u.pm = (r / 21) * 17;
            u.pn = k < 4 ? k : (k < 12 ? 8 + k : (k < 20 ? 12 + k : 56)); }
        u.aux = 0; u.a = A + (size_t)u.pm * 256 * D * 2; u.b = B + (size_t)u.pn * 256 * D * 2; return true; }
    __device__ __forceinline__ void a_ready(const pg8::Unit&) const {}
    __device__ __forceinline__ void done(const pg8::Unit&) const {}
};
struct SchedLru {
    int G, c; const char* xc; const char* wg;
    __device__ __forceinline__ bool next(int i, pg8::Unit& u) const {
        if (!pg8::tile_of((long)i * G + c, M / 256, 16, u.pm, u.pn)) return false;
        u.aux = 0; u.a = xc + (size_t)u.pm * 256 * 1024 * 2 + (size_t)((u.pn & 7) >> 1) * 256 * 2; u.b = wg + (size_t)u.pn * 256 * 256 * 2; return true; }
    __device__ __forceinline__ void a_ready(const pg8::Unit&) const {}
    __device__ __forceinline__ void done(const pg8::Unit&) const {}
};
struct SchedMerge {
    int G, c; const char* br; const char* wbr; int skipctx;
    __device__ __forceinline__ bool next(int i, pg8::Unit& u) const {
        const int T = i / 3, k = i - 3 * T;
        if (!pg8::tile_of((long)T * G + c, skipctx ? 64 : M / 256, D / 256, u.pm, u.pn)) return false;
        if (skipctx) u.pm = (u.pm >> 4) * 17 + 1 + (u.pm & 15);
        u.aux = k; u.a = br + ((size_t)k * M + (size_t)u.pm * 256) * 1024 * 2; u.b = wbr + ((size_t)k * D + (size_t)u.pn * 256) * 1024 * 2; return true; }
    __device__ __forceinline__ void a_ready(const pg8::Unit&) const {}
    __device__ __forceinline__ void done(const pg8::Unit&) const {}
};
struct SchedMoe {
    int nM, nN, G, c; const char* A; const char* W; size_t a_tile, w_exp, w_tile; const unsigned* tile_e;
    __device__ __forceinline__ bool next(int i, pg8::Unit& u) const {
        if (!pg8::tile_of((long)i * G + c, nM, nN, u.pm, u.pn)) return false;
        const int e = (int)(__builtin_amdgcn_readfirstlane(tile_e[u.pm & 511]) & 15u);
        u.aux = e; u.a = A + (size_t)u.pm * a_tile; u.b = W + (size_t)e * w_exp + (size_t)u.pn * w_tile; return true; }
    __device__ __forceinline__ void a_ready(const pg8::Unit&) const {}
    __device__ __forceinline__ void done(const pg8::Unit&) const {}
};

typedef f32x4 (&AccRef)[2][2][4][2];
struct EpiP {
    static constexpr bool PERM = true; bf16* O;
    __device__ __forceinline__ bool operator()(AccRef acc, const pg8::Unit& u, int wr, int wc, int fr, int fq) const {
        const int row0 = u.pm * 256 + wr * 64 + fr, col0 = u.pn * 256 + wc * 32 + 8 * fq;
#pragma unroll
        for (int ai = 0; ai < 2; ++ai)
#pragma unroll
            for (int m = 0; m < 4; ++m) { bf16* rowp = O + (size_t)(row0 + ai * 128 + m * 16) * NP + col0;
#pragma unroll
                for (int bj = 0; bj < 2; ++bj) { const f32x4 v0 = acc[ai][bj][m][0], v1 = acc[ai][bj][m][1]; v4u w;
                    w.x = pg8::cvt_pk_bf16(v0[0], v0[1]); w.y = pg8::cvt_pk_bf16(v0[2], v0[3]); w.z = pg8::cvt_pk_bf16(v1[0], v1[1]); w.w = pg8::cvt_pk_bf16(v1[2], v1[3]);
                    *(v4u*)(rowp + bj * 128) = w; } }
        return false;
    }
};
struct EpiLru {
    static constexpr bool PERM = true; const bf16* xc; const float* gate_b; const float* lam; bf16* la; bf16* bb;
    __device__ __forceinline__ bool operator()(AccRef acc, const pg8::Unit& u, int wr, int wc, int fr, int fq) const {
        const int d = u.pn >> 3, blk = u.pn & 7, c0 = blk * 128 + wc * 32 + 8 * fq;
        float br[8], bi[8], sp[8];
#pragma unroll
        for (int n = 0; n < 2; ++n) { const f32x4 b0 = *(const f32x4*)(gate_b + (d * 2 + 0) * 1024 + c0 + 4 * n), b1 = *(const f32x4*)(gate_b + (d * 2 + 1) * 1024 + c0 + 4 * n), lm = *(const f32x4*)(lam + d * 1024 + c0 + 4 * n);
#pragma unroll
            for (int j = 0; j < 4; ++j) { br[4 * n + j] = b0[j]; bi[4 * n + j] = b1[j]; sp[4 * n + j] = softplusf_(-lm[j]) * (8.f * 1.4426950408889634f); } }
        v4u xw[2][4];
#pragma unroll
        for (int ai = 0; ai < 2; ++ai)
#pragma unroll
            for (int m = 0; m < 4; ++m) xw[ai][m] = *(const v4u*)(xc + (size_t)(u.pm * 256 + ai * 128 + wr * 64 + m * 16 + fr) * 1024 + c0);
#pragma unroll
        for (int ai = 0; ai < 2; ++ai)
#pragma unroll
            for (int m = 0; m < 4; ++m) { const int row = u.pm * 256 + ai * 128 + wr * 64 + m * 16 + fr;
                float x8[8], lo[8], bo[8]; unpack8(xw[ai][m], x8);
#pragma unroll
                for (int j = 0; j < 8; ++j) { const float ea = __expf(-(acc[ai][0][m][j >> 2][j & 3] + br[j])), eb = __expf(-(acc[ai][1][m][j >> 2][j & 3] + bi[j]));
                    const float inv = __builtin_amdgcn_rcpf((1.f + ea) * (1.f + eb)), r = (1.f + eb) * inv, ig = (1.f + ea) * inv, la2 = -r * sp[j];
                    lo[j] = la2; bo[j] = __builtin_amdgcn_sqrtf(fmaxf(1.f - __builtin_amdgcn_exp2f(2.f * la2), 0.f)) * ig * x8[j]; }
                *(v4u*)(la + ((size_t)d * M + row) * 1024 + c0) = pack8(lo); *(v4u*)(bb + ((size_t)d * M + row) * 1024 + c0) = pack8(bo); }
        return false;
    }
};
struct EpiMerge {
    static constexpr bool PERM = true; const bf16* p; bf16* mb;
    __device__ __forceinline__ bool operator()(AccRef acc, const pg8::Unit& u, int wr, int wc, int fr, int fq) const {
        const int k = u.aux, col0 = u.pn * 256 + wc * 32 + 8 * fq; const int k2 = k < 2 ? k + 1 : k;
#pragma unroll
        for (int ai = 0; ai < 2; ++ai) {
            v4u wa[4][2], wb[4][2];
#pragma unroll
            for (int m = 0; m < 4; ++m)
#pragma unroll
                for (int bj = 0; bj < 2; ++bj) { const bf16* gp = p + (size_t)(u.pm * 256 + ai * 128 + wr * 64 + m * 16 + fr) * NP + P_G + col0 + bj * 128;
                    wa[m][bj] = *(const v4u*)(gp + k * D); wb[m][bj] = *(const v4u*)(gp + k2 * D); }
#pragma unroll
            for (int m = 0; m < 4; ++m) { const int row = u.pm * 256 + ai * 128 + wr * 64 + m * 16 + fr;
#pragma unroll
                for (int bj = 0; bj < 2; ++bj) { const int col = col0 + bj * 128; float ga[8]; unpack8(wa[m][bj], ga);
                    if (k < 2) { float gb[8]; unpack8(wb[m][bj], gb);
#pragma unroll
                        for (int j = 0; j < 8; ++j) { const float ea = __expf(-fminf(fmaxf(ga[j], -30.f), 30.f)), eb = __expf(-fminf(fmaxf(gb[j], -30.f), 30.f));
                            acc[ai][bj][m][j >> 2][j & 3] *= (1.f + eb) * __builtin_amdgcn_rcpf(1.f + ea); } }
                    else { float t[8];
#pragma unroll
                        for (int j = 0; j < 8; ++j) t[j] = sigmoidf_(ga[j]) * acc[ai][bj][m][j >> 2][j & 3];
                        *(v4u*)(mb + (size_t)row * D + col) = pack8(t); } } } }
        return k < 2;
    }
};
struct EpiWout {
    static constexpr bool PERM = true; const float* res_lat; const float* res_ctx; const float* g1; float* y;
    __device__ __forceinline__ bool operator()(AccRef acc, const pg8::Unit& u, int wr, int wc, int fr, int fq) const {
        const int b = u.pm / 17, jt = u.pm - 17 * b; const bool isctx = (jt == 0); const int mrow = isctx ? 4 : b, col0 = u.pn * 256 + wc * 32 + 8 * fq;
        f32x4 gv[2][2];
#pragma unroll
        for (int bj = 0; bj < 2; ++bj)
#pragma unroll
            for (int n = 0; n < 2; ++n) gv[bj][n] = *(const f32x4*)(g1 + (size_t)mrow * NADA + col0 + bj * 128 + 4 * n);
#pragma unroll
        for (int ai = 0; ai < 2; ++ai) {
            f32x4 rv[4][2][2];
#pragma unroll
            for (int m = 0; m < 4; ++m) { const int j = jt * 256 + ai * 128 + wr * 64 + m * 16 + fr;
                const float* rp = isctx ? res_ctx + ((size_t)b * LC + j) * D : res_lat + ((size_t)b * LL + (j - LC)) * D;
#pragma unroll
                for (int bj = 0; bj < 2; ++bj)
#pragma unroll
                    for (int n = 0; n < 2; ++n) rv[m][bj][n] = *(const f32x4*)(rp + col0 + bj * 128 + 4 * n); }
#pragma unroll
            for (int m = 0; m < 4; ++m) { const int j = jt * 256 + ai * 128 + wr * 64 + m * 16 + fr; const size_t row = (size_t)b * LT + j;
#pragma unroll
                for (int bj = 0; bj < 2; ++bj)
#pragma unroll
                    for (int n = 0; n < 2; ++n) *(f32x4*)(y + row * D + col0 + bj * 128 + 4 * n) = rv[m][bj][n] * DN_ALPHA + gv[bj][n] * acc[ai][bj][m][n]; } }
        return false;
    }
};
struct EpiMoe1 {
    static constexpr bool PERM = true; unsigned char* act;
    __device__ __forceinline__ bool operator()(AccRef acc, const pg8::Unit& u, int wr, int wc, int fr, int fq) const {
        const int col = u.pn * 128 + wc * 32 + 8 * fq;
#pragma unroll
        for (int m = 0; m < 4; ++m) { const int row = u.pm * 128 + wr * 64 + m * 16 + fr; float t[8];
#pragma unroll
            for (int j = 0; j < 8; ++j) t[j] = siluf_(acc[0][0][m][j >> 2][j & 3] * (1.f / WSC_GU)) * (acc[0][1][m][j >> 2][j & 3] * (1.f / WSC_GU));
            *(v2u*)(act + (size_t)row * DEP + col) = pack8_fp8(t);
            if (u.pn == 10) *(v2u*)(act + (size_t)row * DEP + col + 128) = (v2u){0u, 0u}; }
        return false;
    }
};
struct EpiMoe2 {
    static constexpr bool PERM = true; bf16* fs;
    __device__ __forceinline__ bool operator()(AccRef acc, const pg8::Unit& u, int wr, int wc, int fr, int fq) const {
        const int col0 = u.pn * 256 + wc * 32 + 8 * fq;
#pragma unroll
        for (int m = 0; m < 4; ++m) { const int row = u.pm * 128 + wr * 64 + m * 16 + fr;
#pragma unroll
            for (int bj = 0; bj < 2; ++bj) { const f32x4 v0 = acc[0][bj][m][0] * (1.f / WSC_D), v1 = acc[0][bj][m][1] * (1.f / WSC_D); v4u w;
                w.x = pg8::cvt_pk_bf16(v0[0], v0[1]); w.y = pg8::cvt_pk_bf16(v0[2], v0[3]); w.z = pg8::cvt_pk_bf16(v1[0], v1[1]); w.w = pg8::cvt_pk_bf16(v1[2], v1[3]);
                *(v4u*)(fs + (size_t)row * D + col0 + bj * 128) = w; } }
        return false;
    }
};

#define XB_TMO      128
#define XB_XCNT(j)  (256  + 64 * (j))
#define XB_XSUB(j)  (1280 + 64 * (j))
#define XB_XGEN(j)  (2304 + 64 * (j))
#define XB_TOP      3328
#define XB_TOPGEN   3392
#define XCD_BAR_WORDS 3456
#define XB_SPIN_CAP (1u << 22)

__device__ __forceinline__ unsigned xb_ld(unsigned* p)              { return __hip_atomic_load(p, __ATOMIC_RELAXED, __HIP_MEMORY_SCOPE_AGENT); }
__device__ __forceinline__ unsigned xb_add(unsigned* p, unsigned v) { return __hip_atomic_fetch_add(p, v, __ATOMIC_RELAXED, __HIP_MEMORY_SCOPE_AGENT); }
__device__ __forceinline__ unsigned xb_xcc_id() { return (unsigned)__builtin_amdgcn_s_getreg((3 << 11) | 20) & 0xFu; }
#define XB_SPIN(cond, bar) do { unsigned _sp = 0; while (cond) { __builtin_amdgcn_s_sleep(1); \
    if ((++_sp & 255u) == 0u) { if (xb_ld(&(bar)[XB_TMO])) break; if (_sp > XB_SPIN_CAP) { atomicAdd(&(bar)[XB_TMO], 1u); break; } } } } while (0)

struct XcdBarrier { unsigned* bar; unsigned x; volatile LAS unsigned* st; };

__device__ __forceinline__ XcdBarrier xcd_barrier_post(unsigned* bar, volatile LAS unsigned* st) {
    XcdBarrier b; b.bar = bar; b.x = xb_xcc_id(); b.st = st;
    if (threadIdx.x == 0) (void)xb_add(&bar[XB_XCNT(b.x)], 1u);
    return b;
}
__device__ __forceinline__ void xcd_barrier_complete(unsigned* bar, unsigned x, unsigned& nloc, unsigned& nx) {
    const unsigned G = gridDim.x * gridDim.y * gridDim.z;
    unsigned sum, cnt, mine, sp = 0u;
    for (;;) {
        sum = 0u; cnt = 0u; mine = 0u;
#pragma unroll
        for (unsigned j = 0; j < 16; ++j) { const unsigned c = xb_ld(&bar[XB_XCNT(j)]); sum += c; cnt += (c > 0u) ? 1u : 0u; mine = (j == x) ? c : mine; }
        if (sum == G) break;
        __builtin_amdgcn_s_sleep(1);
        if ((++sp & 255u) == 0u) { if (xb_ld(&bar[XB_TMO])) break; if (sp > XB_SPIN_CAP) { atomicAdd(&bar[XB_TMO], 1u); break; } }
    }
    nloc = mine > 0u ? mine : 1u; nx = cnt > 0u ? cnt : 1u;
}
__device__ __forceinline__ void xcd_barrier(const XcdBarrier& b) {
    asm volatile("s_waitcnt vmcnt(0)" ::: "memory");
    __syncthreads();
    if (threadIdx.x == 0) {
        unsigned* bar = b.bar;
        __builtin_amdgcn_s_waitcnt(0);
        unsigned nloc = b.st[0], nx = b.st[1];
        if (nloc == 0u) { xcd_barrier_complete(bar, b.x, nloc, nx); b.st[0] = nloc; b.st[1] = nx; }
        const unsigned old = xb_add(&bar[XB_XSUB(b.x)], 1u);
        const unsigned gen = old / nloc;
        if (old + 1u == (gen + 1u) * nloc) {
            __builtin_amdgcn_fence(__ATOMIC_RELEASE, "agent");
            asm volatile("s_waitcnt vmcnt(0)" ::: "memory");
            const unsigned og = xb_add(&bar[XB_TOP], 1u);
            const unsigned tg = og / nx;
            if (og + 1u == (tg + 1u) * nx) xb_add(&bar[XB_TOPGEN], 1u);
            else XB_SPIN(xb_ld(&bar[XB_TOPGEN]) == tg, bar);
            __builtin_amdgcn_fence(__ATOMIC_ACQUIRE, "agent");
            xb_add(&bar[XB_XGEN(b.x)], 1u);
            asm volatile("s_waitcnt vmcnt(0)" ::: "memory");
        } else {
            XB_SPIN(xb_ld(&bar[XB_XGEN(b.x)]) == gen, bar);
            __builtin_amdgcn_fence(__ATOMIC_ACQUIRE, "agent");
            asm volatile("s_waitcnt vmcnt(0)" ::: "memory");
        }
    }
    __syncthreads();
}

struct Args { const float* in[29]; float* out; unsigned char* ws; int ph_lo, ph_hi, li, pad; };
struct Ctx { LAS unsigned char* lds; int tid, lane, wave, vcu, G; };
typedef const __attribute__((address_space(4))) Args& ArgsRef;
enum { I_X = 0, I_C, I_CTX, I_CCTX, I_WADA, I_BADA, I_WIN, I_LCW, I_LCB, I_LGW, I_LGB, I_LLAM, I_SCW, I_SCB, I_SALOG, I_SDTB, I_SD, I_SNW, I_ALAM, I_ANW, I_WBR, I_WOUT, I_LNG, I_LNB, I_WR, I_RB, I_WG, I_WU, I_WD };
#define ROWLOOP for (int r = C.vcu * NWAVES + C.wave; r < M; r += C.G * NWAVES)

__device__ __forceinline__ void ph_modp(ArgsRef a, Ctx C) {
    LAS float* sil = (LAS float*)C.lds;
    const float* c = a.in[I_C]; const float* cctx = a.in[I_CCTX];
    for (int i = C.tid; i < 5 * D; i += NTHR) { const float v = i < 4 * D ? c[i] : cctx[i - 4 * D]; sil[i] = siluf_(v); }
    __syncthreads();
    const float* w_ada = a.in[I_WADA]; float* modp = (float*)(a.ws + WS_MODP);
    for (int it = C.vcu * NWAVES + C.wave; it < 2 * 48 * 16; it += C.G * NWAVES) {
        const int l = it / 768, rem = it % 768, cb = rem / 16, ks = rem % 16, col = cb * 256 + C.lane * 4;
        const float* wp = w_ada + ((size_t)l * D + ks * 128) * NADA + col;
        f32x4 acc[5];
#pragma unroll
        for (int r = 0; r < 5; ++r) acc[r] = (f32x4){0.f, 0.f, 0.f, 0.f};
#pragma unroll 8
        for (int k = 0; k < 128; ++k) { const f32x4 w = *(const f32x4*)(wp + (size_t)k * NADA);
#pragma unroll
            for (int r = 0; r < 5; ++r) acc[r] += w * sil[r * D + ks * 128 + k]; }
#pragma unroll
        for (int r = 0; r < 5; ++r) *(f32x4*)(modp + ((size_t)(l * 16 + ks) * 5 + r) * NADA + col) = acc[r];
    }
    __syncthreads();
}
__device__ __forceinline__ void ph_modr(ArgsRef a, Ctx C) {
    const float* modp = (const float*)(a.ws + WS_MODP); float* mod = (float*)(a.ws + WS_MOD); const float* b_ada = a.in[I_BADA];
    for (int i = C.vcu * NTHR + C.tid; i < 2 * 5 * NADA; i += C.G * NTHR) {
        const int l = i / (5 * NADA), rem = i % (5 * NADA), n = rem % NADA; float s = b_ada[l * NADA + n];
#pragma unroll
        for (int ks = 0; ks < 16; ++ks) s += modp[(size_t)(l * 16 + ks) * 5 * NADA + rem];
        mod[i] = s; }
}
__device__ __forceinline__ void tr_item(const float* W, int N, bf16* WT, int K, int k0, int n0, int drow0, LAS float* scr, int lane) {
#pragma unroll 8
    for (int i = 0; i < 32; ++i) { const int kk = 2 * i + (lane >> 5); scr[kk * 33 + (lane & 31)] = W[(size_t)(k0 + kk) * N + n0 + (lane & 31)]; }
    LDS_WAIT(); asm volatile("" ::: "memory");
    const int c = lane & 7;
#pragma unroll
    for (int j = 0; j < 4; ++j) { const int n = (lane >> 3) + 8 * j; const LAS float* s = scr + (8 * c) * 33 + n;
        v4u o; o.x = pk2(s[0 * 33], s[1 * 33]); o.y = pk2(s[2 * 33], s[3 * 33]); o.z = pk2(s[4 * 33], s[5 * 33]); o.w = pk2(s[6 * 33], s[7 * 33]);
        *(GAS v4u*)(WT + (size_t)(drow0 + n) * K + k0 + 8 * c) = o; }
    LDS_WAIT(); asm volatile("" ::: "memory");
}
__device__ __forceinline__ void ph_conva(ArgsRef a, Ctx C, int l) {
    LAS float* scr = (LAS float*)(C.lds + C.wave * 8448);
    bf16* Wt_in = (bf16*)(a.ws + WS_WIN); bf16* Wt_br = (bf16*)(a.ws + WS_WBR); bf16* Wt_out = (bf16*)(a.ws + WS_WOUT); bf16* Wg = (bf16*)(a.ws + WS_WG);
    constexpr int I_IN = 32 * 449, I_BRN = 3 * 16 * 64, I_OUTN = 32 * 64, I_PAD = NP - DIN, I_WGN = 4096;
    for (int it = C.vcu * NWAVES + C.wave; it < I_IN + I_BRN + I_OUTN + I_PAD + I_WGN; it += C.G * NWAVES) {
        int r = it;
        if (r < I_IN) { const int kb = r / 449, nb = r % 449, n0 = nb * 32, drow0 = n0 < 5120 ? n0 : (n0 == 5120 ? P_DT : n0 - 32);
            tr_item(a.in[I_WIN] + (size_t)l * D * DIN, DIN, Wt_in, D, kb * 64, n0, drow0, scr, C.lane); continue; }
        r -= I_IN;
        if (r < I_BRN) { const int k = r / 1024, r2 = r % 1024, kb = r2 / 64, nb = r2 % 64;
            tr_item(a.in[I_WBR] + (size_t)(l * 3 + k) * 1024 * D, D, Wt_br + (size_t)k * D * 1024, 1024, kb * 64, nb * 32, nb * 32, scr, C.lane); continue; }
        r -= I_BRN;
        if (r < I_OUTN) { const int kb = r / 64, nb = r % 64; tr_item(a.in[I_WOUT] + (size_t)l * D * D, D, Wt_out, D, kb * 64, nb * 32, nb * 32, scr, C.lane); continue; }
        r -= I_OUTN;
        if (r < I_PAD) { bf16* row = Wt_in + (size_t)(DIN + r) * D;
#pragma unroll
            for (int q = 0; q < 4; ++q) *(v4u*)(row + C.lane * 8 + q * 512) = (v4u){0u, 0u, 0u, 0u};
            continue; }
        r -= I_PAD;
        {
            const int pn = r >> 8, n = r & 255, d = pn >> 3, blk = pn & 7, g = n >> 7, cl = n & 127, half = blk & 1;
            const float* gw = a.in[I_LGW] + ((((size_t)(l * 2 + d) * 2 + g) * 8 + blk) * 128) * 128 + cl;
            const int k0 = C.lane * 4; float v[4];
#pragma unroll
            for (int j = 0; j < 4; ++j) { const int k = k0 + j; v[j] = ((k >> 7) == half) ? gw[(size_t)(k & 127) * 128] : 0.f; }
            *(v2u*)(Wg + (size_t)r * 256 + k0) = (v2u){pk2(v[0], v[1]), pk2(v[2], v[3])}; }
    }
}
__device__ __forceinline__ void tr_item8(const float* W, int N, unsigned char* WT, int Kb, int k0, int n0, int drow0, float scale, LAS float* scr, int lane) {
#pragma unroll 8
    for (int i = 0; i < 32; ++i) { const int kk = 2 * i + (lane >> 5); scr[kk * 33 + (lane & 31)] = W[(size_t)(k0 + kk) * N + n0 + (lane & 31)]; }
    LDS_WAIT(); asm volatile("" ::: "memory");
    const int c = lane & 7;
#pragma unroll
    for (int j = 0; j < 4; ++j) { const int n = (lane >> 3) + 8 * j; const LAS float* sp = scr + (8 * c) * 33 + n; float v[8];
#pragma unroll
        for (int q = 0; q < 8; ++q) v[q] = sp[q * 33] * scale;
        *(GAS v2u*)(WT + (size_t)(drow0 + n) * Kb + k0 + 8 * c) = pack8_fp8(v); }
    LDS_WAIT(); asm volatile("" ::: "memory");
}
struct ConvItem { const float* W; unsigned char* WT; int N, Kb, k0, n0, drow0; float scale; };
__device__ __forceinline__ bool conv_e_item(ArgsRef a, int l, int it, ConvItem& c) {
    if (it >= NE * 3 * 1408) return false;
    const int e = it / (3 * 1408), r0 = it % (3 * 1408), which = r0 / 1408, r = r0 % 1408;
    if (which < 2) { const int kb = r / 44, nb = r % 44, n0 = nb * 32;
        c.W = a.in[which == 0 ? I_WG : I_WU] + (size_t)(l * NE + e) * D * DE; c.N = DE; c.WT = a.ws + WS_EGU + (size_t)e * 2816 * D; c.Kb = D; c.k0 = kb * 64; c.n0 = n0; c.drow0 = (n0 >> 7) * 256 + (n0 & 127) + which * 128; c.scale = WSC_GU; }
    else { const int kb = r / 64, nb = r % 64;
        c.W = a.in[I_WD] + (size_t)(l * NE + e) * DE * D; c.N = D; c.WT = a.ws + WS_ED + (size_t)e * D * DEP; c.Kb = DEP; c.k0 = kb * 64; c.n0 = nb * 32; c.drow0 = nb * 32; c.scale = WSC_D; }
    return true;
}
__device__ __forceinline__ void conv_e(ArgsRef a, Ctx C, int l, int w0, int nw) {
    LAS float* scr = (LAS float*)(C.lds + C.wave * 8448);
    const int lane = C.lane, total = NE * 3 * 1408 + NE * 32;
    float cur[32], nxt[32]; ConvItem ci, cn; bool hc = false, hn = false;
    int it = w0;
    if (it < total) { hn = conv_e_item(a, l, it, cn);
        if (hn) {
#pragma unroll
            for (int i = 0; i < 32; ++i) nxt[i] = cn.W[(size_t)(cn.k0 + 2 * i + (lane >> 5)) * cn.N + cn.n0 + (lane & 31)]; } }
    for (; it < total; it += nw) {
        ci = cn; hc = hn;
#pragma unroll
        for (int i = 0; i < 32; ++i) cur[i] = nxt[i];
        const int itn = it + nw; hn = false;
        if (itn < total) { hn = conv_e_item(a, l, itn, cn);
            if (hn) {
#pragma unroll
                for (int i = 0; i < 32; ++i) nxt[i] = cn.W[(size_t)(cn.k0 + 2 * i + (lane >> 5)) * cn.N + cn.n0 + (lane & 31)]; } }
        if (!hc) {
            const int z = it - NE * 3 * 1408; unsigned char* row = a.ws + WS_ED + ((size_t)z * 64 + lane) * DEP + DE;
#pragma unroll
            for (int q = 0; q < 8; ++q) *(v4u*)(row + q * 16) = (v4u){0u, 0u, 0u, 0u};
            continue; }
#pragma unroll
        for (int i = 0; i < 32; ++i) scr[(2 * i + (lane >> 5)) * 33 + (lane & 31)] = cur[i];
        LDS_WAIT(); asm volatile("" ::: "memory");
        const int c = lane & 7;
#pragma unroll
        for (int jq = 0; jq < 4; ++jq) { const int n = (lane >> 3) + 8 * jq; const LAS float* sp = scr + (8 * c) * 33 + n; float v[8];
#pragma unroll
            for (int q = 0; q < 8; ++q) v[q] = sp[q * 33] * ci.scale;
            *(GAS v2u*)(ci.WT + (size_t)(ci.drow0 + n) * ci.Kb + ci.k0 + 8 * c) = pack8_fp8(v); }
        LDS_WAIT(); asm volatile("" ::: "memory");
    }
}
__device__ __forceinline__ void ph_ln1(ArgsRef a, Ctx C, int l) {
    const float* res_lat = l == 0 ? a.in[I_X] : a.out; const float* res_ctx = l == 0 ? a.in[I_CTX] : (const float*)(a.ws + WS_XSCTX);
    const float* mod = (const float*)(a.ws + WS_MOD) + (size_t)l * 5 * NADA; bf16* h = (bf16*)(a.ws + WS_H);
    ROWLOOP { const int b = r / LT, j = r - b * LT; const bool isctx = j < LC;
        const float* src = isctx ? res_ctx + ((size_t)b * LC + j) * D : res_lat + ((size_t)b * LL + (j - LC)) * D;
        const float* sh = mod + (size_t)(isctx ? 4 : b) * NADA; const float* sc = sh + D;
        f32x4 v[8]; float s = 0.f;
#pragma unroll
        for (int jj = 0; jj < 8; ++jj) { v[jj] = ((const f32x4*)src)[C.lane + 64 * jj]; s += (v[jj].x + v[jj].y) + (v[jj].z + v[jj].w); }
        const float mean = wave_sum(s) * (1.f / D); float s2 = 0.f;
#pragma unroll
        for (int jj = 0; jj < 8; ++jj) { v[jj] = v[jj] - mean; s2 += (v[jj].x * v[jj].x + v[jj].y * v[jj].y) + (v[jj].z * v[jj].z + v[jj].w * v[jj].w); }
        const float rstd = 1.f / sqrtf(wave_sum(s2) * (1.f / D) + LN_EPS);
        unsigned long long* o8 = (unsigned long long*)(h + (size_t)r * D);
#pragma unroll
        for (int jj = 0; jj < 8; ++jj) { const int q = C.lane + 64 * jj; const f32x4 scv = ((const f32x4*)sc)[q], shv = ((const f32x4*)sh)[q];
            const f32x4 o = v[jj] * rstd * (scv + 1.f) + shv;
            o8[q] = (unsigned long long)pk2(o.x, o.y) | ((unsigned long long)pk2(o.z, o.w) << 32); }
    }
}
__device__ __forceinline__ void ph_prep(ArgsRef a, Ctx C, int l) {
    LAS float* cosT = (LAS float*)C.lds; LAS float* sinT = cosT + 1024;
    for (int e = C.tid; e < 1024; e += NTHR) { const int pos = e >> 4, fi = e & 15; const float freq = exp2f(-(float)fi * (13.287712379549449f / 16.f));
        float rev = (float)pos * freq * 0.15915494309189535f; rev -= floorf(rev); cosT[e] = __builtin_amdgcn_cosf(rev); sinT[e] = __builtin_amdgcn_sinf(rev); }
    __syncthreads();
    const bf16* p = (const bf16*)(a.ws + WS_P); bf16* xc = (bf16*)(a.ws + T_XC); bf16* xbc = (bf16*)(a.ws + T_XBC); float* dtb = (float*)(a.ws + T_DT);
    bf16* Qr = (bf16*)(a.ws + T_QR); bf16* Kr = (bf16*)(a.ws + T_KR);
    const float* lcw = a.in[I_LCW] + (size_t)l * 4 * 1024; const float* lcb = a.in[I_LCB] + (size_t)l * 1024;
    const float* scw = a.in[I_SCW] + (size_t)l * 4 * 2048; const float* scb = a.in[I_SCB] + (size_t)l * 2048; const float* dtbias = a.in[I_SDTB] + l * 32;
    for (int item = C.vcu * NWAVES + C.wave; item < M / 2; item += C.G * NWAVES) {
        const int r0 = item * 2, b = r0 / LT, j0 = r0 - b * LT; const bool isctx = j0 < LC; const int seg_lo = isctx ? 0 : LC, seg_hi = isctx ? LC : LT;
        const bf16* prow0 = p + (size_t)r0 * NP;
        const int hh = C.lane >> 3, mm = (C.lane >> 2) & 1, ax = (C.lane >> 1) & 1, ih = C.lane & 1, base = hh * 128 + mm * 64 + ax * 32 + ih * 8;
        v4u rq[2][4]; unsigned short dtraw[2];
#pragma unroll
        for (int rr = 0; rr < 2; ++rr) { const bf16* prow = prow0 + (size_t)rr * NP;
            rq[rr][0] = *(const v4u*)(prow + P_Q + base); rq[rr][1] = *(const v4u*)(prow + P_Q + base + 16); rq[rr][2] = *(const v4u*)(prow + P_K + base); rq[rr][3] = *(const v4u*)(prow + P_K + base + 16);
            dtraw[rr] = prow[P_DT + (C.lane & 31)]; }
#pragma unroll 1
        for (int hb = 0; hb < 2; ++hb) {
            v4u xr[3][5];
#pragma unroll
            for (int u = 0; u < 3; ++u) { const int it = hb * 3 + u; const bool lru = it < 2; const int c = (lru ? it : it - 2) * 512 + C.lane * 8; const int pofs = (lru ? P_LRUX : P_XBC) + c;
#pragma unroll
                for (int k = 0; k < 5; ++k) { const int jj = j0 - 2 + k; xr[u][k] = (jj >= seg_lo && jj < seg_hi) ? *(const v4u*)(prow0 + (ptrdiff_t)(k - 2) * NP + pofs) : (v4u){0u, 0u, 0u, 0u}; } }
#pragma unroll
            for (int u = 0; u < 3; ++u) { const int it = hb * 3 + u; const bool lru = it < 2; const int c = (lru ? it : it - 2) * 512 + C.lane * 8;
                const float* wq = lru ? lcw + c : scw + c; const int wstride = lru ? 1024 : 2048; const float* bq = lru ? lcb + c : scb + c;
                float xin[5][8];
#pragma unroll
                for (int k = 0; k < 5; ++k) unpack8(xr[u][k], xin[k]);
                float w[4][8], bias[8];
#pragma unroll
                for (int tap = 0; tap < 4; ++tap) { const f32x4 w0 = *(const f32x4*)(wq + tap * wstride), w1 = *(const f32x4*)(wq + tap * wstride + 4);
                    w[tap][0] = w0.x; w[tap][1] = w0.y; w[tap][2] = w0.z; w[tap][3] = w0.w; w[tap][4] = w1.x; w[tap][5] = w1.y; w[tap][6] = w1.z; w[tap][7] = w1.w; }
                { const f32x4 b0 = *(const f32x4*)bq, b1 = *(const f32x4*)(bq + 4); bias[0] = b0.x; bias[1] = b0.y; bias[2] = b0.z; bias[3] = b0.w; bias[4] = b1.x; bias[5] = b1.y; bias[6] = b1.z; bias[7] = b1.w; }
#pragma unroll
                for (int rr = 0; rr < 2; ++rr) { float acc[8];
#pragma unroll
                    for (int q = 0; q < 8; ++q) { float v = bias[q];
#pragma unroll
                        for (int tap = 0; tap < 4; ++tap) v += w[tap][q] * xin[rr + tap][q];
                        acc[q] = lru ? v : siluf_(v); }
                    if (lru) *(v4u*)(xc + (size_t)(r0 + rr) * 1024 + c) = pack8(acc); else *(v4u*)(xbc + (size_t)(r0 + rr) * 2048 + c) = pack8(acc); } }
        }
#pragma unroll
        for (int rr = 0; rr < 2; ++rr) { const int r = r0 + rr, j = j0 + rr;
            if (C.lane < 32) { const float v = __builtin_bit_cast(float, (unsigned)dtraw[rr] << 16) + dtbias[C.lane]; dtb[(size_t)r * 32 + C.lane] = softplusf_(v); }
            float cs[8], sn[8];
            if (!isctx) { const int t = j - LC, pos = ax == 0 ? (t >> 6) : (t & 63);
#pragma unroll
                for (int q = 0; q < 8; ++q) { cs[q] = cosT[pos * 16 + ih * 8 + q]; sn[q] = sinT[pos * 16 + ih * 8 + q]; } }
            else {
#pragma unroll
                for (int q = 0; q < 8; ++q) { cs[q] = 1.f; sn[q] = 0.f; } }
#pragma unroll
            for (int w = 0; w < 2; ++w) { const float scl = w == 0 ? QSCALE : 1.f; bf16* dst = (w == 0 ? Qr : Kr) + (size_t)r * 1024 + base;
                float x1[8], x2[8], o1[8], o2[8]; unpack8(rq[rr][2 * w], x1); unpack8(rq[rr][2 * w + 1], x2);
#pragma unroll
                for (int q = 0; q < 8; ++q) { o1[q] = (x1[q] * cs[q] - x2[q] * sn[q]) * scl; o2[q] = (x1[q] * sn[q] + x2[q] * cs[q]) * scl; }
                *(v4u*)dst = pack8(o1); *(v4u*)(dst + 16) = pack8(o2); } }
    }
    __syncthreads();
}
__device__ __forceinline__ void ph_lru_s1(ArgsRef a, Ctx C) {
    const bf16* la = (const bf16*)(a.ws + T_LA); const bf16* bb = (const bf16*)(a.ws + T_BB); float* aggA = (float*)(a.ws + T_AGGA); float* aggB = (float*)(a.ws + T_AGGB);
    for (int i = C.vcu * NTHR + C.tid; i < 2 * NB * NCH * 512; i += C.G * NTHR) {
        const int c2 = i & 511, qq = i >> 9, q = qq % NCH, b = (qq / NCH) & 3, d = qq / (NCH * 4); const int row0 = b * LT + q * 32;
        const unsigned* lap = (const unsigned*)(la + ((size_t)d * M + row0) * 1024) + c2; const unsigned* bbp = (const unsigned*)(bb + ((size_t)d * M + row0) * 1024) + c2;
        float A0 = 1.f, A1 = 1.f, B0 = 0.f, B1 = 0.f;
#pragma unroll 8
        for (int tt = 0; tt < 32; ++tt) { const int t = d == 0 ? tt : 31 - tt; const unsigned wl = lap[t * 512], wb = bbp[t * 512];
            const float a0 = __builtin_amdgcn_exp2f(bflo(wl)), a1 = __builtin_amdgcn_exp2f(bfhi(wl));
            A0 *= a0; A1 *= a1; B0 = a0 * B0 + bflo(wb); B1 = a1 * B1 + bfhi(wb); }
        const size_t idx = ((size_t)(d * NB + b) * NCH + q) * 1024 + 2 * c2;
        *(f32x2*)(aggA + idx) = (f32x2){A0, A1}; *(f32x2*)(aggB + idx) = (f32x2){B0, B1}; }
}
__device__ __forceinline__ void lru_s2_item(ArgsRef a, int it, int lane) {
    const float* aggA = (const float*)(a.ws + T_AGGA); const float* aggB = (const float*)(a.ws + T_AGGB); float* cin = (float*)(a.ws + T_CIN);
    const int cg = it & 15, b = (it >> 4) & 3, d = it >> 6, c = cg * 64 + lane;
    const size_t base = ((size_t)(d * NB + b) * NCH) * 1024 + c; float carry = 0.f;
#pragma unroll 8
    for (int s = 0; s < NCH; ++s) { const int q = d == 0 ? s : (s < 8 ? 7 - s : NCH + 7 - s);
        const float A = aggA[base + (size_t)q * 1024], Bv = aggB[base + (size_t)q * 1024]; cin[base + (size_t)q * 1024] = carry; carry = A * carry + Bv; }
}
__device__ __forceinline__ void ph_lru_s3(ArgsRef a, Ctx C, int l) {
    const bf16* la = (const bf16*)(a.ws + T_LA); const bf16* bb = (const bf16*)(a.ws + T_BB); const float* cin = (const float*)(a.ws + T_CIN);
    const bf16* p = (const bf16*)(a.ws + WS_P); bf16* out = (bf16*)(a.ws + WS_BR);
    LAS v2u* hfl = (LAS v2u*)C.lds + C.tid;
    const int nchq = (l == DEPTH - 1) ? 128 : NCH, nitems = NB * nchq * 256;
    for (int i = C.vcu * NTHR + C.tid; i < nitems; i += C.G * NTHR) {
        const int c4 = i & 255, qq = i >> 8, q = (l == DEPTH - 1) ? 8 + (qq & 127) : qq % NCH, b = (l == DEPTH - 1) ? (qq >> 7) : qq / NCH; const int row0 = b * LT + q * 32;
        const v2u* la0 = (const v2u*)(la + (size_t)row0 * 1024) + c4; const v2u* bb0 = (const v2u*)(bb + (size_t)row0 * 1024) + c4;
        const v2u* la1 = la0 + (size_t)M * 256; const v2u* bb1 = bb0 + (size_t)M * 256;
        const v2u* gp = (const v2u*)(p + (size_t)row0 * NP + P_LRUG) + c4; v2u* op = (v2u*)(out + (size_t)row0 * 1024) + c4;
        const f32x4 ci0 = *(const f32x4*)(cin + ((size_t)(0 * NB + b) * NCH + q) * 1024 + 4 * c4), ci1 = *(const f32x4*)(cin + ((size_t)(1 * NB + b) * NCH + q) * 1024 + 4 * c4);
        f32x4 h = ci0;
#pragma unroll
        for (int g = 0; g < 4; ++g) {
            v2u wl[8], wb[8];
#pragma unroll
            for (int u = 0; u < 8; ++u) { wl[u] = la0[(g * 8 + u) * 256]; wb[u] = bb0[(g * 8 + u) * 256]; }
#pragma unroll
            for (int u = 0; u < 8; ++u) { const int t = g * 8 + u;
                h.x = __builtin_amdgcn_exp2f(bflo(wl[u].x)) * h.x + bflo(wb[u].x); h.y = __builtin_amdgcn_exp2f(bfhi(wl[u].x)) * h.y + bfhi(wb[u].x);
                h.z = __builtin_amdgcn_exp2f(bflo(wl[u].y)) * h.z + bflo(wb[u].y); h.w = __builtin_amdgcn_exp2f(bfhi(wl[u].y)) * h.w + bfhi(wb[u].y);
                hfl[t * 512] = (v2u){pk2(h.x, h.y), pk2(h.z, h.w)}; }
            asm volatile("" ::: "memory"); }
        h = ci1;
#pragma unroll
        for (int g = 0; g < 4; ++g) {
            v2u wl[8], wb[8], gw[8];
#pragma unroll
            for (int u = 0; u < 8; ++u) { const int t = 31 - (g * 8 + u); wl[u] = la1[t * 256]; wb[u] = bb1[t * 256]; gw[u] = gp[(size_t)t * (NP / 4)]; }
#pragma unroll
            for (int u = 0; u < 8; ++u) { const int t = 31 - (g * 8 + u);
                h.x = __builtin_amdgcn_exp2f(bflo(wl[u].x)) * h.x + bflo(wb[u].x); h.y = __builtin_amdgcn_exp2f(bfhi(wl[u].x)) * h.y + bfhi(wb[u].x);
                h.z = __builtin_amdgcn_exp2f(bflo(wl[u].y)) * h.z + bflo(wb[u].y); h.w = __builtin_amdgcn_exp2f(bfhi(wl[u].y)) * h.w + bfhi(wb[u].y);
                const v2u hf = hfl[t * 512];
                op[t * 256] = (v2u){pk2((bflo(hf.x) + h.x) * gelu_tanh(bflo(gw[u].x)), (bfhi(hf.x) + h.y) * gelu_tanh(bfhi(gw[u].x))), pk2((bflo(hf.y) + h.z) * gelu_tanh(bflo(gw[u].y)), (bfhi(hf.y) + h.w) * gelu_tanh(bfhi(gw[u].y)))}; }
            asm volatile("" ::: "memory"); }
    }
    __syncthreads();
}
__device__ __forceinline__ void ph_ssd_scan(ArgsRef a, Ctx C, int l) {
    LAS float* Xs = (LAS float*)C.lds; LAS float* Bs = Xs + 64 * 64; LAS float* Cs = Bs + 64 * 128; LAS float* Ys = Cs + 64 * 128; LAS float* dts = Ys + 64 * 64;
    const bf16* xbc = (const bf16*)(a.ws + T_XBC); const float* dtb = (const float*)(a.ws + T_DT); bf16* ssdy = (bf16*)(a.ws + T_SSDY);
    const int p_ = C.tid >> 3, ng = C.tid & 7, n0 = ng * 16;
    for (int it = C.vcu; it < 128; it += C.G) { const int h = it & 15, d = (it >> 4) & 1, b = it >> 5, g = h >> 2;
        const float Aneg = -__expf(a.in[I_SALOG][(l * 2 + d) * 16 + h]);
        float S[16];
#pragma unroll
        for (int n = 0; n < 16; ++n) S[n] = 0.f;
        for (int ci = 0; ci < 68; ++ci) { const int q = d == 0 ? ci : (ci < 4 ? 3 - ci : 71 - ci); const int row0 = b * LT + q * 64;
            { const int rr = C.tid >> 3, cc = (C.tid & 7) * 8; float x8[8]; unpack8(*(const v4u*)(xbc + (size_t)(row0 + rr) * 2048 + h * 64 + cc), x8);
              *(LAS f32x4*)(Xs + rr * 64 + cc) = (f32x4){x8[0], x8[1], x8[2], x8[3]}; *(LAS f32x4*)(Xs + rr * 64 + cc + 4) = (f32x4){x8[4], x8[5], x8[6], x8[7]}; }
#pragma unroll
            for (int rep = 0; rep < 2; ++rep) { const int idx = C.tid + rep * 512, rr = idx >> 4, cc = (idx & 15) * 8; float b8[8], c8[8];
                unpack8(*(const v4u*)(xbc + (size_t)(row0 + rr) * 2048 + 1024 + g * 128 + cc), b8); unpack8(*(const v4u*)(xbc + (size_t)(row0 + rr) * 2048 + 1536 + g * 128 + cc), c8);
                *(LAS f32x4*)(Bs + rr * 128 + cc) = (f32x4){b8[0], b8[1], b8[2], b8[3]}; *(LAS f32x4*)(Bs + rr * 128 + cc + 4) = (f32x4){b8[4], b8[5], b8[6], b8[7]};
                *(LAS f32x4*)(Cs + rr * 128 + cc) = (f32x4){c8[0], c8[1], c8[2], c8[3]}; *(LAS f32x4*)(Cs + rr * 128 + cc + 4) = (f32x4){c8[4], c8[5], c8[6], c8[7]}; }
            if (C.tid < 64) { const float dtv = dtb[(size_t)(row0 + C.tid) * 32 + d * 16 + h]; dts[C.tid] = dtv; dts[64 + C.tid] = __expf(dtv * Aneg); }
            __syncthreads();
            for (int tt = 0; tt < 64; ++tt) { const int t = d == 0 ? tt : 63 - tt; const float dt = dts[t], dec = dts[64 + t], xv = Xs[t * 64 + p_] * dt;
                f32x4 Bv[4], Cv[4];
#pragma unroll
                for (int q4 = 0; q4 < 4; ++q4) { Bv[q4] = *(const LAS f32x4*)(Bs + t * 128 + n0 + 4 * q4); Cv[q4] = *(const LAS f32x4*)(Cs + t * 128 + n0 + 4 * q4); }
                float y = 0.f;
#pragma unroll
                for (int n = 0; n < 16; ++n) { S[n] = dec * S[n] + xv * Bv[n >> 2][n & 3]; y += S[n] * Cv[n >> 2][n & 3]; }
                y += __shfl_xor(y, 1); y += __shfl_xor(y, 2); y += __shfl_xor(y, 4);
                if (ng == 0) Ys[t * 64 + p_] = y; }
            __syncthreads();
            { const int rr = C.tid >> 3, cc = (C.tid & 7) * 8; float y8[8]; const f32x4 y0 = *(const LAS f32x4*)(Ys + rr * 64 + cc), y1 = *(const LAS f32x4*)(Ys + rr * 64 + cc + 4);
              y8[0] = y0.x; y8[1] = y0.y; y8[2] = y0.z; y8[3] = y0.w; y8[4] = y1.x; y8[5] = y1.y; y8[6] = y1.z; y8[7] = y1.w;
              *(v4u*)(ssdy + ((size_t)d * M + row0 + rr) * 1024 + h * 64 + cc) = pack8(y8); }
        }
        __syncthreads();
    }
}
__device__ __forceinline__ void ph_attn_naive(ArgsRef a, Ctx C) {
    LAS float* Ks = (LAS float*)C.lds; LAS float* Vs = Ks + 64 * 64;
    const bf16* Qr = (const bf16*)(a.ws + T_QR); const bf16* Kr = (const bf16*)(a.ws + T_KR); const bf16* p = (const bf16*)(a.ws + WS_P); bf16* otmp = (bf16*)(a.ws + T_OTMP);
    const int qi = C.tid >> 2, part = C.tid & 3;
    for (int u = C.vcu; u < 2048 + 128; u += C.G) {
        int qb, hm, b; bool isctx;
        if (u < 2048) { qb = u & 31; hm = (u >> 5) & 15; b = u >> 9; isctx = false; } else { const int u2 = u - 2048; qb = u2 & 1; hm = (u2 >> 1) & 15; b = u2 >> 5; isctx = true; }
        const int qrow = b * LT + (isctx ? 0 : LC) + qb * 128 + qi, kv0 = b * LT, nkt = isctx ? 4 : 68, hh = hm >> 1, qcol = hh * 128 + (hm & 1) * 64;
        float q[16];
        { float t8[8]; unpack8(*(const v4u*)(Qr + (size_t)qrow * 1024 + qcol + part * 16), t8);
#pragma unroll
          for (int j = 0; j < 8; ++j) q[j] = t8[j];
          unpack8(*(const v4u*)(Qr + (size_t)qrow * 1024 + qcol + part * 16 + 8), t8);
#pragma unroll
          for (int j = 0; j < 8; ++j) q[8 + j] = t8[j]; }
        float o[32], mrun = -1e30f, lsum = 0.f;
#pragma unroll
        for (int j = 0; j < 32; ++j) o[j] = 0.f;
        for (int kt = 0; kt < nkt; ++kt) {
            __syncthreads();
            { const int rr = C.tid >> 3, cc = (C.tid & 7) * 8; float k8[8]; unpack8(*(const v4u*)(Kr + (size_t)(kv0 + kt * 64 + rr) * 1024 + qcol + cc), k8);
              *(LAS f32x4*)(Ks + rr * 64 + cc) = (f32x4){k8[0], k8[1], k8[2], k8[3]}; *(LAS f32x4*)(Ks + rr * 64 + cc + 4) = (f32x4){k8[4], k8[5], k8[6], k8[7]}; }
#pragma unroll
            for (int rep = 0; rep < 2; ++rep) { const int idx = C.tid + rep * 512, rr = idx >> 4, cc = (idx & 15) * 8; float v8[8];
                unpack8(*(const v4u*)(p + (size_t)(kv0 + kt * 64 + rr) * NP + P_V + hh * 128 + cc), v8);
                *(LAS f32x4*)(Vs + rr * 128 + cc) = (f32x4){v8[0], v8[1], v8[2], v8[3]}; *(LAS f32x4*)(Vs + rr * 128 + cc + 4) = (f32x4){v8[4], v8[5], v8[6], v8[7]}; }
            __syncthreads();
#pragma unroll 1
            for (int g8 = 0; g8 < 8; ++g8) {
                float s[8];
#pragma unroll
                for (int j = 0; j < 8; ++j) { const LAS float* kp = Ks + (g8 * 8 + j) * 64 + part * 16; float acc = 0.f;
#pragma unroll
                    for (int q4 = 0; q4 < 4; ++q4) { const f32x4 kv = *(const LAS f32x4*)(kp + 4 * q4); acc += q[4 * q4] * kv.x + q[4 * q4 + 1] * kv.y + q[4 * q4 + 2] * kv.z + q[4 * q4 + 3] * kv.w; }
                    acc += __shfl_xor(acc, 1); acc += __shfl_xor(acc, 2); s[j] = acc; }
                float mx = s[0];
#pragma unroll
                for (int j = 1; j < 8; ++j) mx = fmaxf(mx, s[j]);
                const float mnew = fmaxf(mrun, mx), alpha = __builtin_amdgcn_exp2f(mrun - mnew); mrun = mnew; lsum *= alpha;
#pragma unroll
                for (int j = 0; j < 32; ++j) o[j] *= alpha;
#pragma unroll
                for (int j = 0; j < 8; ++j) { const float pj = __builtin_amdgcn_exp2f(s[j] - mnew); lsum += pj; const LAS float* vp = Vs + (g8 * 8 + j) * 128 + part * 32;
#pragma unroll
                    for (int q4 = 0; q4 < 8; ++q4) { const f32x4 vv = *(const LAS f32x4*)(vp + 4 * q4); o[4 * q4] += pj * vv.x; o[4 * q4 + 1] += pj * vv.y; o[4 * q4 + 2] += pj * vv.z; o[4 * q4 + 3] += pj * vv.w; } }
            }
        }
        const float inv = 1.f / lsum; bf16* op = otmp + (size_t)qrow * 2048 + hm * 128 + part * 32;
#pragma unroll
        for (int q8 = 0; q8 < 4; ++q8) { float t8[8];
#pragma unroll
            for (int j = 0; j < 8; ++j) t8[j] = o[q8 * 8 + j] * inv;
            *(v4u*)(op + q8 * 8) = pack8(t8); }
    }
    __syncthreads();
}
namespace att {
using f32x16 = __attribute__((ext_vector_type(16))) float;
using s16x4 = __attribute__((ext_vector_type(4))) short;
constexpr int SHM_V = 64 * 128 * 2, SHM_K = 64 * 64 * 2;
constexpr float THR2 = 11.5f;
#define KSWZ64(row, colB) ((row) * 128 + ((colB) ^ ((((row) >> 1) & 7) << 4)))
#define SBAR() __builtin_amdgcn_sched_barrier(0)
__device__ __forceinline__ int crow(int r, int hi) { return (r & 3) + 8 * (r >> 2) + 4 * hi; }
__device__ __forceinline__ unsigned cvtpk(float lo, float hi) { unsigned r; asm volatile("v_cvt_pk_bf16_f32 %0, %1, %2" : "=v"(r) : "v"(lo), "v"(hi)); return r; }
__device__ __forceinline__ void partialSM(f32x16& p0, f32x16& p1, float& m_reg, float& mn, float& alpha) {
    float pmax = p0[0];
#pragma unroll
    for (int r = 1; r < 16; ++r) pmax = fmaxf(pmax, p0[r]);
#pragma unroll
    for (int r = 0; r < 16; ++r) pmax = fmaxf(pmax, p1[r]);
    { auto rr = __builtin_amdgcn_permlane32_swap(__float_as_uint(pmax), __float_as_uint(pmax), false, false); pmax = fmaxf(__uint_as_float(rr[0]), __uint_as_float(rr[1])); }
    if (__builtin_expect(__all(pmax - m_reg <= THR2), 1)) { mn = m_reg; alpha = 1.f; }
    else { mn = fmaxf(m_reg, pmax); alpha = __builtin_amdgcn_exp2f(m_reg - mn); m_reg = mn; }
#pragma unroll
    for (int r = 0; r < 16; ++r) { p0[r] = p0[r] - mn; p1[r] = p1[r] - mn; }
#pragma unroll
    for (int r = 0; r < 16; ++r) p0[r] = __builtin_amdgcn_exp2f(p0[r]);
}
__device__ __forceinline__ void finishSM(f32x16& p0, f32x16& p1, float alpha, float& l_reg, bf16x8& pa0, bf16x8& pa1, bf16x8& pa2, bf16x8& pa3) {
#pragma unroll
    for (int r = 0; r < 16; ++r) p1[r] = __builtin_amdgcn_exp2f(p1[r]);
    float ps = 0.f;
#pragma unroll
    for (int r = 0; r < 16; ++r) ps += p0[r];
#pragma unroll
    for (int r = 0; r < 16; ++r) ps += p1[r];
    { auto rr = __builtin_amdgcn_permlane32_swap(__float_as_uint(ps), __float_as_uint(ps), false, false); ps = __uint_as_float(rr[0]) + __uint_as_float(rr[1]); }
    l_reg = l_reg * alpha + ps;
#define PK4(P, BASE, OUT) do { unsigned a0 = cvtpk(P[BASE + 0], P[BASE + 1]), a1 = cvtpk(P[BASE + 2], P[BASE + 3]); \
    unsigned b0 = cvtpk(P[BASE + 4], P[BASE + 5]), b1 = cvtpk(P[BASE + 6], P[BASE + 7]); \
    auto r0 = __builtin_amdgcn_permlane32_swap(a0, b0, false, false); auto r1 = __builtin_amdgcn_permlane32_swap(a1, b1, false, false); \
    v4u w = {r0[0], r1[0], r0[1], r1[1]}; OUT = __builtin_bit_cast(bf16x8, w); } while (0)
    PK4(p0, 0, pa0); PK4(p0, 8, pa1); PK4(p1, 0, pa2); PK4(p1, 8, pa3);
#undef PK4
}
__device__ __forceinline__ void qkt(f32x16& p0, f32x16& p1, const LAS char* Ks, const bf16x8* qr, int r32, int hi) {
    p0 = f32x16{}; p1 = f32x16{};
#pragma unroll
    for (int d0 = 0; d0 < 4; ++d0) { const int cb = (d0 * 16 + hi * 8) * 2;
        const bf16x8 b0 = *(const LAS bf16x8*)(Ks + KSWZ64(r32, cb));
        const bf16x8 b1 = *(const LAS bf16x8*)(Ks + KSWZ64(32 + r32, cb));
        p0 = __builtin_amdgcn_mfma_f32_32x32x16_bf16(b0, qr[d0], p0, 0, 0, 0);
        p1 = __builtin_amdgcn_mfma_f32_32x32x16_bf16(b1, qr[d0], p1, 0, 0, 0); }
}
__device__ __forceinline__ int v_st(int k, int c) { const int kk = (k & ~0xC) | ((k & 4) << 1) | ((k & 8) >> 1); return ((kk >> 3) * 4 + (c >> 5)) * 512 + ((kk & 7) * 32 + (c & 31)) * 2; }
__device__ __forceinline__ int v_rd_base(int lane) { return ((lane & 3) << 3) | (((lane >> 2) & 3) << 6) | (((lane >> 4) & 1) << 5) | (((lane >> 5) & 1) << 8); }
constexpr int v_rd_off(int d0, int ks, int half) { return d0 * 512 + ks * 4096 + half * 2048; }
template <int OFF> __device__ __forceinline__ s16x4 tr_read(int vb) { s16x4 r; asm volatile("ds_read_b64_tr_b16 %0, %1 offset:%2" : "=&v"(r) : "v"(vb), "i"(OFF) : "memory"); return r; }
template <int D0> __device__ __forceinline__ void pv_one(f32x16& od, int vb, bf16x8 pa0, bf16x8 pa1, bf16x8 pa2, bf16x8 pa3) {
    const s16x4 l0 = tr_read<v_rd_off(D0, 0, 0)>(vb), h0 = tr_read<v_rd_off(D0, 0, 1)>(vb), l1 = tr_read<v_rd_off(D0, 1, 0)>(vb), h1 = tr_read<v_rd_off(D0, 1, 1)>(vb);
    const s16x4 l2 = tr_read<v_rd_off(D0, 2, 0)>(vb), h2 = tr_read<v_rd_off(D0, 2, 1)>(vb), l3 = tr_read<v_rd_off(D0, 3, 0)>(vb), h3 = tr_read<v_rd_off(D0, 3, 1)>(vb);
    asm volatile("s_waitcnt lgkmcnt(0)" ::: "memory"); SBAR();
#define PK(L, H) (bf16x8){L[0], L[1], L[2], L[3], H[0], H[1], H[2], H[3]}
    od = __builtin_amdgcn_mfma_f32_32x32x16_bf16(pa0, PK(l0, h0), od, 0, 0, 0);
    od = __builtin_amdgcn_mfma_f32_32x32x16_bf16(pa1, PK(l1, h1), od, 0, 0, 0);
    od = __builtin_amdgcn_mfma_f32_32x32x16_bf16(pa2, PK(l2, h2), od, 0, 0, 0);
    od = __builtin_amdgcn_mfma_f32_32x32x16_bf16(pa3, PK(l3, h3), od, 0, 0, 0);
#undef PK
}
__device__ __forceinline__ void pv_d0(f32x16* o, int vb, bf16x8 pa0, bf16x8 pa1, bf16x8 pa2, bf16x8 pa3) {
    pv_one<0>(o[0], vb, pa0, pa1, pa2, pa3); pv_one<1>(o[1], vb, pa0, pa1, pa2, pa3); pv_one<2>(o[2], vb, pa0, pa1, pa2, pa3); pv_one<3>(o[3], vb, pa0, pa1, pa2, pa3);
}
__device__ __forceinline__ void attn_unit(const bf16* __restrict__ Qb, const bf16* __restrict__ Kh, const bf16* __restrict__ Vh, bf16* __restrict__ Ob, int seq, LAS char* lds, int tid) {
    const int wid = __builtin_amdgcn_readfirstlane(tid >> 6), lane = tid & 63, r32 = lane & 31, hi = lane >> 5;
    LAS char* V_lds = lds; LAS char* K_lds = lds + 2 * SHM_V;
    LAS float* wsf = (LAS float*)(lds + 2 * SHM_V + 2 * SHM_K) + wid * 64; LAS float* li_l = wsf; LAS float* al_l = wsf + 32;
    float m_reg = -1e30f, l_reg = 0.f; f32x16 o[4] = {}; bf16x8 qr[4];
    const bf16* Qw = Qb + (size_t)(wid * 32 + r32) * 1024 + hi * 8;
#pragma unroll
    for (int d0 = 0; d0 < 4; ++d0) qr[d0] = *(const bf16x8*)(Qw + d0 * 16);
    const int sr = tid >> 4, sc = (tid & 15) * 8, vst0 = v_st(sr, sc), vst1 = v_st(32 + sr, sc);
    const int kr = tid >> 3, kc = (tid & 7) * 8, kst = KSWZ64(kr, kc * 2);
    const int vb0 = (int)(unsigned)(size_t)V_lds + v_rd_base(lane);
    struct { bf16x8 vs0, vs1, ks0; } sr_[2];
#define SLOAD(i, k0) do { sr_[i].vs0 = *(const bf16x8*)(Vh + (size_t)((k0) + sr) * NP + sc); sr_[i].vs1 = *(const bf16x8*)(Vh + (size_t)((k0) + 32 + sr) * NP + sc); \
    sr_[i].ks0 = *(const bf16x8*)(Kh + (size_t)((k0) + kr) * 1024 + kc); } while (0)
#define SWRITE(b, i) do { *(LAS bf16x8*)(V_lds + (b) * SHM_V + vst0) = sr_[i].vs0; *(LAS bf16x8*)(V_lds + (b) * SHM_V + vst1) = sr_[i].vs1; \
    *(LAS bf16x8*)(K_lds + (b) * SHM_K + kst) = sr_[i].ks0; } while (0)
#define SWAIT() asm volatile("s_waitcnt vmcnt(3)" ::: "memory")
#define RESC(a) do { if (__any((a) < 1.f)) { if (hi == 0) al_l[r32] = (a); asm volatile("s_waitcnt lgkmcnt(0)" ::: "memory"); \
    _Pragma("unroll") for (int d = 0; d < 4; ++d) _Pragma("unroll") for (int r = 0; r < 16; ++r) o[d][r] *= al_l[crow(r, hi)]; } } while (0)
    f32x16 pA0, pA1, pB0, pB1; float mnA, mnB, alA, alB; bf16x8 pa0, pa1, pa2, pa3; const int NT = seq / 64;
    constexpr int SE = 0, SO = 1;
    SLOAD(SE, 0); asm volatile("s_waitcnt vmcnt(0)" ::: "memory"); SWRITE(0, SE); __syncthreads();
    qkt(pA0, pA1, K_lds, qr, r32, hi); partialSM(pA0, pA1, m_reg, mnA, alA);
    SLOAD(SO, 64); if (2 < NT) SLOAD(SE, 2 * 64);
    SWAIT(); SWRITE(1, SO); __syncthreads();
    for (int j = 1; j + 1 < NT; j += 2) {
        SBAR(); qkt(pB0, pB1, K_lds + SHM_K, qr, r32, hi);
        finishSM(pA0, pA1, alA, l_reg, pa0, pa1, pa2, pa3); SBAR();
        SLOAD(SO, (j + 2) * 64); SBAR();
        pv_d0(o, vb0, pa0, pa1, pa2, pa3); partialSM(pB0, pB1, m_reg, mnB, alB);
        __syncthreads(); SWAIT(); SWRITE(0, SE);
        RESC(alB); __syncthreads();
        SBAR(); qkt(pA0, pA1, K_lds, qr, r32, hi);
        finishSM(pB0, pB1, alB, l_reg, pa0, pa1, pa2, pa3); SBAR();
        if (j + 3 < NT) SLOAD(SE, (j + 3) * 64); SBAR();
        pv_d0(o, vb0 + SHM_V, pa0, pa1, pa2, pa3); partialSM(pA0, pA1, m_reg, mnA, alA);
        __syncthreads(); SWAIT(); SWRITE(1, SO);
        RESC(alA); __syncthreads();
    }
    SBAR(); qkt(pB0, pB1, K_lds + SHM_K, qr, r32, hi);
    finishSM(pA0, pA1, alA, l_reg, pa0, pa1, pa2, pa3); SBAR();
    pv_d0(o, vb0, pa0, pa1, pa2, pa3); partialSM(pB0, pB1, m_reg, mnB, alB);
    __syncthreads(); RESC(alB);
    finishSM(pB0, pB1, alB, l_reg, pa0, pa1, pa2, pa3); SBAR();
    pv_d0(o, vb0 + SHM_V, pa0, pa1, pa2, pa3);
    if (hi == 0) li_l[r32] = l_reg; asm volatile("s_waitcnt lgkmcnt(0)" ::: "memory");
    float rli[16];
#pragma unroll
    for (int r = 0; r < 16; ++r) rli[r] = __builtin_amdgcn_rcpf(li_l[crow(r, hi)]);
    bf16* Ow = Ob + (size_t)(wid * 32) * 2048;
#pragma unroll
    for (int r = 0; r < 16; ++r) { const int orow = crow(r, hi);
#pragma unroll
        for (int d0 = 0; d0 < 4; ++d0) Ow[(size_t)orow * 2048 + d0 * 32 + r32] = (bf16)f2bf(o[d0][r] * rli[r]); }
    __syncthreads();
#undef SLOAD
#undef SWRITE
#undef SWAIT
#undef RESC
}
}
namespace ssd {
using att::f32x16; using att::s16x4;
constexpr int IMG = 16384;
#define KSWZ128(row, colB) ((row) * 256 + ((colB) ^ (((row) & 7) << 4)))
template <int OFF> __device__ __forceinline__ s16x4 trr(int vb) { s16x4 r; asm volatile("ds_read_b64_tr_b16 %0, %1 offset:%2" : "=&v"(r) : "v"(vb), "i"(OFF) : "memory"); return r; }
#define SSD_PK(L, H) (bf16x8){L[0], L[1], L[2], L[3], H[0], H[1], H[2], H[3]}
__device__ __forceinline__ void ssd_item(const bf16* __restrict__ xbc, const float* __restrict__ dtb, bf16* __restrict__ ssdy, float Aneg2, int b, int d, int h, LAS char* lds, int tid) {
    const int wid = __builtin_amdgcn_readfirstlane(tid >> 6), lane = tid & 63, r32 = lane & 31, hi = lane >> 5, g = h >> 2;
    const bool ywave = wid < 4; const int tb = wid & 1, pb = (wid >> 1) & 1, pb2 = wid & 1, nb = wid >> 1;
    LAS char* Ss = lds + 8 * IMG; LAS float* cumw = (LAS float*)(lds + 9 * IMG) + wid * 128;
    const int ldsb = (int)(unsigned)(size_t)lds;
    const int sa = tid >> 4, cB = (tid & 15) * 8, sx = tid >> 3, cX = (tid & 7) * 8;
    const int kst_a = KSWZ128(sa, cB * 2), kst_b = KSWZ128(32 + sa, cB * 2), vst_a = att::v_st(sa, cB), vst_b = att::v_st(32 + sa, cB), xst_d = att::v_st(sx, cX), xst_s = att::v_st(sx, 64 + cX);
    const int rdb = att::v_rd_base(lane);
    f32x16 sacc = {};
    { LAS v4u* z = (LAS v4u*)(Ss + tid * 32); z[0] = (v4u){0u, 0u, 0u, 0u}; z[1] = (v4u){0u, 0u, 0u, 0u}; }
    bf16x8 nb0, nb1, nc0, nc1, nx; float ndt; float cum2 = 0.f;
#define SSD_ROW0(ci) (b * LT + ((d == 0) ? (ci) : ((ci) < 4 ? 3 - (ci) : 71 - (ci))) * 64)
#define SSD_ROW(r0, s) ((r0) + ((d == 0) ? (s) : 63 - (s)))
#define SSD_LOAD(ci) do { const int r0_ = SSD_ROW0(ci); \
        nb0 = *(const bf16x8*)(xbc + (size_t)SSD_ROW(r0_, sa) * 2048 + 1024 + g * 128 + cB); nb1 = *(const bf16x8*)(xbc + (size_t)SSD_ROW(r0_, 32 + sa) * 2048 + 1024 + g * 128 + cB); \
        nc0 = *(const bf16x8*)(xbc + (size_t)SSD_ROW(r0_, sa) * 2048 + 1536 + g * 128 + cB); nc1 = *(const bf16x8*)(xbc + (size_t)SSD_ROW(r0_, 32 + sa) * 2048 + 1536 + g * 128 + cB); \
        nx = *(const bf16x8*)(xbc + (size_t)SSD_ROW(r0_, sx) * 2048 + h * 64 + cX); ndt = dtb[(size_t)SSD_ROW(r0_, lane) * 32 + d * 16 + h]; } while (0)
#define SSD_STAGE(buf, cum2n) do { float a2_ = ndt * Aneg2; \
        _Pragma("unroll") for (int off_ = 1; off_ < 64; off_ <<= 1) { const float v_ = __shfl_up(a2_, off_); if (lane >= off_) a2_ += v_; } \
        cum2n = a2_; cumw[(buf) * 64 + lane] = a2_; const float cT_ = __shfl(a2_, 63), cs_ = __shfl(a2_, sx & 63), dts_ = __shfl(ndt, sx & 63); \
        const float w2_ = dts_ * __builtin_amdgcn_exp2f(cT_ - cs_); float x8_[8], xd_[8], xs_[8]; unpack8(__builtin_bit_cast(v4u, nx), x8_); \
        _Pragma("unroll") for (int j_ = 0; j_ < 8; ++j_) { xd_[j_] = x8_[j_] * dts_; xs_[j_] = x8_[j_] * w2_; } \
        LAS char* Bk_ = lds + (buf) * IMG; LAS char* Bv_ = lds + (2 + (buf)) * IMG; LAS char* Xv_ = lds + (4 + (buf)) * IMG; LAS char* Ck_ = lds + (6 + (buf)) * IMG; \
        *(LAS bf16x8*)(Bk_ + kst_a) = nb0; *(LAS bf16x8*)(Bk_ + kst_b) = nb1; *(LAS bf16x8*)(Bv_ + vst_a) = nb0; *(LAS bf16x8*)(Bv_ + vst_b) = nb1; \
        *(LAS bf16x8*)(Ck_ + kst_a) = nc0; *(LAS bf16x8*)(Ck_ + kst_b) = nc1; \
        *(LAS v4u*)(Xv_ + xst_d) = pack8(xd_); *(LAS v4u*)(Xv_ + xst_s) = pack8(xs_); } while (0)
    SSD_LOAD(0); SSD_STAGE(0, cum2);
    __syncthreads();
    for (int ci = 0; ci < 68; ++ci) {
        const int cur = ci & 1; const int row0 = SSD_ROW0(ci);
        if (ci + 1 < 68) SSD_LOAD(ci + 1);
        f32x16 o = {}; bf16x8 Cc[8];
        if (ywave) { bf16x8 sf[8]; const LAS char* Ck = lds + (6 + cur) * IMG;
#pragma unroll
            for (int d0 = 0; d0 < 8; ++d0) { sf[d0] = *(const LAS bf16x8*)(Ss + KSWZ128(pb * 32 + r32, (d0 * 16 + hi * 8) * 2)); Cc[d0] = *(const LAS bf16x8*)(Ck + KSWZ128(tb * 32 + r32, (d0 * 16 + hi * 8) * 2)); }
            asm volatile("s_waitcnt lgkmcnt(0)" ::: "memory"); SBAR();
#pragma unroll
            for (int d0 = 0; d0 < 8; ++d0) o = __builtin_amdgcn_mfma_f32_32x32x16_bf16(Cc[d0], sf[d0], o, 0, 0, 0); }
        __syncthreads();
        {
            const float decT = __builtin_amdgcn_exp2f(__shfl(cum2, 63));
#pragma unroll
            for (int r = 0; r < 16; ++r) sacc[r] *= decT;
            const int vbx = ldsb + (4 + cur) * IMG + rdb + (2 + pb2) * 512, vbb = ldsb + (2 + cur) * IMG + rdb + nb * 512;
            const s16x4 xl0 = trr<0>(vbx), xh0 = trr<2048>(vbx), xl1 = trr<4096>(vbx), xh1 = trr<6144>(vbx), xl2 = trr<8192>(vbx), xh2 = trr<10240>(vbx), xl3 = trr<12288>(vbx), xh3 = trr<14336>(vbx);
            const s16x4 bl0 = trr<0>(vbb), bh0 = trr<2048>(vbb), bl1 = trr<4096>(vbb), bh1 = trr<6144>(vbb), bl2 = trr<8192>(vbb), bh2 = trr<10240>(vbb), bl3 = trr<12288>(vbb), bh3 = trr<14336>(vbb);
            asm volatile("s_waitcnt lgkmcnt(0)" ::: "memory"); SBAR();
            sacc = __builtin_amdgcn_mfma_f32_32x32x16_bf16(SSD_PK(xl0, xh0), SSD_PK(bl0, bh0), sacc, 0, 0, 0);
            sacc = __builtin_amdgcn_mfma_f32_32x32x16_bf16(SSD_PK(xl1, xh1), SSD_PK(bl1, bh1), sacc, 0, 0, 0);
            sacc = __builtin_amdgcn_mfma_f32_32x32x16_bf16(SSD_PK(xl2, xh2), SSD_PK(bl2, bh2), sacc, 0, 0, 0);
            sacc = __builtin_amdgcn_mfma_f32_32x32x16_bf16(SSD_PK(xl3, xh3), SSD_PK(bl3, bh3), sacc, 0, 0, 0);
#pragma unroll
            for (int r = 0; r < 16; ++r) *(LAS bf16*)(Ss + KSWZ128(pb2 * 32 + att::crow(r, hi), (nb * 32 + r32) * 2)) = (bf16)f2bf(sacc[r]);
        }
        if (ywave) {
            const LAS float* cw = cumw + cur * 64; const LAS char* Bk = lds + cur * IMG; const int vby = ldsb + (4 + cur) * IMG + rdb + pb * 512;
#pragma unroll
            for (int r = 0; r < 16; ++r) o[r] *= __builtin_amdgcn_exp2f(cw[tb * 32 + att::crow(r, hi)]);
            const float ct = __shfl(cum2, tb * 32 + r32);
#pragma unroll
            for (int sb = 0; sb < 2; ++sb) {
                if (sb <= tb) {
                    f32x16 p = {};
#pragma unroll
                    for (int d0 = 0; d0 < 8; ++d0) { const bf16x8 kf = *(const LAS bf16x8*)(Bk + KSWZ128(sb * 32 + r32, (d0 * 16 + hi * 8) * 2)); p = __builtin_amdgcn_mfma_f32_32x32x16_bf16(kf, Cc[d0], p, 0, 0, 0); }
#pragma unroll
                    for (int r = 0; r < 16; ++r) { const int sl = att::crow(r, hi); const float w = __builtin_amdgcn_exp2f(ct - cw[sb * 32 + sl]); const float v = p[r] * w; p[r] = (sb == tb && sl > r32) ? 0.f : v; }
                    bf16x8 paA, paB;
#define PK4(P, BASE, OUT) do { unsigned a0 = att::cvtpk(P[BASE + 0], P[BASE + 1]), a1 = att::cvtpk(P[BASE + 2], P[BASE + 3]); \
    unsigned b0 = att::cvtpk(P[BASE + 4], P[BASE + 5]), b1 = att::cvtpk(P[BASE + 6], P[BASE + 7]); \
    auto r0 = __builtin_amdgcn_permlane32_swap(a0, b0, false, false); auto r1 = __builtin_amdgcn_permlane32_swap(a1, b1, false, false); \
    v4u w = {r0[0], r1[0], r0[1], r1[1]}; OUT = __builtin_bit_cast(bf16x8, w); } while (0)
                    PK4(p, 0, paA); PK4(p, 8, paB);
#undef PK4
                    s16x4 l0, h0, l1, h1;
                    if (sb == 0) { l0 = trr<0>(vby); h0 = trr<2048>(vby); l1 = trr<4096>(vby); h1 = trr<6144>(vby); }
                    else { l0 = trr<8192>(vby); h0 = trr<10240>(vby); l1 = trr<12288>(vby); h1 = trr<14336>(vby); }
                    asm volatile("s_waitcnt lgkmcnt(0)" ::: "memory"); SBAR();
                    o = __builtin_amdgcn_mfma_f32_32x32x16_bf16(paA, SSD_PK(l0, h0), o, 0, 0, 0);
                    o = __builtin_amdgcn_mfma_f32_32x32x16_bf16(paB, SSD_PK(l1, h1), o, 0, 0, 0);
                }
            }
            bf16* yp = ssdy + ((size_t)d * M) * 1024 + h * 64 + pb * 32 + r32;
#pragma unroll
            for (int r = 0; r < 16; ++r) { const int t = tb * 32 + att::crow(r, hi); yp[(size_t)SSD_ROW(row0, t) * 1024] = (bf16)f2bf(o[r]); }
        }
        if (ci + 1 < 68) { float c2n; SSD_STAGE(cur ^ 1, c2n); cum2 = c2n; }
        __syncthreads();
    }
#undef SSD_ROW0
#undef SSD_ROW
#undef SSD_LOAD
#undef SSD_STAGE
}
}
__device__ __forceinline__ void ph_ssd_mfma(ArgsRef a, Ctx C, int l) {
    const bf16* xbc = (const bf16*)(a.ws + T_XBC); const float* dtb = (const float*)(a.ws + T_DT); bf16* ssdy = (bf16*)(a.ws + T_SSDY);
    const bool split = C.G >= 256;
    if (!split || C.vcu < 128)
    for (int it = C.vcu; it < 128; it += C.G) { const int h = it & 15, d = (it >> 4) & 1, b = it >> 5;
        const float Aneg2 = -__expf(a.in[I_SALOG][(l * 2 + d) * 16 + h]) * 1.4426950408889634f;
        ssd::ssd_item(xbc, dtb, ssdy, Aneg2, b, d, h, (LAS char*)C.lds, C.tid);
        __syncthreads(); }
    if (split) { if (C.vcu >= 128) { if (C.wave == 0) for (int it = C.vcu - 128; it < 128; it += C.G - 128) lru_s2_item(a, it, C.lane);
                                     conv_e(a, C, l, (C.vcu - 128) * NWAVES + C.wave, (C.G - 128) * NWAVES); } }
    else { for (int it = C.wave * C.G + C.vcu; it < 128; it += NWAVES * C.G) lru_s2_item(a, it, C.lane); conv_e(a, C, l, C.vcu * NWAVES + C.wave, C.G * NWAVES); }
}
__device__ __forceinline__ void ph_attn(ArgsRef a, Ctx C, int l) {
    const bf16* Qr = (const bf16*)(a.ws + T_QR); const bf16* Kr = (const bf16*)(a.ws + T_KR); const bf16* p = (const bf16*)(a.ws + WS_P); bf16* otmp = (bf16*)(a.ws + T_OTMP);
    unsigned* qhead = (unsigned*)(a.ws + WS_CTL) + CW_ATTQ + 64 * l; LAS unsigned* slot = (LAS unsigned*)(C.lds + RING_BYTES + 2048);
    const int nunits = 1024 + (l == DEPTH - 1 ? 0 : 64);
    for (;;) {
        if (C.tid == 0) *slot = __hip_atomic_fetch_add(qhead, 1u, RLX_AGENT);
        __syncthreads();
        const int u = (int)__builtin_amdgcn_readfirstlane(*slot);
        __syncthreads();
        if (u >= nunits) break;
        int qb, hm, b; bool isctx;
        if (u < 1024) { qb = u & 15; hm = (u >> 4) & 15; b = u >> 8; isctx = false; } else { const int u2 = u - 1024; qb = 0; hm = u2 & 15; b = u2 >> 4; isctx = true; }
        const int qrow0 = b * LT + (isctx ? 0 : LC) + qb * 256, kv0 = b * LT, seq = isctx ? LC : LT, hh = hm >> 1, qcol = hh * 128 + (hm & 1) * 64;
        att::attn_unit(Qr + (size_t)qrow0 * 1024 + qcol, Kr + (size_t)kv0 * 1024 + qcol, p + (size_t)kv0 * NP + P_V + hh * 128, otmp + (size_t)qrow0 * 2048 + hm * 128, seq, (LAS char*)C.lds, C.tid);
    }
}
__device__ __forceinline__ void ph_mixfin(ArgsRef a, Ctx C, int l) {
    const bf16* p = (const bf16*)(a.ws + WS_P); const bf16* xbc = (const bf16*)(a.ws + T_XBC); const bf16* ssdy = (const bf16*)(a.ws + T_SSDY); const bf16* otmp = (const bf16*)(a.ws + T_OTMP);
    bf16* br1 = (bf16*)(a.ws + WS_BR) + (size_t)M * 1024; bf16* br2 = br1 + (size_t)M * 1024;
    const float* sd = a.in[I_SD] + l * 16; const float* snw = a.in[I_SNW] + l * 1024; const float* anw = a.in[I_ANW] + l * 128; const float* lv = a.in[I_ALAM] + l * 256;
    const float lam_init = 0.8f - 0.6f * __expf(-0.3f * (float)l);
    const float lam = __expf(wave_sum(lv[C.lane] * lv[64 + C.lane])) - __expf(wave_sum(lv[128 + C.lane] * lv[192 + C.lane])) + lam_init;
    ROWLOOP {
        if (l == DEPTH - 1 && (r % LT) < LC) continue;
        float v[2][8]; float ss = 0.f;
#pragma unroll
        for (int it = 0; it < 2; ++it) { const int c = it * 512 + C.lane * 8; float x8[8], yf[8], yb[8], z8[8];
            unpack8(*(const v4u*)(xbc + (size_t)r * 2048 + c), x8); unpack8(*(const v4u*)(ssdy + (size_t)r * 1024 + c), yf); unpack8(*(const v4u*)(ssdy + ((size_t)M + r) * 1024 + c), yb);
            unpack8(*(const v4u*)(p + (size_t)r * NP + P_Z + c), z8); const float Dh = sd[c >> 6];
#pragma unroll
            for (int j = 0; j < 8; ++j) { const float y = Dh * x8[j] + yf[j] + yb[j]; const float vv = y * siluf_(z8[j]); v[it][j] = vv; ss += vv * vv; } }
        ss = wave_sum(ss); const float sc = 1.f / sqrtf(ss * (1.f / 1024.f) + LN_EPS);
#pragma unroll
        for (int it = 0; it < 2; ++it) { const int c = it * 512 + C.lane * 8; float o8[8];
#pragma unroll
            for (int j = 0; j < 8; ++j) o8[j] = v[it][j] * sc * snw[c + j];
            *(v4u*)(br1 + (size_t)r * 1024 + c) = pack8(o8); }
        const int hh = C.lane >> 3, d0 = (C.lane & 7) * 16; float od[16]; float s2 = 0.f;
#pragma unroll
        for (int hf = 0; hf < 2; ++hf) { float o0[8], o1[8]; unpack8(*(const v4u*)(otmp + (size_t)r * 2048 + (2 * hh) * 128 + d0 + hf * 8), o0); unpack8(*(const v4u*)(otmp + (size_t)r * 2048 + (2 * hh + 1) * 128 + d0 + hf * 8), o1);
#pragma unroll
            for (int j = 0; j < 8; ++j) { const float o = o0[j] - lam * o1[j]; od[hf * 8 + j] = o; s2 += o * o; } }
        s2 = sum8(s2);
        const float sc2 = (1.f - lam_init) / sqrtf(s2 * (1.f / 128.f) + LN_EPS);
#pragma unroll
        for (int hf = 0; hf < 2; ++hf) { float o8[8];
#pragma unroll
            for (int j = 0; j < 8; ++j) o8[j] = od[hf * 8 + j] * sc2 * anw[d0 + hf * 8 + j];
            *(v4u*)(br2 + (size_t)r * 1024 + hh * 128 + d0 + hf * 8) = pack8(o8); }
    }
}
struct RouteOut { int e0, e1; float w0, w1; };
__device__ __forceinline__ void lnmid_norms(f32x4 (&v)[8], float* xdst, bf16* hrow, const float* lng, const float* lnb, const float* sh, const float* sc, int lane) {
    float s = 0.f, q = 0.f;
#pragma unroll
    for (int jj = 0; jj < 8; ++jj) { s += (v[jj].x + v[jj].y) + (v[jj].z + v[jj].w); q += (v[jj].x * v[jj].x + v[jj].y * v[jj].y) + (v[jj].z * v[jj].z + v[jj].w * v[jj].w); }
    s = wave_sum(s); q = wave_sum(q);
    float mean = s * (1.f / D), rstd = 1.f / sqrtf(fmaxf(q * (1.f / D) - mean * mean, 0.f) + LN_EPS); s = 0.f; q = 0.f;
#pragma unroll
    for (int jj = 0; jj < 8; ++jj) { const int c = lane + 64 * jj; v[jj] = (v[jj] - mean) * rstd * ((const f32x4*)lng)[c] + ((const f32x4*)lnb)[c]; ((f32x4*)xdst)[c] = v[jj];
        s += (v[jj].x + v[jj].y) + (v[jj].z + v[jj].w); q += (v[jj].x * v[jj].x + v[jj].y * v[jj].y) + (v[jj].z * v[jj].z + v[jj].w * v[jj].w); }
    s = wave_sum(s); q = wave_sum(q);
    mean = s * (1.f / D); rstd = 1.f / sqrtf(fmaxf(q * (1.f / D) - mean * mean, 0.f) + LN_EPS);
    unsigned long long* o8 = (unsigned long long*)hrow;
#pragma unroll
    for (int jj = 0; jj < 8; ++jj) { const int c = lane + 64 * jj; v[jj] = (v[jj] - mean) * rstd * (((const f32x4*)sc)[c] + 1.f) + ((const f32x4*)sh)[c];
        o8[c] = (unsigned long long)pk2(v[jj].x, v[jj].y) | ((unsigned long long)pk2(v[jj].z, v[jj].w) << 32); }
}
__device__ __forceinline__ RouteOut route_pick(const float (&lg)[16], const float* rb) {
    float mx = lg[0];
#pragma unroll
    for (int e = 1; e < 16; ++e) mx = fmaxf(mx, lg[e]);
    float sm = 0.f, scs[16], sel[16];
#pragma unroll
    for (int e = 0; e < 16; ++e) { scs[e] = __expf(lg[e] - mx); sm += scs[e]; }
    const float ism = 1.f / sm;
#pragma unroll
    for (int e = 0; e < 16; ++e) { scs[e] *= ism; sel[e] = scs[e] + rb[e]; }
    int gbest = 0, i0b = 0, i1b = 0; float gsb = -1e30f;
#pragma unroll
    for (int g = 0; g < 4; ++g) { float best = sel[4 * g]; int bi = 0;
#pragma unroll
        for (int i = 1; i < 4; ++i) if (sel[4 * g + i] > best) { best = sel[4 * g + i]; bi = i; }
        float sb = -1e30f; int si = 0;
#pragma unroll
        for (int i = 0; i < 4; ++i) if (i != bi && sel[4 * g + i] > sb) { sb = sel[4 * g + i]; si = i; }
        const float gs = best + sb;
        if (gs > gsb) { gsb = gs; gbest = g; i0b = bi; i1b = si; } }
    RouteOut o; o.e0 = gbest * 4 + i0b; o.e1 = gbest * 4 + i1b; float w0 = 0.f, w1 = 0.f;
#pragma unroll
    for (int e = 0; e < 16; ++e) { w0 = (e == o.e0) ? scs[e] : w0; w1 = (e == o.e1) ? scs[e] : w1; }
    const float iw = 1.f / (w0 + w1); o.w0 = w0 * iw; o.w1 = w1 * iw;
    return o;
}
__device__ __forceinline__ void ph_lnmid(ArgsRef a, Ctx C, int l) {
    LAS float* wt = (LAS float*)C.lds;
    LAS unsigned* cnt = (LAS unsigned*)(C.lds + RING_BYTES + 1024); LAS unsigned* base = cnt + 16; LAS unsigned* park = cnt + 64;
    const float* wr = a.in[I_WR];
    for (int i = C.tid; i < D * NE; i += NTHR) wt[(i & 15) * D + (i >> 4)] = wr[i];
    if (C.tid < 16) cnt[C.tid] = 0u;
    __syncthreads();
    const float* y = (const float*)(a.ws + T_MACC); float* xs_ctx = (float*)(a.ws + WS_XSCTX); bf16* h = (bf16*)(a.ws + WS_H);
    const float* mod = (const float*)(a.ws + WS_MOD) + (size_t)l * 5 * NADA; const float* lng = a.in[I_LNG] + (size_t)(l * 2) * D; const float* lnb = a.in[I_LNB] + (size_t)(l * 2) * D;
    const float* rb = a.in[I_RB];
    int* tok_e = (int*)(a.ws + WS_ROUTE); float* tok_w = (float*)(tok_e + 2 * M); int* tok_idx = (int*)(tok_w + 2 * M);
    const int nrows = (l == DEPTH - 1) ? NB * LL : M, rstep = C.G * NWAVES;
#define LNM_ROW(i) ((l == DEPTH - 1) ? ((i) >> 12) * LT + LC + ((i) & 4095) : (i))
#define LNM_COMMIT(r_, o_) do { const unsigned x0 = __hip_atomic_fetch_add(&cnt[(o_).e0], 1u, __ATOMIC_RELAXED, __HIP_MEMORY_SCOPE_WORKGROUP), x1 = __hip_atomic_fetch_add(&cnt[(o_).e1], 1u, __ATOMIC_RELAXED, __HIP_MEMORY_SCOPE_WORKGROUP); \
        tok_e[2 * (r_)] = (o_).e0; tok_e[2 * (r_) + 1] = (o_).e1; tok_w[2 * (r_)] = (o_).w0; tok_w[2 * (r_) + 1] = (o_).w1; \
        LAS unsigned* pk = park + (C.wave * 16 + nrow) * 4; pk[0] = (unsigned)(o_).e0; pk[1] = (unsigned)(o_).e1; pk[2] = x0; pk[3] = x1; ++nrow; } while (0)
    int nrow = 0;
    for (int ri = C.vcu * NWAVES + C.wave; ri < nrows; ri += 2 * rstep) {
        const bool has2 = ri + rstep < nrows; const int r1 = LNM_ROW(ri), r2 = has2 ? LNM_ROW(ri + rstep) : r1;
        const int b1 = r1 / LT, j1 = r1 - b1 * LT, b2 = r2 / LT, j2 = r2 - b2 * LT; const bool c1 = j1 < LC, c2 = j2 < LC;
        f32x4 v1[8], v2[8];
#pragma unroll
        for (int jj = 0; jj < 8; ++jj) { v1[jj] = ((const f32x4*)(y + (size_t)r1 * D))[C.lane + 64 * jj]; v2[jj] = ((const f32x4*)(y + (size_t)r2 * D))[C.lane + 64 * jj]; }
        const float* sh1 = mod + (size_t)(c1 ? 4 : b1) * NADA + 3 * D; const float* sh2 = mod + (size_t)(c2 ? 4 : b2) * NADA + 3 * D;
        lnmid_norms(v1, c1 ? xs_ctx + ((size_t)b1 * LC + j1) * D : a.out + ((size_t)b1 * LL + (j1 - LC)) * D, h + (size_t)r1 * D, lng, lnb, sh1, sh1 + D, C.lane);
        lnmid_norms(v2, c2 ? xs_ctx + ((size_t)b2 * LC + j2) * D : a.out + ((size_t)b2 * LL + (j2 - LC)) * D, h + (size_t)r2 * D, lng, lnb, sh2, sh2 + D, C.lane);
        float lg1[16], lg2[16];
#pragma unroll
        for (int e = 0; e < 16; ++e) { float a1 = 0.f, a2 = 0.f;
#pragma unroll
            for (int jj = 0; jj < 8; ++jj) { const f32x4 w = *(const LAS f32x4*)(wt + e * D + (C.lane + 64 * jj) * 4);
                a1 += (v1[jj].x * w.x + v1[jj].y * w.y) + (v1[jj].z * w.z + v1[jj].w * w.w); a2 += (v2[jj].x * w.x + v2[jj].y * w.y) + (v2[jj].z * w.z + v2[jj].w * w.w); }
            lg1[e] = wave_sum(a1); lg2[e] = wave_sum(a2);
            if (e & 1) asm volatile("" ::: "memory"); }
        const RouteOut o1 = route_pick(lg1, rb), o2 = route_pick(lg2, rb);
        if (C.lane == 0) { LNM_COMMIT(r1, o1); if (has2) LNM_COMMIT(r2, o2); }
    }
    __syncthreads();
    if (C.tid < 16) base[C.tid] = __hip_atomic_fetch_add((unsigned*)(a.ws + WS_CTL) + CW_GCNT + l * 16 + C.tid, cnt[C.tid], RLX_AGENT);
    __syncthreads();
    { int n2 = 0;
      for (int ri = C.vcu * NWAVES + C.wave; ri < nrows; ri += rstep) { const int r = LNM_ROW(ri);
          if (C.lane == 0) { const LAS unsigned* pk = park + (C.wave * 16 + n2) * 4; tok_idx[2 * r] = (int)(pk[2] + base[pk[0] & 15u]); tok_idx[2 * r + 1] = (int)(pk[3] + base[pk[1] & 15u]); }
          ++n2; } }
#undef LNM_ROW
#undef LNM_COMMIT
}
__device__ __forceinline__ void ph_gather(ArgsRef a, Ctx C, int l) {
    LAS int* offs = (LAS int*)(C.lds + RING_BYTES + 1024);
    unsigned* ctl = (unsigned*)(a.ws + WS_CTL);
    LAS int* cnts = offs + 32;
    if (C.tid < 16) cnts[C.tid] = (int)__hip_atomic_load(ctl + CW_GCNT + l * 16 + C.tid, RLX_AGENT);
    __syncthreads();
    if (C.tid == 0) { int o = 0;
        for (int e = 0; e < 16; ++e) { offs[e] = o; o += ((cnts[e] + 127) >> 7) * 128; }
        offs[16] = o; if (blockIdx.x == 0) ctl[CW_NMT + l] = (unsigned)(o >> 7); }
    __syncthreads();
    if (blockIdx.x == 0) { const int nt = offs[16] >> 7;
        for (int t = C.tid; t < nt; t += NTHR) { int e = 0;
#pragma unroll
            for (int k = 1; k < 16; ++k) e += (t * 128 >= offs[k]) ? 1 : 0;
            ctl[CW_TILEE + l * 512 + t] = (unsigned)e; } }
    const int* tok_e = (const int*)(a.ws + WS_ROUTE); const int* tok_idx = tok_e + 4 * M; int* tok_pos = (int*)tok_e + 6 * M;
    const bf16* h = (const bf16*)(a.ws + WS_H); unsigned char* Xg = a.ws + WS_XG;
    const int gw = C.vcu * NWAVES + C.wave, NGW = C.G * NWAVES;
    int mypos = -1;
    { const int r = gw + (C.lane >> 1) * NGW, k = C.lane & 1;
      if (C.lane < 18 && r < M && !(l == DEPTH - 1 && (r % LT) < LC)) { const int e = tok_e[2 * r + k] & 15, idx = tok_idx[2 * r + k]; int pos = offs[e] + idx; pos = pos < 0 ? 0 : (pos >= MOE_ROWS ? MOE_ROWS - 1 : pos);
          tok_pos[2 * r + k] = pos; mypos = pos; } }
    v4u cur[4], nxt[4];
    { const int r0 = gw; if (r0 < M) {
#pragma unroll
        for (int q = 0; q < 4; ++q) nxt[q] = ((const v4u*)(h + (size_t)r0 * D))[C.lane + 64 * q]; } }
#pragma unroll 1
    for (int j = 0; j < 9; ++j) { const int r = gw + j * NGW; if (r >= M) break;
#pragma unroll
        for (int q = 0; q < 4; ++q) cur[q] = nxt[q];
        if (r + NGW < M) {
#pragma unroll
            for (int q = 0; q < 4; ++q) nxt[q] = ((const v4u*)(h + (size_t)(r + NGW) * D))[C.lane + 64 * q]; }
        const int p0 = __shfl(mypos, 2 * j), p1 = __shfl(mypos, 2 * j + 1);
        if (p0 < 0) continue;
        v2u* d0 = (v2u*)(Xg + (size_t)p0 * D); v2u* d1 = (v2u*)(Xg + (size_t)p1 * D);
#pragma unroll
        for (int q = 0; q < 4; ++q) { float x8[8]; unpack8(cur[q], x8); const v2u w = pack8_fp8(x8); d0[C.lane + 64 * q] = w; d1[C.lane + 64 * q] = w; }
    }
    __syncthreads();
}
__device__ __forceinline__ void ph_final(ArgsRef a, Ctx C, int l) {
    const int* tok_pos = (const int*)(a.ws + WS_ROUTE) + 6 * M; const float* tok_w = (const float*)(a.ws + WS_ROUTE) + 2 * M;
    const bf16* fs = (const bf16*)(a.ws + WS_FS); float* xs_ctx = (float*)(a.ws + WS_XSCTX);
    const float* mod = (const float*)(a.ws + WS_MOD) + (size_t)l * 5 * NADA; const float* lng = a.in[I_LNG] + (size_t)(l * 2 + 1) * D; const float* lnb = a.in[I_LNB] + (size_t)(l * 2 + 1) * D;
    const int nrows = (l == DEPTH - 1) ? NB * LL : M, rstep = C.G * NWAVES;
#define FIN_ROW(i) ((l == DEPTH - 1) ? ((i) >> 12) * LT + LC + ((i) & 4095) : (i))
#define FIN_XROW(r_) (((r_) % LT) < LC ? xs_ctx + ((size_t)((r_) / LT) * LC + ((r_) % LT)) * D : a.out + ((size_t)((r_) / LT) * LL + (((r_) % LT) - LC)) * D)
    f32x4 xn[8]; v2u f0n[8], f1n[8]; float w0n = 0.f, w1n = 0.f; int ri = C.vcu * NWAVES + C.wave;
#define FIN_LOAD(i) do { const int r_ = FIN_ROW(i); const float* xr_ = FIN_XROW(r_); const v2u* p0_ = (const v2u*)(fs + (size_t)tok_pos[2 * r_] * D); const v2u* p1_ = (const v2u*)(fs + (size_t)tok_pos[2 * r_ + 1] * D); \
        w0n = tok_w[2 * r_]; w1n = tok_w[2 * r_ + 1]; \
        _Pragma("unroll") for (int jj = 0; jj < 8; ++jj) { const int q = C.lane + 64 * jj; xn[jj] = ((const f32x4*)xr_)[q]; f0n[jj] = p0_[q]; f1n[jj] = p1_[q]; } } while (0)
    if (ri < nrows) FIN_LOAD(ri);
    for (; ri < nrows; ri += rstep) { const int r = FIN_ROW(ri); const int b = r / LT, j = r - b * LT; const bool isctx = j < LC;
        float* xrow = isctx ? xs_ctx + ((size_t)b * LC + j) * D : a.out + ((size_t)b * LL + (j - LC)) * D;
        const float* g2 = mod + (size_t)(isctx ? 4 : b) * NADA + 5 * D;
        f32x4 v[8]; float s = 0.f, s2 = 0.f; const float w0 = w0n, w1 = w1n;
#pragma unroll
        for (int jj = 0; jj < 8; ++jj) { const int q = C.lane + 64 * jj; const v2u a0 = f0n[jj], a1 = f1n[jj];
            const f32x4 f = (f32x4){bflo(a0.x), bfhi(a0.x), bflo(a0.y), bfhi(a0.y)} * w0 + (f32x4){bflo(a1.x), bfhi(a1.x), bflo(a1.y), bfhi(a1.y)} * w1;
            v[jj] = xn[jj] * DN_ALPHA + ((const f32x4*)g2)[q] * f; s += (v[jj].x + v[jj].y) + (v[jj].z + v[jj].w); s2 += (v[jj].x * v[jj].x + v[jj].y * v[jj].y) + (v[jj].z * v[jj].z + v[jj].w * v[jj].w); }
        if (ri + rstep < nrows) FIN_LOAD(ri + rstep);
        const float mean = wave_sum(s) * (1.f / D), rstd = 1.f / sqrtf(fmaxf(wave_sum(s2) * (1.f / D) - mean * mean, 0.f) + LN_EPS);
        float s3 = 0.f, s4 = 0.f;
#pragma unroll
        for (int jj = 0; jj < 8; ++jj) { const int q = C.lane + 64 * jj; v[jj] = (v[jj] - mean) * rstd * ((const f32x4*)lng)[q] + ((const f32x4*)lnb)[q]; ((f32x4*)xrow)[q] = v[jj];
            s3 += (v[jj].x + v[jj].y) + (v[jj].z + v[jj].w); s4 += (v[jj].x * v[jj].x + v[jj].y * v[jj].y) + (v[jj].z * v[jj].z + v[jj].w * v[jj].w); }
        if (l < DEPTH - 1) {
            const float* sh = mod + (size_t)5 * NADA + (size_t)(isctx ? 4 : b) * NADA; const float* sc = sh + D;
            const float mean2 = wave_sum(s3) * (1.f / D), rstd2 = 1.f / sqrtf(fmaxf(wave_sum(s4) * (1.f / D) - mean2 * mean2, 0.f) + LN_EPS);
            unsigned long long* o8 = (unsigned long long*)((bf16*)(a.ws + WS_H) + (size_t)r * D);
#pragma unroll
            for (int jj = 0; jj < 8; ++jj) { const int q = C.lane + 64 * jj; const f32x4 o = (v[jj] - mean2) * rstd2 * (((const f32x4*)sc)[q] + 1.f) + ((const f32x4*)sh)[q];
                o8[q] = (unsigned long long)pk2(o.x, o.y) | ((unsigned long long)pk2(o.z, o.w) << 32); } }
    }
#undef FIN_LOAD
#undef FIN_ROW
#undef FIN_XROW
}

constexpr int NPL = 15, NPH = 2 + DEPTH * NPL;
__global__ void __launch_bounds__(NTHR, 2) fwd(Args args) {
    extern __shared__ __attribute__((aligned(16))) unsigned char lds_raw[];
    Ctx C; C.lds = (LAS unsigned char*)lds_raw; C.tid = threadIdx.x; C.lane = C.tid & 63; C.wave = __builtin_amdgcn_readfirstlane(C.tid >> 6);
    C.G = gridDim.x; { const int bx = blockIdx.x; C.vcu = (C.G % 8 == 0) ? (bx % 8) * (C.G / 8) + bx / 8 : bx; }
    for (int u = C.tid; u < (LDS_BYTES - RING_BYTES) / 4; u += NTHR) ((LAS unsigned*)(C.lds + RING_BYTES))[u] = 0u;
    __syncthreads();
    const __attribute__((address_space(4))) Args* kargs = (const __attribute__((address_space(4))) Args*)__builtin_amdgcn_kernarg_segment_ptr();
    unsigned* ctl0 = (unsigned*)(kargs->ws + WS_CTL);
    XcdBarrier bar; bar.bar = ctl0 + CW_BAR; bar.x = 0; bar.st = nullptr;
    if (MK_N_LAUNCHES == 1) bar = xcd_barrier_post(ctl0 + CW_BAR, (volatile LAS unsigned*)(C.lds + MISC_OFF) + 8);
    const int lo = kargs->ph_lo, hi = kargs->ph_hi;
#ifndef PHMASK
#define PHMASK 0xFFFFFFFFu
#endif
#define EN(k) ((PHMASK >> (k)) & 1u)
#define IN(k) (lo <= (k) && (k) < hi)
#define SEAM(k) do { if (MK_N_LAUNCHES == 1 && IN(k) && IN((k) + 1)) xcd_barrier(bar); } while (0)
    const int cblk = (int)blockIdx.x;
#define PH_CTX Ctx Cq = C; { int t_ = C.tid; asm volatile("" : "+v"(t_)); Cq.tid = t_; Cq.lane = t_ & 63; Cq.wave = __builtin_amdgcn_readfirstlane(t_ >> 6); } \
    const __attribute__((address_space(4))) Args* ap_ = kargs; asm volatile("" : "+s"(ap_)); ArgsRef A = *ap_; unsigned char* ws = A.ws; unsigned* ctl = (unsigned*)(ws + WS_CTL); (void)ctl

    if (EN(0) && IN(0)) { PH_CTX; ph_modp(A, Cq); ph_conva(A, Cq, 0); }
    SEAM(0);
    if (EN(1) && IN(1)) { PH_CTX; ph_modr(A, Cq); }
    SEAM(1);
    { constexpr int l = 0; constexpr int pb = 2 + l * NPL;
        if (l == 0) { if (EN(2) && IN(pb + 0)) { PH_CTX; ph_ln1(A, Cq, l); } SEAM(pb + 0); }
        if (EN(3) && IN(pb + 1)) {
            PH_CTX;
            const pg8::Gemm g{D, D, D}; const SchedIn S{Cq.G, cblk, l == DEPTH - 1, (const char*)(ws + WS_H), (const char*)(ws + WS_WIN)};
            const EpiP E{(bf16*)(ws + WS_P)};
            pg8::gemm_phase<EpiP, SchedIn, true, true>(Cq.lds, Cq.tid, g, S, E); }
        SEAM(pb + 1);
        if (EN(4) && IN(pb + 2)) { PH_CTX; ph_prep(A, Cq, l); }
        SEAM(pb + 2);
        if (EN(5) && IN(pb + 3)) {
            PH_CTX;
            const pg8::Gemm g{256, 1024, 256}; const SchedLru S{Cq.G, cblk, (const char*)(ws + T_XC), (const char*)(ws + WS_WG)};
            const EpiLru E{(const bf16*)(ws + T_XC), A.in[I_LGB] + (size_t)l * 4096, A.in[I_LLAM] + (size_t)l * 2048, (bf16*)(ws + T_LA), (bf16*)(ws + T_BB)};
            pg8::gemm_phase<EpiLru, SchedLru, false, true>(Cq.lds, Cq.tid, g, S, E); }
        SEAM(pb + 3);
        if (EN(6) && IN(pb + 4)) { PH_CTX; ph_lru_s1(A, Cq); }
        SEAM(pb + 4);
        if (EN(7) && IN(pb + 5)) { PH_CTX; ph_ssd_mfma(A, Cq, l); }
        if (EN(8) && IN(pb + 5)) { PH_CTX; __syncthreads(); ph_attn(A, Cq, l); }
        SEAM(pb + 5);
        if (EN(9) && IN(pb + 7)) { PH_CTX; ph_lru_s3(A, Cq, l); ph_mixfin(A, Cq, l); }
        SEAM(pb + 7);
        if (EN(10) && IN(pb + 8)) {
            PH_CTX;
            const pg8::Gemm g{1024, 1024, 1024}; const SchedMerge S{Cq.G, cblk, (const char*)(ws + WS_BR), (const char*)(ws + WS_WBR), l == DEPTH - 1};
            const EpiMerge E{(const bf16*)(ws + WS_P), (bf16*)(ws + T_MB)};
            pg8::gemm_phase<EpiMerge, SchedMerge, true, true>(Cq.lds, Cq.tid, g, S, E); }
        SEAM(pb + 8);
        if (EN(11) && IN(pb + 9)) {
            PH_CTX;
            const pg8::Gemm g{D, D, D}; const SchedPlain S{l == DEPTH - 1 ? 64 : M / 256, D / 256, Cq.G, cblk, (const char*)(ws + T_MB), (const char*)(ws + WS_WOUT), (size_t)256 * D * 2, (size_t)256 * D * 2, l == DEPTH - 1};
            const EpiWout E{l == 0 ? A.in[I_X] : A.out, l == 0 ? A.in[I_CTX] : (const float*)(ws + WS_XSCTX), (const float*)(ws + WS_MOD) + (size_t)l * 5 * NADA + 2 * D, (float*)(ws + T_MACC)};
            pg8::gemm_phase<EpiWout, SchedPlain, true, true>(Cq.lds, Cq.tid, g, S, E); }
        SEAM(pb + 9);
        if (EN(12) && IN(pb + 10)) { PH_CTX; ph_lnmid(A, Cq, l); }
        SEAM(pb + 10);
        if (EN(13) && IN(pb + 11)) { PH_CTX; ph_gather(A, Cq, l); }
        SEAM(pb + 11);
        if (EN(14) && IN(pb + 12)) {
            PH_CTX;
            int nmt = (int)__builtin_amdgcn_readfirstlane(__hip_atomic_load(ctl + CW_NMT + l, RLX_AGENT)); nmt = nmt > MOE_TILES ? MOE_TILES : nmt;
            const pg8::Gemm g{D / 2, D / 2, D / 2}; const SchedMoe S{nmt, 11, Cq.G, cblk, (const char*)(ws + WS_XG), (const char*)(ws + WS_EGU), (size_t)128 * D, (size_t)2816 * D, (size_t)256 * D, ctl + CW_TILEE + l * 512};
            const EpiMoe1 E{ws + WS_ACT};
            pg8::gemm_phase<EpiMoe1, SchedMoe, true, true, true, true>(Cq.lds, Cq.tid, g, S, E); }
        SEAM(pb + 12);
        if (EN(15) && IN(pb + 13)) {
            PH_CTX;
            int nmt = (int)__builtin_amdgcn_readfirstlane(__hip_atomic_load(ctl + CW_NMT + l, RLX_AGENT)); nmt = nmt > MOE_TILES ? MOE_TILES : nmt;
            const pg8::Gemm g{DEP / 2, DEP / 2, DEP / 2}; const SchedMoe S{nmt, 8, Cq.G, cblk, (const char*)(ws + WS_ACT), (const char*)(ws + WS_ED), (size_t)128 * DEP, (size_t)D * DEP, (size_t)256 * DEP, ctl + CW_TILEE + l * 512};
            const EpiMoe2 E{(bf16*)(ws + WS_FS)};
            pg8::gemm_phase<EpiMoe2, SchedMoe, true, true, true, true>(Cq.lds, Cq.tid, g, S, E); }
        SEAM(pb + 13);
        if (EN(16) && IN(pb + 14)) { PH_CTX; ph_final(A, Cq, l); if (l < DEPTH - 1) ph_conva(A, Cq, l + 1); }
        if (l < DEPTH - 1) SEAM(pb + 14);
    }
    { constexpr int l = 1; constexpr int pb = 2 + l * NPL;
        if (l == 0) { if (EN(2) && IN(pb + 0)) { PH_CTX; ph_ln1(A, Cq, l); } SEAM(pb + 0); }
        if (EN(3) && IN(pb + 1)) {
            PH_CTX;
            const pg8::Gemm g{D, D, D}; const SchedIn S{Cq.G, cblk, l == DEPTH - 1, (const char*)(ws + WS_H), (const char*)(ws + WS_WIN)};
            const EpiP E{(bf16*)(ws + WS_P)};
            pg8::gemm_phase<EpiP, SchedIn, true, true>(Cq.lds, Cq.tid, g, S, E); }
        SEAM(pb + 1);
        if (EN(4) && IN(pb + 2)) { PH_CTX; ph_prep(A, Cq, l); }
        SEAM(pb + 2);
        if (EN(5) && IN(pb + 3)) {
            PH_CTX;
            const pg8::Gemm g{256, 1024, 256}; const SchedLru S{Cq.G, cblk, (const char*)(ws + T_XC), (const char*)(ws + WS_WG)};
            const EpiLru E{(const bf16*)(ws + T_XC), A.in[I_LGB] + (size_t)l * 4096, A.in[I_LLAM] + (size_t)l * 2048, (bf16*)(ws + T_LA), (bf16*)(ws + T_BB)};
            pg8::gemm_phase<EpiLru, SchedLru, false, true>(Cq.lds, Cq.tid, g, S, E); }
        SEAM(pb + 3);
        if (EN(6) && IN(pb + 4)) { PH_CTX; ph_lru_s1(A, Cq); }
        SEAM(pb + 4);
        if (EN(7) && IN(pb + 5)) { PH_CTX; ph_ssd_mfma(A, Cq, l); }
        if (EN(8) && IN(pb + 5)) { PH_CTX; __syncthreads(); ph_attn(A, Cq, l); }
        SEAM(pb + 5);
        if (EN(9) && IN(pb + 7)) { PH_CTX; ph_lru_s3(A, Cq, l); ph_mixfin(A, Cq, l); }
        SEAM(pb + 7);
        if (EN(10) && IN(pb + 8)) {
            PH_CTX;
            const pg8::Gemm g{1024, 1024, 1024}; const SchedMerge S{Cq.G, cblk, (const char*)(ws + WS_BR), (const char*)(ws + WS_WBR), l == DEPTH - 1};
            const EpiMerge E{(const bf16*)(ws + WS_P), (bf16*)(ws + T_MB)};
            pg8::gemm_phase<EpiMerge, SchedMerge, true, true>(Cq.lds, Cq.tid, g, S, E); }
        SEAM(pb + 8);
        if (EN(11) && IN(pb + 9)) {
            PH_CTX;
            const pg8::Gemm g{D, D, D}; const SchedPlain S{l == DEPTH - 1 ? 64 : M / 256, D / 256, Cq.G, cblk, (const char*)(ws + T_MB), (const char*)(ws + WS_WOUT), (size_t)256 * D * 2, (size_t)256 * D * 2, l == DEPTH - 1};
            const EpiWout E{l == 0 ? A.in[I_X] : A.out, l == 0 ? A.in[I_CTX] : (const float*)(ws + WS_XSCTX), (const float*)(ws + WS_MOD) + (size_t)l * 5 * NADA + 2 * D, (float*)(ws + T_MACC)};
            pg8::gemm_phase<EpiWout, SchedPlain, true, true>(Cq.lds, Cq.tid, g, S, E); }
        SEAM(pb + 9);
        if (EN(12) && IN(pb + 10)) { PH_CTX; ph_lnmid(A, Cq, l); }
        SEAM(pb + 10);
        if (EN(13) && IN(pb + 11)) { PH_CTX; ph_gather(A, Cq, l); }
        SEAM(pb + 11);
        if (EN(14) && IN(pb + 12)) {
            PH_CTX;
            int nmt = (int)__builtin_amdgcn_readfirstlane(__hip_atomic_load(ctl + CW_NMT + l, RLX_AGENT)); nmt = nmt > MOE_TILES ? MOE_TILES : nmt;
            const pg8::Gemm g{D / 2, D / 2, D / 2}; const SchedMoe S{nmt, 11, Cq.G, cblk, (const char*)(ws + WS_XG), (const char*)(ws + WS_EGU), (size_t)128 * D, (size_t)2816 * D, (size_t)256 * D, ctl + CW_TILEE + l * 512};
            const EpiMoe1 E{ws + WS_ACT};
            pg8::gemm_phase<EpiMoe1, SchedMoe, true, true, true, true>(Cq.lds, Cq.tid, g, S, E); }
        SEAM(pb + 12);
        if (EN(15) && IN(pb + 13)) {
            PH_CTX;
            int nmt = (int)__builtin_amdgcn_readfirstlane(__hip_atomic_load(ctl + CW_NMT + l, RLX_AGENT)); nmt = nmt > MOE_TILES ? MOE_TILES : nmt;
            const pg8::Gemm g{DEP / 2, DEP / 2, DEP / 2}; const SchedMoe S{nmt, 8, Cq.G, cblk, (const char*)(ws + WS_ACT), (const char*)(ws + WS_ED), (size_t)128 * DEP, (size_t)D * DEP, (size_t)256 * DEP, ctl + CW_TILEE + l * 512};
            const EpiMoe2 E{(bf16*)(ws + WS_FS)};
            pg8::gemm_phase<EpiMoe2, SchedMoe, true, true, true, true>(Cq.lds, Cq.tid, g, S, E); }
        SEAM(pb + 13);
        if (EN(16) && IN(pb + 14)) { PH_CTX; ph_final(A, Cq, l); if (l < DEPTH - 1) ph_conva(A, Cq, l + 1); }
        if (l < DEPTH - 1) SEAM(pb + 14);
    }
#undef IN
#undef SEAM
}

extern "C" void kernel_launch(void* const* d_in, const int* in_sizes, int n_in, void* d_out, int out_size, void* d_ws, size_t ws_size, hipStream_t stream) {
    static int grid = 0;
    if (grid == 0) {
        if (n_in != 29 || out_size != NB * LL * D || ws_size < WS_END) { fprintf(stderr, "kernel_launch: unexpected shapes: n_in %d out %d ws %zu (need %zu)\n", n_in, out_size, ws_size, (size_t)WS_END); grid = -1; return; }
        int dev = 0, cus = 0, per_cu = 0;
        if (hipGetDevice(&dev) != hipSuccess || hipDeviceGetAttribute(&cus, hipDeviceAttributeMultiprocessorCount, dev) != hipSuccess) { grid = -1; return; }
        if (hipFuncSetAttribute((const void*)fwd, hipFuncAttributeMaxDynamicSharedMemorySize, LDS_BYTES) != hipSuccess) { fprintf(stderr, "kernel_launch: hipFuncSetAttribute failed\n"); grid = -1; return; }
        if (hipOccupancyMaxActiveBlocksPerMultiprocessor(&per_cu, (const void*)fwd, NTHR, LDS_BYTES) != hipSuccess || per_cu < 1) fprintf(stderr, "kernel_launch: occupancy query says %d\n", per_cu);
        (void)hipGetLastError();
        grid = cus;
    }
    if (grid < 0) return;
    if (hipMemsetAsync((char*)d_ws + WS_CTL, 0, CTL_ZERO_BYTES, stream) != hipSuccess) return;
    Args a{};
    for (int i = 0; i < 29; ++i) a.in[i] = (const float*)d_in[i];
    a.out = (float*)d_out; a.ws = (unsigned char*)d_ws; a.li = 0; a.pad = 0;
    if (MK_N_LAUNCHES == 1) { a.ph_lo = 0; a.ph_hi = NPH; hipLaunchKernelGGL(fwd, dim3(grid), dim3(NTHR), LDS_BYTES, stream, a); }
    else for (int k = 0; k < NPH; ++k) { a.ph_lo = k; a.ph_hi = k + 1; hipLaunchKernelGGL(fwd, dim3(grid), dim3(NTHR), LDS_BYTES, stream, a);
#ifdef REPMASK
        { const int bit = k < 2 ? k : 2 + (k - 2) % NPL; if ((REPMASK >> bit) & 1u) hipLaunchKernelGGL(fwd, dim3(grid), dim3(NTHR), LDS_BYTES, stream, a); }
#endif
    }
    const hipError_t le = hipPeekAtLastError();
    if (le != hipSuccess) fprintf(stderr, "kernel_launch: launch failed: %s\n", hipGetErrorName(le));
}
```

```cpp
#include <hip/hip_runtime.h>
#include <cstdio>
#include <cstdint>

#define GAS __attribute__((address_space(1)))
#define LAS __attribute__((address_space(3)))
typedef unsigned short bf16;
typedef unsigned v4u __attribute__((ext_vector_type(4)));
typedef unsigned v2u __attribute__((ext_vector_type(2)));
typedef float f32x4 __attribute__((ext_vector_type(4)));
typedef float f32x2 __attribute__((ext_vector_type(2)));
typedef short bf16x8 __attribute__((ext_vector_type(8)));
typedef GAS unsigned gu32;

#ifndef MK_N_LAUNCHES
#define MK_N_LAUNCHES 1
#endif

constexpr int NB = 4, LC = 256, LL = 4096, LT = LC + LL, M = NB * LT;
constexpr int D = 2048, NADA = 6 * D, DEPTH = 2;
constexpr int DIN = 14368, NP = 14592;
constexpr int P_LRUX = 0, P_LRUG = 1024, P_Z = 2048, P_XBC = 3072, P_Q = 5120, P_K = 6144, P_V = 7168, P_G = 8192, P_DT = 14336;
constexpr int NE = 16, DE = 1408, MOE_ROWS = 39168, MOE_TILES = MOE_ROWS / 128;
constexpr float LN_EPS = 1e-6f;
constexpr float DN_ALPHA = 1.4142135623730951f;
constexpr float QSCALE = 0.125f * 1.4426950408889634f;
constexpr float WSC_GU = 64.f, WSC_D = 128.f;
constexpr int DEP = 1536;
constexpr int NCH = 136;

constexpr size_t MiB = 1u << 20;
constexpr size_t WS_CTL = 0, CTL_ZERO_BYTES = 1 * MiB;
constexpr size_t WS_MODP = 1 * MiB, WS_MOD = 9 * MiB, WS_ROUTE = 10 * MiB, WS_XSCTX = 11 * MiB;
constexpr size_t WS_WIN = 19 * MiB, WS_WBR = 76 * MiB, WS_WOUT = 88 * MiB, WS_WG = 96 * MiB;
constexpr size_t WS_P = 98 * MiB;
constexpr size_t WS_XG = WS_P, WS_ACT = WS_P + 153 * MiB, WS_FS = WS_P + 259 * MiB;
constexpr size_t WS_H = 583 * MiB, WS_BR = 651 * MiB, WS_T = 753 * MiB;
constexpr size_t T_XC = WS_T, T_XBC = WS_T + 34 * MiB, T_DT = WS_T + 102 * MiB, T_QR = WS_T + 105 * MiB, T_KR = WS_T + 139 * MiB;
constexpr size_t T_LA = WS_T + 173 * MiB, T_BB = WS_T + 241 * MiB, T_AGGA = WS_T + 309 * MiB, T_AGGB = WS_T + 314 * MiB, T_CIN = WS_T + 319 * MiB;
constexpr size_t T_SSDY = WS_T + 324 * MiB, T_OTMP = WS_T + 392 * MiB;
constexpr size_t T_MACC = WS_T, T_MB = WS_T + 136 * MiB;
constexpr size_t WS_EGU = WS_T + 468 * MiB, WS_ED = WS_EGU + 176 * MiB;
constexpr size_t WS_END = WS_ED + 88 * MiB;
static_assert(WS_WIN + (size_t)NP * D * 2 <= WS_WBR && WS_WBR + (size_t)3 * D * 1024 * 2 <= WS_WOUT && WS_WOUT + (size_t)D * D * 2 <= WS_WG && WS_WG + (size_t)4096 * 256 * 2 <= WS_P, "A-set map");
static_assert(WS_P + (size_t)M * NP * 2 <= WS_H && WS_FS + (size_t)MOE_ROWS * D * 2 <= WS_H && WS_XG + (size_t)MOE_ROWS * D * 2 <= WS_ACT && WS_ACT + (size_t)MOE_ROWS * DE * 2 <= WS_FS, "p map");
static_assert(WS_H + (size_t)M * D * 2 <= WS_BR && WS_BR + (size_t)3 * M * 1024 * 2 <= WS_T, "h/br map");
static_assert(T_OTMP + (size_t)M * D * 2 <= WS_EGU && WS_EGU + (size_t)NE * 2816 * D * 2 <= WS_ED && WS_ED + (size_t)NE * D * DE * 2 <= WS_END && T_MACC + (size_t)M * D * 4 <= T_MB && T_MB + (size_t)M * D * 2 <= WS_EGU, "T map");
static_assert(T_AGGA + (size_t)2 * NB * NCH * 1024 * 4 <= T_AGGB && T_AGGB + (size_t)2 * NB * NCH * 1024 * 4 <= T_CIN && T_CIN + (size_t)2 * NB * NCH * 1024 * 4 <= T_SSDY, "agg map");
constexpr int CW_TMO = 0, CW_BAR = 4096, CW_GCNT = 16384  , CW_NMT = 16384 + 64  , CW_TILEE = 20480  , CW_ATTQ = 16384 + 1024  ;

constexpr int RING_BYTES = 155648, MISC_OFF = RING_BYTES + 320, LDS_BYTES = 163840;
constexpr int NWAVES = 8, NTHR = 512;

#define LDS_WAIT() asm volatile("s_waitcnt lgkmcnt(0)" ::: "memory")
#define VM_WAIT() asm volatile("s_waitcnt vmcnt(0)" ::: "memory")
#define RLX_AGENT __ATOMIC_RELAXED, __HIP_MEMORY_SCOPE_AGENT
__device__ __forceinline__ unsigned f2bf(float f) { unsigned u = __builtin_bit_cast(unsigned, f); return (u + 0x7fffu + ((u >> 16) & 1u)) >> 16; }
__device__ __forceinline__ unsigned pk2(float lo, float hi) { return f2bf(lo) | (f2bf(hi) << 16); }
__device__ __forceinline__ float bflo(unsigned w) { return __builtin_bit_cast(float, w << 16); }
__device__ __forceinline__ float bfhi(unsigned w) { return __builtin_bit_cast(float, w & 0xffff0000u); }
__device__ __forceinline__ void unpack8(v4u w, float (&o)[8]) { o[0] = bflo(w.x); o[1] = bfhi(w.x); o[2] = bflo(w.y); o[3] = bfhi(w.y); o[4] = bflo(w.z); o[5] = bfhi(w.z); o[6] = bflo(w.w); o[7] = bfhi(w.w); }
__device__ __forceinline__ v4u pack8(const float (&o)[8]) { v4u w; w.x = pk2(o[0], o[1]); w.y = pk2(o[2], o[3]); w.z = pk2(o[4], o[5]); w.w = pk2(o[6], o[7]); return w; }
__device__ __forceinline__ float clamp8(float v) { return fminf(fmaxf(v, -448.f), 448.f); }
__device__ __forceinline__ v2u pack8_fp8(const float (&o)[8]) {
    int w0 = 0, w1 = 0;
    w0 = __builtin_amdgcn_cvt_pk_fp8_f32(clamp8(o[0]), clamp8(o[1]), w0, false); w0 = __builtin_amdgcn_cvt_pk_fp8_f32(clamp8(o[2]), clamp8(o[3]), w0, true);
    w1 = __builtin_amdgcn_cvt_pk_fp8_f32(clamp8(o[4]), clamp8(o[5]), w1, false); w1 = __builtin_amdgcn_cvt_pk_fp8_f32(clamp8(o[6]), clamp8(o[7]), w1, true);
    return (v2u){(unsigned)w0, (unsigned)w1}; }
#define DPP_ADD(v, ctrl) v += __int_as_float(__builtin_amdgcn_update_dpp(0, __float_as_int(v), ctrl, 0xF, 0xF, true))
__device__ __forceinline__ float wave_sum(float v) {
    DPP_ADD(v, 0xB1); DPP_ADD(v, 0x4E); DPP_ADD(v, 0x141); DPP_ADD(v, 0x140);
    { const auto r = __builtin_amdgcn_permlane16_swap(__float_as_uint(v), __float_as_uint(v), false, false); const unsigned r0 = r[0], r1 = r[1]; v = __uint_as_float(r0) + __uint_as_float(r1); }
    { const auto r = __builtin_amdgcn_permlane32_swap(__float_as_uint(v), __float_as_uint(v), false, false); const unsigned r0 = r[0], r1 = r[1]; v = __uint_as_float(r0) + __uint_as_float(r1); }
    return v;
}
__device__ __forceinline__ float sum8(float v) { DPP_ADD(v, 0xB1); DPP_ADD(v, 0x4E); DPP_ADD(v, 0x141); return v; }
__device__ __forceinline__ float sigmoidf_(float x) { return 1.f / (1.f + __expf(-x)); }
__device__ __forceinline__ float siluf_(float x) { return x / (1.f + __expf(-x)); }
__device__ __forceinline__ float softplusf_(float x) { return x > 20.f ? x : log1pf(__expf(x)); }
__device__ __forceinline__ float gelu_tanh(float x) { const float u = 0.7978845608028654f * (x + 0.044715f * x * x * x); const float e = __expf(2.f * u); const float t = 1.f - 2.f / (e + 1.f); return 0.5f * x * (1.f + t); }

namespace pg8 {
constexpr int BM = 256, BK = 64, HALF = 128, HTB = HALF * BK * 2, STAGE_BYTES = 8 * HTB;
__host__ __device__ __forceinline__ int lds_byte(int r, int c) { const int st = (r >> 4) * 2 + (c >> 5), rr = r & 15, cc = c & 31, ob = rr * 64 + cc * 2; return st * 1024 + (ob ^ (((ob >> 9) & 1) << 5)); }
__host__ __device__ __forceinline__ void stage_rc(int b, int& R, int& C) { const int st = b / 1024, sb = b % 1024, swz = sb ^ (((sb >> 9) & 1) << 5); R = (st >> 1) * 16 + swz / 64; C = (st & 1) * 32 + (swz % 64) / 2; }
__host__ __device__ __forceinline__ int perm32(int rho) { const int n = rho >> 4, i = rho & 15; return 8 * (i >> 2) + 4 * n + (i & 3); }

struct Unit { int pm, pn, aux; const char* a; const char* b; };
struct Gemm { int K, lda, ldb; };

__device__ __forceinline__ bool tile_of(long L, int nM, int nN, int& pm, int& pn) {
    const int nwg = nM * nN; if (L >= nwg) return false;
    int wgid = (int)L; { const int q = nwg / 8, r = nwg % 8, xcd = wgid % 8, off = wgid / 8; wgid = (xcd < r ? xcd * (q + 1) : r * (q + 1) + (xcd - r) * q) + off; }
    const int nig = 8 * nN, gid = wgid / nig, fm = gid * 8, gsz = (nM - fm) < 8 ? (nM - fm) : 8;
    pm = fm + ((wgid % nig) % gsz); pn = (wgid % nig) / gsz; return true;
}

__device__ __forceinline__ unsigned cvt_pk_bf16(float lo, float hi) { unsigned r; asm volatile("v_cvt_pk_bf16_f32 %0, %1, %2" : "=v"(r) : "v"(lo), "v"(hi)); return r; }

typedef int v8i __attribute__((ext_vector_type(8)));
typedef int v4i __attribute__((ext_vector_type(4)));
template <class Epi, class Sched, bool ALIGN_EPI = false, bool SP2 = false, bool FP8 = false, bool HALFM = false>
__device__ __forceinline__ void gemm_phase(LAS unsigned char* lds, const int tid, const Gemm g, const Sched& S, const Epi& E) {
    const int wid = __builtin_amdgcn_readfirstlane(tid >> 6), lane = tid & 63, wr = wid >> 2, wc = wid & 3, fr = lane & 15, fq = lane >> 4;
    const int K = g.K, nt = K / BK;
    unsigned voffA[2], voffB[2];
#pragma unroll
    for (int i = 0; i < 2; ++i) { int R, C; stage_rc(tid * 16 + i * 8192, R, C); const int Rb = Epi::PERM ? ((R & ~31) + perm32(R & 31)) : R;
        voffA[i] = (unsigned)(R * g.lda + C) * 2u; voffB[i] = (unsigned)(Rb * g.ldb + C) * 2u; }
    const size_t kstep = (size_t)(BK * 2);
    static_assert(!HALFM || SP2, "HALFM is written for the SP2 loop");
    const size_t hstepA = HALFM ? (size_t)0 : (size_t)HALF * g.lda * 2, hstepB = (size_t)HALF * g.ldb * 2;
    const unsigned ldsw = (unsigned)wid * 1024u;
    const int aoff = lds_byte(wr * 64 + fr, fq * 8), boff = lds_byte(wc * 32 + fr, fq * 8);
#define PG8_SA(b, h) (((b) * 2 + (h)) * HTB)
#define PG8_SB(b, h) ((4 + (b) * 2 + (h)) * HTB)
#define PG8_STAGE(bufoff, gbase, voff) do { _Pragma("unroll") for (int _i = 0; _i < 2; ++_i) \
        __builtin_amdgcn_global_load_lds((const unsigned*)((const char*)(gbase) + (voff)[_i]), (LAS unsigned*)(lds + (bufoff) + ldsw + _i * 8192), 16, 0, 0); } while (0)
#define PG8_LDA(dst, b, h) do { _Pragma("unroll") for (int m = 0; m < 4; ++m) { if constexpr (FP8) { const v4i lo_ = *(const LAS v4i*)(lds + PG8_SA(b, h) + aoff + m * 2048), hi_ = *(const LAS v4i*)(lds + PG8_SA(b, h) + aoff + m * 2048 + 1024); dst##8[m] = __builtin_shufflevector(lo_, hi_, 0, 1, 2, 3, 4, 5, 6, 7); } \
        else { _Pragma("unroll") for (int k = 0; k < 2; ++k) dst[m][k] = *(const LAS bf16x8*)(lds + PG8_SA(b, h) + aoff + m * 2048 + k * 1024); } } } while (0)
#define PG8_LDB(dst, b, h) do { _Pragma("unroll") for (int n = 0; n < 2; ++n) { if constexpr (FP8) { const v4i lo_ = *(const LAS v4i*)(lds + PG8_SB(b, h) + boff + n * 2048), hi_ = *(const LAS v4i*)(lds + PG8_SB(b, h) + boff + n * 2048 + 1024); dst##8[n] = __builtin_shufflevector(lo_, hi_, 0, 1, 2, 3, 4, 5, 6, 7); } \
        else { _Pragma("unroll") for (int k = 0; k < 2; ++k) dst[n][k] = *(const LAS bf16x8*)(lds + PG8_SB(b, h) + boff + n * 2048 + k * 1024); } } } while (0)
#define PG8_MMA(ai, bj, At, Bt) do { __builtin_amdgcn_s_setprio(1); _Pragma("unroll") for (int m = 0; m < 4; ++m) _Pragma("unroll") for (int n = 0; n < 2; ++n) { \
        if constexpr (FP8) acc[ai][bj][m][n] = __builtin_amdgcn_mfma_scale_f32_16x16x128_f8f6f4(Bt##8[n], At##8[m], acc[ai][bj][m][n], 0, 0, 0, 0x7f7f7f7f, 0, 0x7f7f7f7f); \
        else { _Pragma("unroll") for (int k = 0; k < 2; ++k) acc[ai][bj][m][n] = __builtin_amdgcn_mfma_f32_16x16x32_bf16(Bt[n][k], At[m][k], acc[ai][bj][m][n], 0, 0, 0); } } \
        __builtin_amdgcn_s_setprio(0); } while (0)
#define PG8_WAIT_V(n) asm volatile("s_waitcnt vmcnt(" #n ")" ::: "memory")
#define PG8_WAIT_L(n) asm volatile("s_waitcnt lgkmcnt(" #n ")" ::: "memory")
#define PG8_BAR __builtin_amdgcn_s_barrier()
#define PG8_SCHED __builtin_amdgcn_sched_barrier(0)
    Unit cur, nxt; int ui = 0;
    if (!S.next(0, cur)) return;
    f32x4 acc[2][2][4][2];
#pragma unroll
    for (int a = 0; a < 2; ++a)
#pragma unroll
        for (int b = 0; b < 2; ++b)
#pragma unroll
            for (int m = 0; m < 4; ++m)
#pragma unroll
                for (int n = 0; n < 2; ++n) acc[a][b][m][n] = (f32x4){0.f, 0.f, 0.f, 0.f};
    bf16x8 At[4][2], B0[2][2], B1[2][2]; v8i At8[4], B08[2], B18[2];
    const char* cA = cur.a; const char* cB = cur.b;
    S.a_ready(cur);
    if constexpr (SP2) {
        PG8_STAGE(PG8_SB(0, 0), cB, voffB); PG8_STAGE(PG8_SB(0, 1), cB + hstepB, voffB); PG8_STAGE(PG8_SA(0, 0), cA, voffA); PG8_STAGE(PG8_SA(0, 1), cA + hstepA, voffA);
        if (wr == 1) PG8_BAR;
        PG8_WAIT_V(2); PG8_BAR;
        PG8_STAGE(PG8_SB(1, 0), cB + kstep, voffB); PG8_STAGE(PG8_SA(1, 0), cA + kstep, voffA); PG8_STAGE(PG8_SB(1, 1), cB + hstepB + kstep, voffB);
        PG8_WAIT_V(6); PG8_BAR;
    } else {
        PG8_STAGE(PG8_SB(0, 0), cB, voffB); PG8_STAGE(PG8_SA(0, 0), cA, voffA); PG8_STAGE(PG8_SB(0, 1), cB + hstepB, voffB); PG8_STAGE(PG8_SA(0, 1), cA + hstepA, voffA);
        if (wr == 1) PG8_BAR;
        PG8_WAIT_V(4); PG8_BAR;
        PG8_STAGE(PG8_SB(1, 0), cB + kstep, voffB); PG8_STAGE(PG8_SA(1, 0), cA + kstep, voffA); PG8_STAGE(PG8_SB(1, 1), cB + hstepB + kstep, voffB);
        PG8_WAIT_V(6); PG8_BAR;
    }
    for (;;) {
        const bool has_next = S.next(ui + 1, nxt);
        const char* nA = has_next ? nxt.a : cA; const char* nB = has_next ? nxt.b : cB;
#pragma unroll 1
        for (int t = 0; t < nt; t += 2) {
            const bool last = (t == nt - 2);
            const char* a1 = cA + (size_t)(t + 1) * kstep;
            const char* a2 = last ? nA : cA + (size_t)(t + 2) * kstep; const char* b2 = last ? nB : cB + (size_t)(t + 2) * kstep;
            const char* a3 = a2 + kstep; const char* b3 = b2 + kstep;
            if (last && has_next) S.a_ready(nxt);
            if constexpr (SP2) {
            PG8_LDB(B0, 0, 0); PG8_LDB(B1, 0, 1); PG8_SCHED; PG8_LDA(At, 0, 0); PG8_STAGE(PG8_SA(1, 1), a1 + hstepA, voffA);
            PG8_WAIT_V(8); PG8_WAIT_L(0); PG8_BAR; PG8_MMA(0, 0, At, B0); PG8_MMA(0, 1, At, B1); PG8_BAR; PG8_SCHED;
            if constexpr (!HALFM) PG8_LDA(At, 0, 1);
            PG8_STAGE(PG8_SB(0, 0), b2, voffB); PG8_STAGE(PG8_SB(0, 1), b2 + hstepB, voffB); PG8_STAGE(PG8_SA(0, 0), a2, voffA);
            PG8_WAIT_V(8); PG8_WAIT_L(0); PG8_BAR; if constexpr (!HALFM) { PG8_MMA(1, 0, At, B0); PG8_MMA(1, 1, At, B1); } PG8_BAR; PG8_SCHED;
            PG8_LDB(B0, 1, 0); PG8_LDB(B1, 1, 1); PG8_SCHED; PG8_LDA(At, 1, 0); PG8_STAGE(PG8_SA(0, 1), a2 + hstepA, voffA);
            PG8_WAIT_V(8); PG8_WAIT_L(0); PG8_BAR; PG8_MMA(0, 0, At, B0); PG8_MMA(0, 1, At, B1); PG8_BAR; PG8_SCHED;
            if constexpr (!HALFM) PG8_LDA(At, 1, 1);
            PG8_STAGE(PG8_SB(1, 0), b3, voffB); PG8_STAGE(PG8_SB(1, 1), b3 + hstepB, voffB); PG8_STAGE(PG8_SA(1, 0), a3, voffA);
            PG8_WAIT_V(8); PG8_WAIT_L(0); PG8_BAR; if constexpr (!HALFM) { PG8_MMA(1, 0, At, B0); PG8_MMA(1, 1, At, B1); } PG8_BAR; PG8_SCHED;
            } else {
            PG8_LDB(B0, 0, 0); PG8_SCHED; PG8_LDA(At, 0, 0); PG8_STAGE(PG8_SA(1, 1), a1 + hstepA, voffA);
            PG8_WAIT_L(8); PG8_BAR; PG8_WAIT_L(0); PG8_MMA(0, 0, At, B0); PG8_BAR; PG8_SCHED;
            PG8_LDB(B1, 0, 1); PG8_STAGE(PG8_SB(0, 0), b2, voffB);
            PG8_BAR; PG8_WAIT_L(0); PG8_MMA(0, 1, At, B1); PG8_BAR;
            PG8_LDA(At, 0, 1); PG8_STAGE(PG8_SA(0, 0), a2, voffA);
            PG8_BAR; PG8_WAIT_L(0); PG8_MMA(1, 0, At, B0); PG8_BAR; PG8_SCHED;
            PG8_STAGE(PG8_SB(0, 1), b2 + hstepB, voffB);
            PG8_WAIT_V(6); PG8_BAR; PG8_MMA(1, 1, At, B1); PG8_BAR;
            PG8_LDB(B0, 1, 0); PG8_SCHED; PG8_LDA(At, 1, 0); PG8_STAGE(PG8_SA(0, 1), a2 + hstepA, voffA);
            PG8_WAIT_L(8); PG8_BAR; PG8_WAIT_L(0); PG8_MMA(0, 0, At, B0); PG8_BAR; PG8_SCHED;
            PG8_LDB(B1, 1, 1); PG8_STAGE(PG8_SB(1, 0), b3, voffB);
            PG8_BAR; PG8_WAIT_L(0); PG8_MMA(0, 1, At, B1); PG8_BAR;
            PG8_LDA(At, 1, 1); PG8_STAGE(PG8_SA(1, 0), a3, voffA);
            PG8_BAR; PG8_WAIT_L(0); PG8_MMA(1, 0, At, B0); PG8_BAR; PG8_SCHED;
            PG8_STAGE(PG8_SB(1, 1), b3 + hstepB, voffB);
            PG8_WAIT_V(6); PG8_BAR; PG8_MMA(1, 1, At, B1); PG8_BAR;
            }
        }
        if constexpr (ALIGN_EPI) { if (wr == 0) PG8_BAR; }
        const bool carry = E(acc, cur, wr, wc, fr, fq); S.done(cur);
        if (!has_next) break;
        if (!carry)
#pragma unroll
        for (int a = 0; a < 2; ++a)
#pragma unroll
            for (int b = 0; b < 2; ++b)
#pragma unroll
                for (int m = 0; m < 4; ++m)
#pragma unroll
                    for (int n = 0; n < 2; ++n) acc[a][b][m][n] = (f32x4){0.f, 0.f, 0.f, 0.f};
        cur = nxt; cA = nA; cB = nB; ++ui;
        if constexpr (ALIGN_EPI) { if (wr == 1) PG8_BAR; }
    }
    PG8_WAIT_V(0);
    if constexpr (!ALIGN_EPI) { if (wr == 0) PG8_BAR; }
    PG8_BAR;
#undef PG8_SA
#undef PG8_SB
#undef PG8_STAGE
#undef PG8_LDA
#undef PG8_LDB
#undef PG8_MMA
#undef PG8_WAIT_V
#undef PG8_WAIT_L
#undef PG8_BAR
#undef PG8_SCHED
}
}

struct SchedPlain {
    int nM, nN, G, c; const char* A; const char* B; size_t a_tile, b_tile; int skipctx;
    __device__ __forceinline__ bool next(int i, pg8::Unit& u) const {
        if (!pg8::tile_of((long)i * G + c, nM, nN, u.pm, u.pn)) return false;
        if (skipctx) u.pm = (u.pm >> 4) * 17 + 1 + (u.pm & 15);
        u.aux = 0; u.a = A + (size_t)u.pm * a_tile; u.b = B + (size_t)u.pn * b_tile; return true; }
    __device__ __forceinline__ void a_ready(const pg8::Unit&) const {}
    __device__ __forceinline__ void done(const pg8::Unit&) const {}
};
struct SchedIn {
    int G, c, last; const char* A; const char* B;
    __device__ __forceinline__ bool next(int i, pg8::Unit& u) const {
        const long L = (long)i * G + c;
        if (!last) { if (!pg8::tile_of(L, M / 256, NP / 256, u.pm, u.pn)) return false; }
        else if (L < 64 * 57) { pg8::tile_of(L, 64, NP / 256, u.pm, u.pn); u.pm = (u.pm >> 4) * 17 + 1 + (u.pm & 15); }
        else { const int r = (int)(L - 64 * 57); if (r >= 4 * 21) return false; const int k = r % 21; u.pm = (r / 21) * 17;
            u.pn = k < 4 ? k : (k < 12 ? 8 + k : (k < 20 ? 12 + k : 56)); }
        u.aux = 0; u.a = A + (size_t)u.pm * 256 * D * 2; u.b = B + (size_t)u.pn * 256 * D * 2; return true; }
    __device__ __forceinline__ void a_ready(const pg8::Unit&) const {}
    __device__ __forceinline__ void done(const pg8::Unit&) const {}
};
struct SchedLru {
    int G, c; const char* xc; const char* wg;
    __device__ __forceinline__ bool next(int i, pg8::Unit& u) const {
        if (!pg8::tile_of((long)i * G + c, M / 256, 16, u.pm, u.pn)) return false;
        u.aux = 0; u.a = xc + (size_t)u.pm * 256 * 1024 * 2 + (size_t)((u.pn & 7) >> 1) * 256 * 2; u.b = wg + (size_t)u.pn * 256 * 256 * 2; return true; }
    __device__ __forceinline__ void a_ready(const pg8::Unit&) const {}
    __device__ __forceinline__ void done(const pg8::Unit&) const {}
};
struct SchedMerge {
    int G, c; const char* br; const char* wbr; int skipctx;
    __device__ __forceinline__ bool next(int i, pg8::Unit& u) const {
        const int T = i / 3, k = i - 3 * T;
        if (!pg8::tile_of((long)T * G + c, skipctx ? 64 : M / 256, D / 256, u.pm, u.pn)) return false;
        if (skipctx) u.pm = (u.pm >> 4) * 17 + 1 + (u.pm & 15);
        u.aux = k; u.a = br + ((size_t)k * M + (size_t)u.pm * 256) * 1024 * 2; u.b = wbr + ((size_t)k * D + (size_t)u.pn * 256) * 1024 * 2; return true; }
    __device__ __forceinline__ void a_ready(const pg8::Unit&) const {}
    __device__ __forceinline__ void done(const pg8::Unit&) const {}
};
struct SchedMoe {
    int nM, nN, G, c; const char* A; const char* W; size_t a_tile, w_exp, w_tile; const unsigned* tile_e;
    __device__ __forceinline__ bool next(int i, pg8::Unit& u) const {
        if (!pg8::tile_of((long)i * G + c, nM, nN, u.pm, u.pn)) return false;
        const int e = (int)(__builtin_amdgcn_readfirstlane(tile_e[u.pm & 511]) & 15u);
        u.aux = e; u.a = A + (size_t)u.pm * a_tile; u.b = W + (size_t)e * w_exp + (size_t)u.pn * w_tile; return true; }
    __device__ __forceinline__ void a_ready(const pg8::Unit&) const {}
    __device__ __forceinline__ void done(const pg8::Unit&) const {}
};

typedef f32x4 (&AccRef)[2][2][4][2];
struct EpiP {
    static constexpr bool PERM = true; bf16* O;
    __device__ __forceinline__ bool operator()(AccRef acc, const pg8::Unit& u, int wr, int wc, int fr, int fq) const {
        const int row0 = u.pm * 256 + wr * 64 + fr, col0 = u.pn * 256 + wc * 32 + 8 * fq;
#pragma unroll
        for (int ai = 0; ai < 2; ++ai)
#pragma unroll
            for (int m = 0; m < 4; ++m) { bf16* rowp = O + (size_t)(row0 + ai * 128 + m * 16) * NP + col0;
#pragma unroll
                for (int bj = 0; bj < 2; ++bj) { const f32x4 v0 = acc[ai][bj][m][0], v1 = acc[ai][bj][m][1]; v4u w;
                    w.x = pg8::cvt_pk_bf16(v0[0], v0[1]); w.y = pg8::cvt_pk_bf16(v0[2], v0[3]); w.z = pg8::cvt_pk_bf16(v1[0], v1[1]); w.w = pg8::cvt_pk_bf16(v1[2], v1[3]);
                    *(v4u*)(rowp + bj * 128) = w; } }
        return false;
    }
};
struct EpiLru {
    static constexpr bool PERM = true; const bf16* xc; const float* gate_b; const float* lam; bf16* la; bf16* bb;
    __device__ __forceinline__ bool operator()(AccRef acc, const pg8::Unit& u, int wr, int wc, int fr, int fq) const {
        const int d = u.pn >> 3, blk = u.pn & 7, c0 = blk * 128 + wc * 32 + 8 * fq;
        float br[8], bi[8], sp[8];
#pragma unroll
        for (int n = 0; n < 2; ++n) { const f32x4 b0 = *(const f32x4*)(gate_b + (d * 2 + 0) * 1024 + c0 + 4 * n), b1 = *(const f32x4*)(gate_b + (d * 2 + 1) * 1024 + c0 + 4 * n), lm = *(const f32x4*)(lam + d * 1024 + c0 + 4 * n);
#pragma unroll
            for (int j = 0; j < 4; ++j) { br[4 * n + j] = b0[j]; bi[4 * n + j] = b1[j]; sp[4 * n + j] = softplusf_(-lm[j]) * (8.f * 1.4426950408889634f); } }
        v4u xw[2][4];
#pragma unroll
        for (int ai = 0; ai < 2; ++ai)
#pragma unroll
            for (int m = 0; m < 4; ++m) xw[ai][m] = *(const v4u*)(xc + (size_t)(u.pm * 256 + ai * 128 + wr * 64 + m * 16 + fr) * 1024 + c0);
#pragma unroll
        for (int ai = 0; ai < 2; ++ai)
#pragma unroll
            for (int m = 0; m < 4; ++m) { const int row = u.pm * 256 + ai * 128 + wr * 64 + m * 16 + fr;
                float x8[8], lo[8], bo[8]; unpack8(xw[ai][m], x8);
#pragma unroll
                for (int j = 0; j < 8; ++j) { const float ea = __expf(-(acc[ai][0][m][j >> 2][j & 3] + br[j])), eb = __expf(-(acc[ai][1][m][j >> 2][j & 3] + bi[j]));
                    const float inv = __builtin_amdgcn_rcpf((1.f + ea) * (1.f + eb)), r = (1.f + eb) * inv, ig = (1.f + ea) * inv, la2 = -r * sp[j];
                    lo[j] = la2; bo[j] = __builtin_amdgcn_sqrtf(fmaxf(1.f - __builtin_amdgcn_exp2f(2.f * la2), 0.f)) * ig * x8[j]; }
                *(v4u*)(la + ((size_t)d * M + row) * 1024 + c0) = pack8(lo); *(v4u*)(bb + ((size_t)d * M + row) * 1024 + c0) = pack8(bo); }
        return false;
    }
};
struct EpiMerge {
    static constexpr bool PERM = true; const bf16* p; bf16* mb;
    __device__ __forceinline__ bool operator()(AccRef acc, const pg8::Unit& u, int wr, int wc, int fr, int fq) const {
        const int k = u.aux, col0 = u.pn * 256 + wc * 32 + 8 * fq; const int k2 = k < 2 ? k + 1 : k;
#pragma unroll
        for (int ai = 0; ai < 2; ++ai) {
            v4u wa[4][2], wb[4][2];
#pragma unroll
            for (int m = 0; m < 4; ++m)
#pragma unroll
                for (int bj = 0; bj < 2; ++bj) { const bf16* gp = p + (size_t)(u.pm * 256 + ai * 128 + wr * 64 + m * 16 + fr) * NP + P_G + col0 + bj * 128;
                    wa[m][bj] = *(const v4u*)(gp + k * D); wb[m][bj] = *(const v4u*)(gp + k2 * D); }
#pragma unroll
            for (int m = 0; m < 4; ++m) { const int row = u.pm * 256 + ai * 128 + wr * 64 + m * 16 + fr;
#pragma unroll
                for (int bj = 0; bj < 2; ++bj) { const int col = col0 + bj * 128; float ga[8]; unpack8(wa[m][bj], ga);
                    if (k < 2) { float gb[8]; unpack8(wb[m][bj], gb);
#pragma unroll
                        for (int j = 0; j < 8; ++j) { const float ea = __expf(-fminf(fmaxf(ga[j], -30.f), 30.f)), eb = __expf(-fminf(fmaxf(gb[j], -30.f), 30.f));
                            acc[ai][bj][m][j >> 2][j & 3] *= (1.f + eb) * __builtin_amdgcn_rcpf(1.f + ea); } }
                    else { float t[8];
#pragma unroll
                        for (int j = 0; j < 8; ++j) t[j] = sigmoidf_(ga[j]) * acc[ai][bj][m][j >> 2][j & 3];
                        *(v4u*)(mb + (size_t)row * D + col) = pack8(t); } } } }
        return k < 2;
    }
};
struct EpiWout {
    static constexpr bool PERM = true; const float* res_lat; const float* res_ctx; const float* g1; bf16* y;
    __device__ __forceinline__ bool operator()(AccRef acc, const pg8::Unit& u, int wr, int wc, int fr, int fq) const {
        const int b = u.pm / 17, jt = u.pm - 17 * b; const bool isctx = (jt == 0); const int mrow = isctx ? 4 : b, col0 = u.pn * 256 + wc * 32 + 8 * fq;
        f32x4 gv[2][2];
#pragma unroll
        for (int bj = 0; bj < 2; ++bj)
#pragma unroll
            for (int n = 0; n < 2; ++n) gv[bj][n] = *(const f32x4*)(g1 + (size_t)mrow * NADA + col0 + bj * 128 + 4 * n);
#pragma unroll
        for (int ai = 0; ai < 2; ++ai) {
            f32x4 rv[4][2][2];
#pragma unroll
            for (int m = 0; m < 4; ++m) { const int j = jt * 256 + ai * 128 + wr * 64 + m * 16 + fr;
                const float* rp = isctx ? res_ctx + ((size_t)b * LC + j) * D : res_lat + ((size_t)b * LL + (j - LC)) * D;
#pragma unroll
                for (int bj = 0; bj < 2; ++bj)
#pragma unroll
                    for (int n = 0; n < 2; ++n) rv[m][bj][n] = *(const f32x4*)(rp + col0 + bj * 128 + 4 * n); }
#pragma unroll
            for (int m = 0; m < 4; ++m) { const int j = jt * 256 + ai * 128 + wr * 64 + m * 16 + fr; const size_t row = (size_t)b * LT + j;
#pragma unroll
                for (int bj = 0; bj < 2; ++bj)
                { const f32x4 y0 = rv[m][bj][0] * DN_ALPHA + gv[bj][0] * acc[ai][bj][m][0], y1 = rv[m][bj][1] * DN_ALPHA + gv[bj][1] * acc[ai][bj][m][1];
                    *(v4u*)(y + row * D + col0 + bj * 128) = (v4u){pk2(y0[0], y0[1]), pk2(y0[2], y0[3]), pk2(y1[0], y1[1]), pk2(y1[2], y1[3])}; } } }
        return false;
    }
};
struct EpiMoe1 {
    static constexpr bool PERM = true; unsigned char* act;
    __device__ __forceinline__ bool operator()(AccRef acc, const pg8::Unit& u, int wr, int wc, int fr, int fq) const {
        const int col = u.pn * 128 + wc * 32 + 8 * fq;
#pragma unroll
        for (int m = 0; m < 4; ++m) { const int row = u.pm * 128 + wr * 64 + m * 16 + fr; float t[8];
#pragma unroll
            for (int j = 0; j < 8; ++j) t[j] = siluf_(acc[0][0][m][j >> 2][j & 3] * (1.f / WSC_GU)) * (acc[0][1][m][j >> 2][j & 3] * (1.f / WSC_GU));
            *(v2u*)(act + (size_t)row * DEP + col) = pack8_fp8(t);
            if (u.pn == 10) *(v2u*)(act + (size_t)row * DEP + col + 128) = (v2u){0u, 0u}; }
        return false;
    }
};
struct EpiMoe2 {
    static constexpr bool PERM = true; bf16* fs;
    __device__ __forceinline__ bool operator()(AccRef acc, const pg8::Unit& u, int wr, int wc, int fr, int fq) const {
        const int col0 = u.pn * 256 + wc * 32 + 8 * fq;
#pragma unroll
        for (int m = 0; m < 4; ++m) { const int row = u.pm * 128 + wr * 64 + m * 16 + fr;
#pragma unroll
            for (int bj = 0; bj < 2; ++bj) { const f32x4 v0 = acc[0][bj][m][0] * (1.f / WSC_D), v1 = acc[0][bj][m][1] * (1.f / WSC_D); v4u w;
                w.x = pg8::cvt_pk_bf16(v0[0], v0[1]); w.y = pg8::cvt_pk_bf16(v0[2], v0[3]); w.z = pg8::cvt_pk_bf16(v1[0], v1[1]); w.w = pg8::cvt_pk_bf16(v1[2], v1[3]);
                *(v4u*)(fs + (size_t)row * D + col0 + bj * 128) = w; } }
        return false;
    }
};

#define XB_TMO      128
#define XB_XCNT(j)  (256  + 64 * (j))
#define XB_XSUB(j)  (1280 + 64 * (j))
#define XB_XGEN(j)  (2304 + 64 * (j))
#define XB_TOP      3328
#define XB_TOPGEN   3392
#define XCD_BAR_WORDS 3456
#define XB_SPIN_CAP (1u << 22)

__device__ __forceinline__ unsigned xb_ld(unsigned* p)              { return __hip_atomic_load(p, __ATOMIC_RELAXED, __HIP_MEMORY_SCOPE_AGENT); }
__device__ __forceinline__ unsigned xb_add(unsigned* p, unsigned v) { return __hip_atomic_fetch_add(p, v, __ATOMIC_RELAXED, __HIP_MEMORY_SCOPE_AGENT); }
__device__ __forceinline__ unsigned xb_xcc_id() { return (unsigned)__builtin_amdgcn_s_getreg((3 << 11) | 20) & 0xFu; }
#define XB_SPIN(cond, bar) do { unsigned _sp = 0; while (cond) { __builtin_amdgcn_s_sleep(1); \
    if ((++_sp & 255u) == 0u) { if (xb_ld(&(bar)[XB_TMO])) break; if (_sp > XB_SPIN_CAP) { atomicAdd(&(bar)[XB_TMO], 1u); break; } } } } while (0)

struct XcdBarrier { unsigned* bar; unsigned x; volatile LAS unsigned* st; };

__device__ __forceinline__ XcdBarrier xcd_barrier_post(unsigned* bar, volatile LAS unsigned* st) {
    XcdBarrier b; b.bar = bar; b.x = xb_xcc_id(); b.st = st;
    if (threadIdx.x == 0) (void)xb_add(&bar[XB_XCNT(b.x)], 1u);
    return b;
}
__device__ __forceinline__ void xcd_barrier_complete(unsigned* bar, unsigned x, unsigned& nloc, unsigned& nx) {
    const unsigned G = gridDim.x * gridDim.y * gridDim.z;
    unsigned sum, cnt, mine, sp = 0u;
    for (;;) {
        sum = 0u; cnt = 0u; mine = 0u;
#pragma unroll
        for (unsigned j = 0; j < 16; ++j) { const unsigned c = xb_ld(&bar[XB_XCNT(j)]); sum += c; cnt += (c > 0u) ? 1u : 0u; mine = (j == x) ? c : mine; }
        if (sum == G) break;
        __builtin_amdgcn_s_sleep(1);
        if ((++sp & 255u) == 0u) { if (xb_ld(&bar[XB_TMO])) break; if (sp > XB_SPIN_CAP) { atomicAdd(&bar[XB_TMO], 1u); break; } }
    }
    nloc = mine > 0u ? mine : 1u; nx = cnt > 0u ? cnt : 1u;
}
__device__ __forceinline__ void xcd_barrier(const XcdBarrier& b) {
    asm volatile("s_waitcnt vmcnt(0)" ::: "memory");
    __syncthreads();
    if (threadIdx.x == 0) {
        unsigned* bar = b.bar;
        __builtin_amdgcn_s_waitcnt(0);
        unsigned nloc = b.st[0], nx = b.st[1];
        if (nloc == 0u) { xcd_barrier_complete(bar, b.x, nloc, nx); b.st[0] = nloc; b.st[1] = nx; }
        const unsigned old = xb_add(&bar[XB_XSUB(b.x)], 1u);
        const unsigned gen = old / nloc;
        if (old + 1u == (gen + 1u) * nloc) {
            __builtin_amdgcn_fence(__ATOMIC_RELEASE, "agent");
            asm volatile("s_waitcnt vmcnt(0)" ::: "memory");
            const unsigned og = xb_add(&bar[XB_TOP], 1u);
            const unsigned tg = og / nx;
            if (og + 1u == (tg + 1u) * nx) xb_add(&bar[XB_TOPGEN], 1u);
            else XB_SPIN(xb_ld(&bar[XB_TOPGEN]) == tg, bar);
            __builtin_amdgcn_fence(__ATOMIC_ACQUIRE, "agent");
            xb_add(&bar[XB_XGEN(b.x)], 1u);
            asm volatile("s_waitcnt vmcnt(0)" ::: "memory");
        } else {
            XB_SPIN(xb_ld(&bar[XB_XGEN(b.x)]) == gen, bar);
            __builtin_amdgcn_fence(__ATOMIC_ACQUIRE, "agent");
            asm volatile("s_waitcnt vmcnt(0)" ::: "memory");
        }
    }
    __syncthreads();
}

struct Args { const float* in[29]; float* out; unsigned char* ws; int ph_lo, ph_hi, li, pad; };
struct Ctx { LAS unsigned char* lds; int tid, lane, wave, vcu, G; };
typedef const __attribute__((address_space(4))) Args& ArgsRef;
enum { I_X = 0, I_C, I_CTX, I_CCTX, I_WADA, I_BADA, I_WIN, I_LCW, I_LCB, I_LGW, I_LGB, I_LLAM, I_SCW, I_SCB, I_SALOG, I_SDTB, I_SD, I_SNW, I_ALAM, I_ANW, I_WBR, I_WOUT, I_LNG, I_LNB, I_WR, I_RB, I_WG, I_WU, I_WD };
#define ROWLOOP for (int r = C.vcu * NWAVES + C.wave; r < M; r += C.G * NWAVES)

__device__ __forceinline__ void ph_modp(ArgsRef a, Ctx C) {
    LAS float* sil = (LAS float*)C.lds;
    const float* c = a.in[I_C]; const float* cctx = a.in[I_CCTX];
    for (int i = C.tid; i < 5 * D; i += NTHR) { const float v = i < 4 * D ? c[i] : cctx[i - 4 * D]; sil[i] = siluf_(v); }
    __syncthreads();
    const float* w_ada = a.in[I_WADA]; float* modp = (float*)(a.ws + WS_MODP);
    for (int it = C.vcu * NWAVES + C.wave; it < 2 * 48 * 16; it += C.G * NWAVES) {
        const int l = it / 768, rem = it % 768, cb = rem / 16, ks = rem % 16, col = cb * 256 + C.lane * 4;
        const float* wp = w_ada + ((size_t)l * D + ks * 128) * NADA + col;
        f32x4 acc[5];
#pragma unroll
        for (int r = 0; r < 5; ++r) acc[r] = (f32x4){0.f, 0.f, 0.f, 0.f};
#pragma unroll 8
        for (int k = 0; k < 128; ++k) { const f32x4 w = *(const f32x4*)(wp + (size_t)k * NADA);
#pragma unroll
            for (int r = 0; r < 5; ++r) acc[r] += w * sil[r * D + ks * 128 + k]; }
#pragma unroll
        for (int r = 0; r < 5; ++r) *(f32x4*)(modp + ((size_t)(l * 16 + ks) * 5 + r) * NADA + col) = acc[r];
    }
    __syncthreads();
}
__device__ __forceinline__ void ph_modr(ArgsRef a, Ctx C) {
    const float* modp = (const float*)(a.ws + WS_MODP); float* mod = (float*)(a.ws + WS_MOD); const float* b_ada = a.in[I_BADA];
    for (int i = C.vcu * NTHR + C.tid; i < 2 * 5 * NADA; i += C.G * NTHR) {
        const int l = i / (5 * NADA), rem = i % (5 * NADA), n = rem % NADA; float s = b_ada[l * NADA + n];
#pragma unroll
        for (int ks = 0; ks < 16; ++ks) s += modp[(size_t)(l * 16 + ks) * 5 * NADA + rem];
        mod[i] = s; }
}
__device__ __forceinline__ void tr_item(const float* W, int N, bf16* WT, int K, int k0, int n0, int drow0, LAS float* scr, int lane) {
#pragma unroll 8
    for (int i = 0; i < 32; ++i) { const int kk = 2 * i + (lane >> 5); scr[kk * 33 + (lane & 31)] = W[(size_t)(k0 + kk) * N + n0 + (lane & 31)]; }
    LDS_WAIT(); asm volatile("" ::: "memory");
    const int c = lane & 7;
#pragma unroll
    for (int j = 0; j < 4; ++j) { const int n = (lane >> 3) + 8 * j; const LAS float* s = scr + (8 * c) * 33 + n;
        v4u o; o.x = pk2(s[0 * 33], s[1 * 33]); o.y = pk2(s[2 * 33], s[3 * 33]); o.z = pk2(s[4 * 33], s[5 * 33]); o.w = pk2(s[6 * 33], s[7 * 33]);
        *(GAS v4u*)(WT + (size_t)(drow0 + n) * K + k0 + 8 * c) = o; }
    LDS_WAIT(); asm volatile("" ::: "memory");
}
__device__ __forceinline__ void ph_conva(ArgsRef a, Ctx C, int l) {
    LAS float* scr = (LAS float*)(C.lds + C.wave * 8448);
    bf16* Wt_in = (bf16*)(a.ws + WS_WIN); bf16* Wt_br = (bf16*)(a.ws + WS_WBR); bf16* Wt_out = (bf16*)(a.ws + WS_WOUT); bf16* Wg = (bf16*)(a.ws + WS_WG);
    constexpr int I_IN = 32 * 449, I_BRN = 3 * 16 * 64, I_OUTN = 32 * 64, I_PAD = NP - DIN, I_WGN = 4096;
    for (int it = C.vcu * NWAVES + C.wave; it < I_IN + I_BRN + I_OUTN + I_PAD + I_WGN; it += C.G * NWAVES) {
        int r = it;
        if (r < I_IN) { const int kb = r / 449, nb = r % 449, n0 = nb * 32, drow0 = n0 < 5120 ? n0 : (n0 == 5120 ? P_DT : n0 - 32);
            tr_item(a.in[I_WIN] + (size_t)l * D * DIN, DIN, Wt_in, D, kb * 64, n0, drow0, scr, C.lane); continue; }
        r -= I_IN;
        if (r < I_BRN) { const int k = r / 1024, r2 = r % 1024, kb = r2 / 64, nb = r2 % 64;
            tr_item(a.in[I_WBR] + (size_t)(l * 3 + k) * 1024 * D, D, Wt_br + (size_t)k * D * 1024, 1024, kb * 64, nb * 32, nb * 32, scr, C.lane); continue; }
        r -= I_BRN;
        if (r < I_OUTN) { const int kb = r / 64, nb = r % 64; tr_item(a.in[I_WOUT] + (size_t)l * D * D, D, Wt_out, D, kb * 64, nb * 32, nb * 32, scr, C.lane); continue; }
        r -= I_OUTN;
        if (r < I_PAD) { bf16* row = Wt_in + (size_t)(DIN + r) * D;
#pragma unroll
            for (int q = 0; q < 4; ++q) *(v4u*)(row + C.lane * 8 + q * 512) = (v4u){0u, 0u, 0u, 0u};
            continue; }
        r -= I_PAD;
        {
            const int pn = r >> 8, n = r & 255, d = pn >> 3, blk = pn & 7, g = n >> 7, cl = n & 127, half = blk & 1;
            const float* gw = a.in[I_LGW] + ((((size_t)(l * 2 + d) * 2 + g) * 8 + blk) * 128) * 128 + cl;
            const int k0 = C.lane * 4; float v[4];
#pragma unroll
            for (int j = 0; j < 4; ++j) { const int k = k0 + j; v[j] = ((k >> 7) == half) ? gw[(size_t)(k & 127) * 128] : 0.f; }
            *(v2u*)(Wg + (size_t)r * 256 + k0) = (v2u){pk2(v[0], v[1]), pk2(v[2], v[3])}; }
    }
}
__device__ __forceinline__ void tr_item8(const float* W, int N, unsigned char* WT, int Kb, int k0, int n0, int drow0, float scale, LAS float* scr, int lane) {
#pragma unroll 8
    for (int i = 0; i < 32; ++i) { const int kk = 2 * i + (lane >> 5); scr[kk * 33 + (lane & 31)] = W[(size_t)(k0 + kk) * N + n0 + (lane & 31)]; }
    LDS_WAIT(); asm volatile("" ::: "memory");
    const int c = lane & 7;
#pragma unroll
    for (int j = 0; j < 4; ++j) { const int n = (lane >> 3) + 8 * j; const LAS float* sp = scr + (8 * c) * 33 + n; float v[8];
#pragma unroll
        for (int q = 0; q < 8; ++q) v[q] = sp[q * 33] * scale;
        *(GAS v2u*)(WT + (size_t)(drow0 + n) * Kb + k0 + 8 * c) = pack8_fp8(v); }
    LDS_WAIT(); asm volatile("" ::: "memory");
}
struct ConvItem { const float* W; unsigned char* WT; int N, Kb, k0, n0, drow0; float scale; };
__device__ __forceinline__ bool conv_e_item(ArgsRef a, int l, int it, ConvItem& c) {
    if (it >= NE * 3 * 1408) return false;
    const int e = it / (3 * 1408), r0 = it % (3 * 1408), which = r0 / 1408, r = r0 % 1408;
    if (which < 2) { const int kb = r / 44, nb = r % 44, n0 = nb * 32;
        c.W = a.in[which == 0 ? I_WG : I_WU] + (size_t)(l * NE + e) * D * DE; c.N = DE; c.WT = a.ws + WS_EGU + (size_t)e * 2816 * D; c.Kb = D; c.k0 = kb * 64; c.n0 = n0; c.drow0 = (n0 >> 7) * 256 + (n0 & 127) + which * 128; c.scale = WSC_GU; }
    else { const int kb = r / 64, nb = r % 64;
        c.W = a.in[I_WD] + (size_t)(l * NE + e) * DE * D; c.N = D; c.WT = a.ws + WS_ED + (size_t)e * D * DEP; c.Kb = DEP; c.k0 = kb * 64; c.n0 = nb * 32; c.drow0 = nb * 32; c.scale = WSC_D; }
    return true;
}
__device__ __forceinline__ void conv_e(ArgsRef a, Ctx C, int l, int w0, int nw) {
    LAS float* scr = (LAS float*)(C.lds + C.wave * 8448);
    const int lane = C.lane, total = NE * 3 * 1408 + NE * 32;
    float cur[32], nxt[32]; ConvItem ci, cn; bool hc = false, hn = false;
    int it = w0;
    if (it < total) { hn = conv_e_item(a, l, it, cn);
        if (hn) {
#pragma unroll
            for (int i = 0; i < 32; ++i) nxt[i] = cn.W[(size_t)(cn.k0 + 2 * i + (lane >> 5)) * cn.N + cn.n0 + (lane & 31)]; } }
    for (; it < total; it += nw) {
        ci = cn; hc = hn;
#pragma unroll
        for (int i = 0; i < 32; ++i) cur[i] = nxt[i];
        const int itn = it + nw; hn = false;
        if (itn < total) { hn = conv_e_item(a, l, itn, cn);
            if (hn) {
#pragma unroll
                for (int i = 0; i < 32; ++i) nxt[i] = cn.W[(size_t)(cn.k0 + 2 * i + (lane >> 5)) * cn.N + cn.n0 + (lane & 31)]; } }
        if (!hc) {
            const int z = it - NE * 3 * 1408; unsigned char* row = a.ws + WS_ED + ((size_t)z * 64 + lane) * DEP + DE;
#pragma unroll
            for (int q = 0; q < 8; ++q) *(v4u*)(row + q * 16) = (v4u){0u, 0u, 0u, 0u};
            continue; }
#pragma unroll
        for (int i = 0; i < 32; ++i) scr[(2 * i + (lane >> 5)) * 33 + (lane & 31)] = cur[i];
        LDS_WAIT(); asm volatile("" ::: "memory");
        const int c = lane & 7;
#pragma unroll
        for (int jq = 0; jq < 4; ++jq) { const int n = (lane >> 3) + 8 * jq; const LAS float* sp = scr + (8 * c) * 33 + n; float v[8];
#pragma unroll
            for (int q = 0; q < 8; ++q) v[q] = sp[q * 33] * ci.scale;
            *(GAS v2u*)(ci.WT + (size_t)(ci.drow0 + n) * ci.Kb + ci.k0 + 8 * c) = pack8_fp8(v); }
        LDS_WAIT(); asm volatile("" ::: "memory");
    }
}
__device__ __forceinline__ void ph_ln1(ArgsRef a, Ctx C, int l) {
    const float* res_lat = l == 0 ? a.in[I_X] : a.out; const float* res_ctx = l == 0 ? a.in[I_CTX] : (const float*)(a.ws + WS_XSCTX);
    const float* mod = (const float*)(a.ws + WS_MOD) + (size_t)l * 5 * NADA; bf16* h = (bf16*)(a.ws + WS_H);
    ROWLOOP { const int b = r / LT, j = r - b * LT; const bool isctx = j < LC;
        const float* src = isctx ? res_ctx + ((size_t)b * LC + j) * D : res_lat + ((size_t)b * LL + (j - LC)) * D;
        const float* sh = mod + (size_t)(isctx ? 4 : b) * NADA; const float* sc = sh + D;
        f32x4 v[8]; float s = 0.f;
#pragma unroll
        for (int jj = 0; jj < 8; ++jj) { v[jj] = ((const f32x4*)src)[C.lane + 64 * jj]; s += (v[jj].x + v[jj].y) + (v[jj].z + v[jj].w); }
        const float mean = wave_sum(s) * (1.f / D); float s2 = 0.f;
#pragma unroll
        for (int jj = 0; jj < 8; ++jj) { v[jj] = v[jj] - mean; s2 += (v[jj].x * v[jj].x + v[jj].y * v[jj].y) + (v[jj].z * v[jj].z + v[jj].w * v[jj].w); }
        const float rstd = 1.f / sqrtf(wave_sum(s2) * (1.f / D) + LN_EPS);
        unsigned long long* o8 = (unsigned long long*)(h + (size_t)r * D);
#pragma unroll
        for (int jj = 0; jj < 8; ++jj) { const int q = C.lane + 64 * jj; const f32x4 scv = ((const f32x4*)sc)[q], shv = ((const f32x4*)sh)[q];
            const f32x4 o = v[jj] * rstd * (scv + 1.f) + shv;
            o8[q] = (unsigned long long)pk2(o.x, o.y) | ((unsigned long long)pk2(o.z, o.w) << 32); }
    }
}
__device__ __forceinline__ void ph_prep(ArgsRef a, Ctx C, int l) {
    LAS float* cosT = (LAS float*)C.lds; LAS float* sinT = cosT + 1024;
    for (int e = C.tid; e < 1024; e += NTHR) { const int pos = e >> 4, fi = e & 15; const float freq = exp2f(-(float)fi * (13.287712379549449f / 16.f));
        float rev = (float)pos * freq * 0.15915494309189535f; rev -= floorf(rev); cosT[e] = __builtin_amdgcn_cosf(rev); sinT[e] = __builtin_amdgcn_sinf(rev); }
    __syncthreads();
    const bf16* p = (const bf16*)(a.ws + WS_P); bf16* xc = (bf16*)(a.ws + T_XC); bf16* xbc = (bf16*)(a.ws + T_XBC); float* dtb = (float*)(a.ws + T_DT);
    bf16* Qr = (bf16*)(a.ws + T_QR); bf16* Kr = (bf16*)(a.ws + T_KR);
    const float* lcw = a.in[I_LCW] + (size_t)l * 4 * 1024; const float* lcb = a.in[I_LCB] + (size_t)l * 1024;
    const float* scw = a.in[I_SCW] + (size_t)l * 4 * 2048; const float* scb = a.in[I_SCB] + (size_t)l * 2048; const float* dtbias = a.in[I_SDTB] + l * 32;
    for (int item = C.vcu * NWAVES + C.wave; item < M / 2; item += C.G * NWAVES) {
        const int r0 = item * 2, b = r0 / LT, j0 = r0 - b * LT; const bool isctx = j0 < LC; const int seg_lo = isctx ? 0 : LC, seg_hi = isctx ? LC : LT;
        const bf16* prow0 = p + (size_t)r0 * NP;
        const int hh = C.lane >> 3, mm = (C.lane >> 2) & 1, ax = (C.lane >> 1) & 1, ih = C.lane & 1, base = hh * 128 + mm * 64 + ax * 32 + ih * 8;
        v4u rq[2][4]; unsigned short dtraw[2];
#pragma unroll
        for (int rr = 0; rr < 2; ++rr) { const bf16* prow = prow0 + (size_t)rr * NP;
            rq[rr][0] = *(const v4u*)(prow + P_Q + base); rq[rr][1] = *(const v4u*)(prow + P_Q + base + 16); rq[rr][2] = *(const v4u*)(prow + P_K + base); rq[rr][3] = *(const v4u*)(prow + P_K + base + 16);
            dtraw[rr] = prow[P_DT + (C.lane & 31)]; }
#pragma unroll 1
        for (int hb = 0; hb < 2; ++hb) {
            v4u xr[3][5];
#pragma unroll
            for (int u = 0; u < 3; ++u) { const int it = hb * 3 + u; const bool lru = it < 2; const int c = (lru ? it : it - 2) * 512 + C.lane * 8; const int pofs = (lru ? P_LRUX : P_XBC) + c;
#pragma unroll
                for (int k = 0; k < 5; ++k) { const int jj = j0 - 2 + k; xr[u][k] = (jj >= seg_lo && jj < seg_hi) ? *(const v4u*)(prow0 + (ptrdiff_t)(k - 2) * NP + pofs) : (v4u){0u, 0u, 0u, 0u}; } }
#pragma unroll
            for (int u = 0; u < 3; ++u) { const int it = hb * 3 + u; const bool lru = it < 2; const int c = (lru ? it : it - 2) * 512 + C.lane * 8;
                const float* wq = lru ? lcw + c : scw + c; const int wstride = lru ? 1024 : 2048; const float* bq = lru ? lcb + c : scb + c;
                float xin[5][8];
#pragma unroll
                for (int k = 0; k < 5; ++k) unpack8(xr[u][k], xin[k]);
                float w[4][8], bias[8];
#pragma unroll
                for (int tap = 0; tap < 4; ++tap) { const f32x4 w0 = *(const f32x4*)(wq + tap * wstride), w1 = *(const f32x4*)(wq + tap * wstride + 4);
                    w[tap][0] = w0.x; w[tap][1] = w0.y; w[tap][2] = w0.z; w[tap][3] = w0.w; w[tap][4] = w1.x; w[tap][5] = w1.y; w[tap][6] = w1.z; w[tap][7] = w1.w; }
                { const f32x4 b0 = *(const f32x4*)bq, b1 = *(const f32x4*)(bq + 4); bias[0] = b0.x; bias[1] = b0.y; bias[2] = b0.z; bias[3] = b0.w; bias[4] = b1.x; bias[5] = b1.y; bias[6] = b1.z; bias[7] = b1.w; }
#pragma unroll
                for (int rr = 0; rr < 2; ++rr) { float acc[8];
#pragma unroll
                    for (int q = 0; q < 8; ++q) { float v = bias[q];
#pragma unroll
                        for (int tap = 0; tap < 4; ++tap) v += w[tap][q] * xin[rr + tap][q];
                        acc[q] = lru ? v : siluf_(v); }
                    if (lru) *(v4u*)(xc + (size_t)(r0 + rr) * 1024 + c) = pack8(acc); else *(v4u*)(xbc + (size_t)(r0 + rr) * 2048 + c) = pack8(acc); } }
        }
#pragma unroll
        for (int rr = 0; rr < 2; ++rr) { const int r = r0 + rr, j = j0 + rr;
            if (C.lane < 32) { const float v = __builtin_bit_cast(float, (unsigned)dtraw[rr] << 16) + dtbias[C.lane]; dtb[(size_t)r * 32 + C.lane] = softplusf_(v); }
            float cs[8], sn[8];
            if (!isctx) { const int t = j - LC, pos = ax == 0 ? (t >> 6) : (t & 63);
#pragma unroll
                for (int q = 0; q < 8; ++q) { cs[q] = cosT[pos * 16 + ih * 8 + q]; sn[q] = sinT[pos * 16 + ih * 8 + q]; } }
            else {
#pragma unroll
                for (int q = 0; q < 8; ++q) { cs[q] = 1.f; sn[q] = 0.f; } }
#pragma unroll
            for (int w = 0; w < 2; ++w) { const float scl = w == 0 ? QSCALE : 1.f; bf16* dst = (w == 0 ? Qr : Kr) + (size_t)r * 1024 + base;
                float x1[8], x2[8], o1[8], o2[8]; unpack8(rq[rr][2 * w], x1); unpack8(rq[rr][2 * w + 1], x2);
#pragma unroll
                for (int q = 0; q < 8; ++q) { o1[q] = (x1[q] * cs[q] - x2[q] * sn[q]) * scl; o2[q] = (x1[q] * sn[q] + x2[q] * cs[q]) * scl; }
                *(v4u*)dst = pack8(o1); *(v4u*)(dst + 16) = pack8(o2); } }
    }
    __syncthreads();
}
__device__ __forceinline__ void ph_lru_s1(ArgsRef a, Ctx C) {
    const bf16* la = (const bf16*)(a.ws + T_LA); const bf16* bb = (const bf16*)(a.ws + T_BB); float* aggA = (float*)(a.ws + T_AGGA); float* aggB = (float*)(a.ws + T_AGGB);
    for (int i = C.vcu * NTHR + C.tid; i < 2 * NB * NCH * 512; i += C.G * NTHR) {
        const int c2 = i & 511, qq = i >> 9, q = qq % NCH, b = (qq / NCH) & 3, d = qq / (NCH * 4); const int row0 = b * LT + q * 32;
        const unsigned* lap = (const unsigned*)(la + ((size_t)d * M + row0) * 1024) + c2; const unsigned* bbp = (const unsigned*)(bb + ((size_t)d * M + row0) * 1024) + c2;
        float A0 = 1.f, A1 = 1.f, B0 = 0.f, B1 = 0.f;
#pragma unroll 8
        for (int tt = 0; tt < 32; ++tt) { const int t = d == 0 ? tt : 31 - tt; const unsigned wl = lap[t * 512], wb = bbp[t * 512];
            const float a0 = __builtin_amdgcn_exp2f(bflo(wl)), a1 = __builtin_amdgcn_exp2f(bfhi(wl));
            A0 *= a0; A1 *= a1; B0 = a0 * B0 + bflo(wb); B1 = a1 * B1 + bfhi(wb); }
        const size_t idx = ((size_t)(d * NB + b) * NCH + q) * 1024 + 2 * c2;
        *(f32x2*)(aggA + idx) = (f32x2){A0, A1}; *(f32x2*)(aggB + idx) = (f32x2){B0, B1}; }
}
__device__ __forceinline__ void lru_s2_item(ArgsRef a, int it, int lane) {
    const float* aggA = (const float*)(a.ws + T_AGGA); const float* aggB = (const float*)(a.ws + T_AGGB); float* cin = (float*)(a.ws + T_CIN);
    const int cg = it & 15, b = (it >> 4) & 3, d = it >> 6, c = cg * 64 + lane;
    const size_t base = ((size_t)(d * NB + b) * NCH) * 1024 + c; float carry = 0.f;
#pragma unroll 8
    for (int s = 0; s < NCH; ++s) { const int q = d == 0 ? s : (s < 8 ? 7 - s : NCH + 7 - s);
        const float A = aggA[base + (size_t)q * 1024], Bv = aggB[base + (size_t)q * 1024]; cin[base + (size_t)q * 1024] = carry; carry = A * carry + Bv; }
}
__device__ __forceinline__ void ph_lru_s3(ArgsRef a, Ctx C, int l) {
    const bf16* la = (const bf16*)(a.ws + T_LA); const bf16* bb = (const bf16*)(a.ws + T_BB); const float* cin = (const float*)(a.ws + T_CIN);
    const bf16* p = (const bf16*)(a.ws + WS_P); bf16* out = (bf16*)(a.ws + WS_BR);
    LAS v2u* hfl = (LAS v2u*)C.lds + C.tid;
    const int nchq = (l == DEPTH - 1) ? 128 : NCH, nitems = NB * nchq * 256;
    for (int i = C.vcu * NTHR + C.tid; i < nitems; i += C.G * NTHR) {
        const int c4 = i & 255, qq = i >> 8, q = (l == DEPTH - 1) ? 8 + (qq & 127) : qq % NCH, b = (l == DEPTH - 1) ? (qq >> 7) : qq / NCH; const int row0 = b * LT + q * 32;
        const v2u* la0 = (const v2u*)(la + (size_t)row0 * 1024) + c4; const v2u* bb0 = (const v2u*)(bb + (size_t)row0 * 1024) + c4;
        const v2u* la1 = la0 + (size_t)M * 256; const v2u* bb1 = bb0 + (size_t)M * 256;
        const v2u* gp = (const v2u*)(p + (size_t)row0 * NP + P_LRUG) + c4; v2u* op = (v2u*)(out + (size_t)row0 * 1024) + c4;
        const f32x4 ci0 = *(const f32x4*)(cin + ((size_t)(0 * NB + b) * NCH + q) * 1024 + 4 * c4), ci1 = *(const f32x4*)(cin + ((size_t)(1 * NB + b) * NCH + q) * 1024 + 4 * c4);
        f32x4 h = ci0;
#pragma unroll
        for (int g = 0; g < 4; ++g) {
            v2u wl[8], wb[8];
#pragma unroll
            for (int u = 0; u < 8; ++u) { wl[u] = la0[(g * 8 + u) * 256]; wb[u] = bb0[(g * 8 + u) * 256]; }
#pragma unroll
            for (int u = 0; u < 8; ++u) { const int t = g * 8 + u;
                h.x = __builtin_amdgcn_exp2f(bflo(wl[u].x)) * h.x + bflo(wb[u].x); h.y = __builtin_amdgcn_exp2f(bfhi(wl[u].x)) * h.y + bfhi(wb[u].x);
                h.z = __builtin_amdgcn_exp2f(bflo(wl[u].y)) * h.z + bflo(wb[u].y); h.w = __builtin_amdgcn_exp2f(bfhi(wl[u].y)) * h.w + bfhi(wb[u].y);
                hfl[t * 512] = (v2u){pk2(h.x, h.y), pk2(h.z, h.w)}; }
            asm volatile("" ::: "memory"); }
        h = ci1;
#pragma unroll
        for (int g = 0; g < 4; ++g) {
            v2u wl[8], wb[8], gw[8];
#pragma unroll
            for (int u = 0; u < 8; ++u) { const int t = 31 - (g * 8 + u); wl[u] = la1[t * 256]; wb[u] = bb1[t * 256]; gw[u] = gp[(size_t)t * (NP / 4)]; }
#pragma unroll
            for (int u = 0; u < 8; ++u) { const int t = 31 - (g * 8 + u);
                h.x = __builtin_amdgcn_exp2f(bflo(wl[u].x)) * h.x + bflo(wb[u].x); h.y = __builtin_amdgcn_exp2f(bfhi(wl[u].x)) * h.y + bfhi(wb[u].x);
                h.z = __builtin_amdgcn_exp2f(bflo(wl[u].y)) * h.z + bflo(wb[u].y); h.w = __builtin_amdgcn_exp2f(bfhi(wl[u].y)) * h.w + bfhi(wb[u].y);
                const v2u hf = hfl[t * 512];
                op[t * 256] = (v2u){pk2((bflo(hf.x) + h.x) * gelu_tanh(bflo(gw[u].x)), (bfhi(hf.x) + h.y) * gelu_tanh(bfhi(gw[u].x))), pk2((bflo(hf.y) + h.z) * gelu_tanh(bflo(gw[u].y)), (bfhi(hf.y) + h.w) * gelu_tanh(bfhi(gw[u].y)))}; }
            asm volatile("" ::: "memory"); }
    }
    __syncthreads();
}
__device__ __forceinline__ void ph_ssd_scan(ArgsRef a, Ctx C, int l) {
    LAS float* Xs = (LAS float*)C.lds; LAS float* Bs = Xs + 64 * 64; LAS float* Cs = Bs + 64 * 128; LAS float* Ys = Cs + 64 * 128; LAS float* dts = Ys + 64 * 64;
    const bf16* xbc = (const bf16*)(a.ws + T_XBC); const float* dtb = (const float*)(a.ws + T_DT); bf16* ssdy = (bf16*)(a.ws + T_SSDY);
    const int p_ = C.tid >> 3, ng = C.tid & 7, n0 = ng * 16;
    for (int it = C.vcu; it < 128; it += C.G) { const int h = it & 15, d = (it >> 4) & 1, b = it >> 5, g = h >> 2;
        const float Aneg = -__expf(a.in[I_SALOG][(l * 2 + d) * 16 + h]);
        float S[16];
#pragma unroll
        for (int n = 0; n < 16; ++n) S[n] = 0.f;
        for (int ci = 0; ci < 68; ++ci) { const int q = d == 0 ? ci : (ci < 4 ? 3 - ci : 71 - ci); const int row0 = b * LT + q * 64;
            { const int rr = C.tid >> 3, cc = (C.tid & 7) * 8; float x8[8]; unpack8(*(const v4u*)(xbc + (size_t)(row0 + rr) * 2048 + h * 64 + cc), x8);
              *(LAS f32x4*)(Xs + rr * 64 + cc) = (f32x4){x8[0], x8[1], x8[2], x8[3]}; *(LAS f32x4*)(Xs + rr * 64 + cc + 4) = (f32x4){x8[4], x8[5], x8[6], x8[7]}; }
#pragma unroll
            for (int rep = 0; rep < 2; ++rep) { const int idx = C.tid + rep * 512, rr = idx >> 4, cc = (idx & 15) * 8; float b8[8], c8[8];
                unpack8(*(const v4u*)(xbc + (size_t)(row0 + rr) * 2048 + 1024 + g * 128 + cc), b8); unpack8(*(const v4u*)(xbc + (size_t)(row0 + rr) * 2048 + 1536 + g * 128 + cc), c8);
                *(LAS f32x4*)(Bs + rr * 128 + cc) = (f32x4){b8[0], b8[1], b8[2], b8[3]}; *(LAS f32x4*)(Bs + rr * 128 + cc + 4) = (f32x4){b8[4], b8[5], b8[6], b8[7]};
                *(LAS f32x4*)(Cs + rr * 128 + cc) = (f32x4){c8[0], c8[1], c8[2], c8[3]}; *(LAS f32x4*)(Cs + rr * 128 + cc + 4) = (f32x4){c8[4], c8[5], c8[6], c8[7]}; }
            if (C.tid < 64) { const float dtv = dtb[(size_t)(row0 + C.tid) * 32 + d * 16 + h]; dts[C.tid] = dtv; dts[64 + C.tid] = __expf(dtv * Aneg); }
            __syncthreads();
            for (int tt = 0; tt < 64; ++tt) { const int t = d == 0 ? tt : 63 - tt; const float dt = dts[t], dec = dts[64 + t], xv = Xs[t * 64 + p_] * dt;
                f32x4 Bv[4], Cv[4];
#pragma unroll
                for (int q4 = 0; q4 < 4; ++q4) { Bv[q4] = *(const LAS f32x4*)(Bs + t * 128 + n0 + 4 * q4); Cv[q4] = *(const LAS f32x4*)(Cs + t * 128 + n0 + 4 * q4); }
                float y = 0.f;
#pragma unroll
                for (int n = 0; n < 16; ++n) { S[n] = dec * S[n] + xv * Bv[n >> 2][n & 3]; y += S[n] * Cv[n >> 2][n & 3]; }
                y += __shfl_xor(y, 1); y += __shfl_xor(y, 2); y += __shfl_xor(y, 4);
                if (ng == 0) Ys[t * 64 + p_] = y; }
            __syncthreads();
            { const int rr = C.tid >> 3, cc = (C.tid & 7) * 8; float y8[8]; const f32x4 y0 = *(const LAS f32x4*)(Ys + rr * 64 + cc), y1 = *(const LAS f32x4*)(Ys + rr * 64 + cc + 4);
              y8[0] = y0.x; y8[1] = y0.y; y8[2] = y0.z; y8[3] = y0.w; y8[4] = y1.x; y8[5] = y1.y; y8[6] = y1.z; y8[7] = y1.w;
              *(v4u*)(ssdy + ((size_t)d * M + row0 + rr) * 1024 + h * 64 + cc) = pack8(y8); }
        }
        __syncthreads();
    }
}
__device__ __forceinline__ void ph_attn_naive(ArgsRef a, Ctx C) {
    LAS float* Ks = (LAS float*)C.lds; LAS float* Vs = Ks + 64 * 64;
    const bf16* Qr = (const bf16*)(a.ws + T_QR); const bf16* Kr = (const bf16*)(a.ws + T_KR); const bf16* p = (const bf16*)(a.ws + WS_P); bf16* otmp = (bf16*)(a.ws + T_OTMP);
    const int qi = C.tid >> 2, part = C.tid & 3;
    for (int u = C.vcu; u < 2048 + 128; u += C.G) {
        int qb, hm, b; bool isctx;
        if (u < 2048) { qb = u & 31; hm = (u >> 5) & 15; b = u >> 9; isctx = false; } else { const int u2 = u - 2048; qb = u2 & 1; hm = (u2 >> 1) & 15; b = u2 >> 5; isctx = true; }
        const int qrow = b * LT + (isctx ? 0 : LC) + qb * 128 + qi, kv0 = b * LT, nkt = isctx ? 4 : 68, hh = hm >> 1, qcol = hh * 128 + (hm & 1) * 64;
        float q[16];
        { float t8[8]; unpack8(*(const v4u*)(Qr + (size_t)qrow * 1024 + qcol + part * 16), t8);
#pragma unroll
          for (int j = 0; j < 8; ++j) q[j] = t8[j];
          unpack8(*(const v4u*)(Qr + (size_t)qrow * 1024 + qcol + part * 16 + 8), t8);
#pragma unroll
          for (int j = 0; j < 8; ++j) q[8 + j] = t8[j]; }
        float o[32], mrun = -1e30f, lsum = 0.f;
#pragma unroll
        for (int j = 0; j < 32; ++j) o[j] = 0.f;
        for (int kt = 0; kt < nkt; ++kt) {
            __syncthreads();
            { const int rr = C.tid >> 3, cc = (C.tid & 7) * 8; float k8[8]; unpack8(*(const v4u*)(Kr + (size_t)(kv0 + kt * 64 + rr) * 1024 + qcol + cc), k8);
              *(LAS f32x4*)(Ks + rr * 64 + cc) = (f32x4){k8[0], k8[1], k8[2], k8[3]}; *(LAS f32x4*)(Ks + rr * 64 + cc + 4) = (f32x4){k8[4], k8[5], k8[6], k8[7]}; }
#pragma unroll
            for (int rep = 0; rep < 2; ++rep) { const int idx = C.tid + rep * 512, rr = idx >> 4, cc = (idx & 15) * 8; float v8[8];
                unpack8(*(const v4u*)(p + (size_t)(kv0 + kt * 64 + rr) * NP + P_V + hh * 128 + cc), v8);
                *(LAS f32x4*)(Vs + rr * 128 + cc) = (f32x4){v8[0], v8[1], v8[2], v8[3]}; *(LAS f32x4*)(Vs + rr * 128 + cc + 4) = (f32x4){v8[4], v8[5], v8[6], v8[7]}; }
            __syncthreads();
#pragma unroll 1
            for (int g8 = 0; g8 < 8; ++g8) {
                float s[8];
#pragma unroll
                for (int j = 0; j < 8; ++j) { const LAS float* kp = Ks + (g8 * 8 + j) * 64 + part * 16; float acc = 0.f;
#pragma unroll
                    for (int q4 = 0; q4 < 4; ++q4) { const f32x4 kv = *(const LAS f32x4*)(kp + 4 * q4); acc += q[4 * q4] * kv.x + q[4 * q4 + 1] * kv.y + q[4 * q4 + 2] * kv.z + q[4 * q4 + 3] * kv.w; }
                    acc += __shfl_xor(acc, 1); acc += __shfl_xor(acc, 2); s[j] = acc; }
                float mx = s[0];
#pragma unroll
                for (int j = 1; j < 8; ++j) mx = fmaxf(mx, s[j]);
                const float mnew = fmaxf(mrun, mx), alpha = __builtin_amdgcn_exp2f(mrun - mnew); mrun = mnew; lsum *= alpha;
#pragma unroll
                for (int j = 0; j < 32; ++j) o[j] *= alpha;
#pragma unroll
                for (int j = 0; j < 8; ++j) { const float pj = __builtin_amdgcn_exp2f(s[j] - mnew); lsum += pj; const LAS float* vp = Vs + (g8 * 8 + j) * 128 + part * 32;
#pragma unroll
                    for (int q4 = 0; q4 < 8; ++q4) { const f32x4 vv = *(const LAS f32x4*)(vp + 4 * q4); o[4 * q4] += pj * vv.x; o[4 * q4 + 1] += pj * vv.y; o[4 * q4 + 2] += pj * vv.z; o[4 * q4 + 3] += pj * vv.w; } }
            }
        }
        const float inv = 1.f / lsum; bf16* op = otmp + (size_t)qrow * 2048 + hm * 128 + part * 32;
#pragma unroll
        for (int q8 = 0; q8 < 4; ++q8) { float t8[8];
#pragma unroll
            for (int j = 0; j < 8; ++j) t8[j] = o[q8 * 8 + j] * inv;
            *(v4u*)(op + q8 * 8) = pack8(t8); }
    }
    __syncthreads();
}
namespace att {
using f32x16 = __attribute__((ext_vector_type(16))) float;
using s16x4 = __attribute__((ext_vector_type(4))) short;
constexpr int SHM_V = 64 * 128 * 2, SHM_K = 64 * 64 * 2;
constexpr float THR2 = 11.5f;
#define KSWZ64(row, colB) ((row) * 128 + ((colB) ^ ((((row) >> 1) & 7) << 4)))
#define SBAR() __builtin_amdgcn_sched_barrier(0)
__device__ __forceinline__ int crow(int r, int hi) { return (r & 3) + 8 * (r >> 2) + 4 * hi; }
__device__ __forceinline__ unsigned cvtpk(float lo, float hi) { unsigned r; asm volatile("v_cvt_pk_bf16_f32 %0, %1, %2" : "=v"(r) : "v"(lo), "v"(hi)); return r; }
__device__ __forceinline__ void partialSM(f32x16& p0, f32x16& p1, float& m_reg, float& mn, float& alpha) {
    float pmax = p0[0];
#pragma unroll
    for (int r = 1; r < 16; ++r) pmax = fmaxf(pmax, p0[r]);
#pragma unroll
    for (int r = 0; r < 16; ++r) pmax = fmaxf(pmax, p1[r]);
    { auto rr = __builtin_amdgcn_permlane32_swap(__float_as_uint(pmax), __float_as_uint(pmax), false, false); pmax = fmaxf(__uint_as_float(rr[0]), __uint_as_float(rr[1])); }
    if (__builtin_expect(__all(pmax - m_reg <= THR2), 1)) { mn = m_reg; alpha = 1.f; }
    else { mn = fmaxf(m_reg, pmax); alpha = __builtin_amdgcn_exp2f(m_reg - mn); m_reg = mn; }
#pragma unroll
    for (int r = 0; r < 16; ++r) { p0[r] = p0[r] - mn; p1[r] = p1[r] - mn; }
#pragma unroll
    for (int r = 0; r < 16; ++r) p0[r] = __builtin_amdgcn_exp2f(p0[r]);
}
__device__ __forceinline__ void finishSM(f32x16& p0, f32x16& p1, float alpha, float& l_reg, bf16x8& pa0, bf16x8& pa1, bf16x8& pa2, bf16x8& pa3) {
#pragma unroll
    for (int r = 0; r < 16; ++r) p1[r] = __builtin_amdgcn_exp2f(p1[r]);
    float ps = 0.f;
#pragma unroll
    for (int r = 0; r < 16; ++r) ps += p0[r];
#pragma unroll
    for (int r = 0; r < 16; ++r) ps += p1[r];
    { auto rr = __builtin_amdgcn_permlane32_swap(__float_as_uint(ps), __float_as_uint(ps), false, false); ps = __uint_as_float(rr[0]) + __uint_as_float(rr[1]); }
    l_reg = l_reg * alpha + ps;
#define PK4(P, BASE, OUT) do { unsigned a0 = cvtpk(P[BASE + 0], P[BASE + 1]), a1 = cvtpk(P[BASE + 2], P[BASE + 3]); \
    unsigned b0 = cvtpk(P[BASE + 4], P[BASE + 5]), b1 = cvtpk(P[BASE + 6], P[BASE + 7]); \
    auto r0 = __builtin_amdgcn_permlane32_swap(a0, b0, false, false); auto r1 = __builtin_amdgcn_permlane32_swap(a1, b1, false, false); \
    v4u w = {r0[0], r1[0], r0[1], r1[1]}; OUT = __builtin_bit_cast(bf16x8, w); } while (0)
    PK4(p0, 0, pa0); PK4(p0, 8, pa1); PK4(p1, 0, pa2); PK4(p1, 8, pa3);
#undef PK4
}
__device__ __forceinline__ void qkt(f32x16& p0, f32x16& p1, const LAS char* Ks, const bf16x8* qr, int r32, int hi) {
    p0 = f32x16{}; p1 = f32x16{};
#pragma unroll
    for (int d0 = 0; d0 < 4; ++d0) { const int cb = (d0 * 16 + hi * 8) * 2;
        const bf16x8 b0 = *(const LAS bf16x8*)(Ks + KSWZ64(r32, cb));
        const bf16x8 b1 = *(const LAS bf16x8*)(Ks + KSWZ64(32 + r32, cb));
        p0 = __builtin_amdgcn_mfma_f32_32x32x16_bf16(b0, qr[d0], p0, 0, 0, 0);
        p1 = __builtin_amdgcn_mfma_f32_32x32x16_bf16(b1, qr[d0], p1, 0, 0, 0); }
}
__device__ __forceinline__ int v_st(int k, int c) { const int kk = (k & ~0xC) | ((k & 4) << 1) | ((k & 8) >> 1); return ((kk >> 3) * 4 + (c >> 5)) * 512 + ((kk & 7) * 32 + (c & 31)) * 2; }
__device__ __forceinline__ int v_rd_base(int lane) { return ((lane & 3) << 3) | (((lane >> 2) & 3) << 6) | (((lane >> 4) & 1) << 5) | (((lane >> 5) & 1) << 8); }
constexpr int v_rd_off(int d0, int ks, int half) { return d0 * 512 + ks * 4096 + half * 2048; }
template <int OFF> __device__ __forceinline__ s16x4 tr_read(int vb) { s16x4 r; asm volatile("ds_read_b64_tr_b16 %0, %1 offset:%2" : "=&v"(r) : "v"(vb), "i"(OFF) : "memory"); return r; }
template <int D0> __device__ __forceinline__ void pv_one(f32x16& od, int vb, bf16x8 pa0, bf16x8 pa1, bf16x8 pa2, bf16x8 pa3) {
    const s16x4 l0 = tr_read<v_rd_off(D0, 0, 0)>(vb), h0 = tr_read<v_rd_off(D0, 0, 1)>(vb), l1 = tr_read<v_rd_off(D0, 1, 0)>(vb), h1 = tr_read<v_rd_off(D0, 1, 1)>(vb);
    const s16x4 l2 = tr_read<v_rd_off(D0, 2, 0)>(vb), h2 = tr_read<v_rd_off(D0, 2, 1)>(vb), l3 = tr_read<v_rd_off(D0, 3, 0)>(vb), h3 = tr_read<v_rd_off(D0, 3, 1)>(vb);
    asm volatile("s_waitcnt lgkmcnt(0)" ::: "memory"); SBAR();
#define PK(L, H) (bf16x8){L[0], L[1], L[2], L[3], H[0], H[1], H[2], H[3]}
    od = __builtin_amdgcn_mfma_f32_32x32x16_bf16(pa0, PK(l0, h0), od, 0, 0, 0);
    od = __builtin_amdgcn_mfma_f32_32x32x16_bf16(pa1, PK(l1, h1), od, 0, 0, 0);
    od = __builtin_amdgcn_mfma_f32_32x32x16_bf16(pa2, PK(l2, h2), od, 0, 0, 0);
    od = __builtin_amdgcn_mfma_f32_32x32x16_bf16(pa3, PK(l3, h3), od, 0, 0, 0);
#undef PK
}
__device__ __forceinline__ void pv_d0(f32x16* o, int vb, bf16x8 pa0, bf16x8 pa1, bf16x8 pa2, bf16x8 pa3) {
    pv_one<0>(o[0], vb, pa0, pa1, pa2, pa3); pv_one<1>(o[1], vb, pa0, pa1, pa2, pa3); pv_one<2>(o[2], vb, pa0, pa1, pa2, pa3); pv_one<3>(o[3], vb, pa0, pa1, pa2, pa3);
}
__device__ __forceinline__ void attn_unit(const bf16* __restrict__ Qb, const bf16* __restrict__ Kh, const bf16* __restrict__ Vh, bf16* __restrict__ Ob, int seq, LAS char* lds, int tid) {
    const int wid = __builtin_amdgcn_readfirstlane(tid >> 6), lane = tid & 63, r32 = lane & 31, hi = lane >> 5;
    LAS char* V_lds = lds; LAS char* K_lds = lds + 2 * SHM_V;
    LAS float* wsf = (LAS float*)(lds + 2 * SHM_V + 2 * SHM_K) + wid * 64; LAS float* li_l = wsf; LAS float* al_l = wsf + 32;
    float m_reg = -1e30f, l_reg = 0.f; f32x16 o[4] = {}; bf16x8 qr[4];
    const bf16* Qw = Qb + (size_t)(wid * 32 + r32) * 1024 + hi * 8;
#pragma unroll
    for (int d0 = 0; d0 < 4; ++d0) qr[d0] = *(const bf16x8*)(Qw + d0 * 16);
    const int sr = tid >> 4, sc = (tid & 15) * 8, vst0 = v_st(sr, sc), vst1 = v_st(32 + sr, sc);
    const int kr = tid >> 3, kc = (tid & 7) * 8, kst = KSWZ64(kr, kc * 2);
    const int vb0 = (int)(unsigned)(size_t)V_lds + v_rd_base(lane);
    struct { bf16x8 vs0, vs1, ks0; } sr_[2];
#define SLOAD(i, k0) do { sr_[i].vs0 = *(const bf16x8*)(Vh + (size_t)((k0) + sr) * NP + sc); sr_[i].vs1 = *(const bf16x8*)(Vh + (size_t)((k0) + 32 + sr) * NP + sc); \
    sr_[i].ks0 = *(const bf16x8*)(Kh + (size_t)((k0) + kr) * 1024 + kc); } while (0)
#define SWRITE(b, i) do { *(LAS bf16x8*)(V_lds + (b) * SHM_V + vst0) = sr_[i].vs0; *(LAS bf16x8*)(V_lds + (b) * SHM_V + vst1) = sr_[i].vs1; \
    *(LAS bf16x8*)(K_lds + (b) * SHM_K + kst) = sr_[i].ks0; } while (0)
#define SWAIT() asm volatile("s_waitcnt vmcnt(3)" ::: "memory")
#define RESC(a) do { if (__any((a) < 1.f)) { if (hi == 0) al_l[r32] = (a); asm volatile("s_waitcnt lgkmcnt(0)" ::: "memory"); \
    _Pragma("unroll") for (int d = 0; d < 4; ++d) _Pragma("unroll") for (int r = 0; r < 16; ++r) o[d][r] *= al_l[crow(r, hi)]; } } while (0)
    f32x16 pA0, pA1, pB0, pB1; float mnA, mnB, alA, alB; bf16x8 pa0, pa1, pa2, pa3; const int NT = seq / 64;
    constexpr int SE = 0, SO = 1;
    SLOAD(SE, 0); asm volatile("s_waitcnt vmcnt(0)" ::: "memory"); SWRITE(0, SE); __syncthreads();
    qkt(pA0, pA1, K_lds, qr, r32, hi); partialSM(pA0, pA1, m_reg, mnA, alA);
    SLOAD(SO, 64); if (2 < NT) SLOAD(SE, 2 * 64);
    SWAIT(); SWRITE(1, SO); __syncthreads();
    for (int j = 1; j + 1 < NT; j += 2) {
        SBAR(); qkt(pB0, pB1, K_lds + SHM_K, qr, r32, hi);
        finishSM(pA0, pA1, alA, l_reg, pa0, pa1, pa2, pa3); SBAR();
        SLOAD(SO, (j + 2) * 64); SBAR();
        pv_d0(o, vb0, pa0, pa1, pa2, pa3); partialSM(pB0, pB1, m_reg, mnB, alB);
        __syncthreads(); SWAIT(); SWRITE(0, SE);
        RESC(alB); __syncthreads();
        SBAR(); qkt(pA0, pA1, K_lds, qr, r32, hi);
        finishSM(pB0, pB1, alB, l_reg, pa0, pa1, pa2, pa3); SBAR();
        if (j + 3 < NT) SLOAD(SE, (j + 3) * 64); SBAR();
        pv_d0(o, vb0 + SHM_V, pa0, pa1, pa2, pa3); partialSM(pA0, pA1, m_reg, mnA, alA);
        __syncthreads(); SWAIT(); SWRITE(1, SO);
        RESC(alA); __syncthreads();
    }
    SBAR(); qkt(pB0, pB1, K_lds + SHM_K, qr, r32, hi);
    finishSM(pA0, pA1, alA, l_reg, pa0, pa1, pa2, pa3); SBAR();
    pv_d0(o, vb0, pa0, pa1, pa2, pa3); partialSM(pB0, pB1, m_reg, mnB, alB);
    __syncthreads(); RESC(alB);
    finishSM(pB0, pB1, alB, l_reg, pa0, pa1, pa2, pa3); SBAR();
    pv_d0(o, vb0 + SHM_V, pa0, pa1, pa2, pa3);
    if (hi == 0) li_l[r32] = l_reg; asm volatile("s_waitcnt lgkmcnt(0)" ::: "memory");
    float rli[16];
#pragma unroll
    for (int r = 0; r < 16; ++r) rli[r] = __builtin_amdgcn_rcpf(li_l[crow(r, hi)]);
    bf16* Ow = Ob + (size_t)(wid * 32) * 2048;
#pragma unroll
    for (int r = 0; r < 16; ++r) { const int orow = crow(r, hi);
#pragma unroll
        for (int d0 = 0; d0 < 4; ++d0) Ow[(size_t)orow * 2048 + d0 * 32 + r32] = (bf16)f2bf(o[d0][r] * rli[r]); }
    __syncthreads();
#undef SLOAD
#undef SWRITE
#undef SWAIT
#undef RESC
}
}
namespace ssd {
using att::f32x16; using att::s16x4;
constexpr int IMG = 16384;
#define KSWZ128(row, colB) ((row) * 256 + ((colB) ^ (((row) & 7) << 4)))
template <int OFF> __device__ __forceinline__ s16x4 trr(int vb) { s16x4 r; asm volatile("ds_read_b64_tr_b16 %0, %1 offset:%2" : "=&v"(r) : "v"(vb), "i"(OFF) : "memory"); return r; }
#define SSD_PK(L, H) (bf16x8){L[0], L[1], L[2], L[3], H[0], H[1], H[2], H[3]}
__device__ __forceinline__ void ssd_item(const bf16* __restrict__ xbc, const float* __restrict__ dtb, bf16* __restrict__ ssdy, float Aneg2, int b, int d, int h, LAS char* lds, int tid) {
    const int wid = __builtin_amdgcn_readfirstlane(tid >> 6), lane = tid & 63, r32 = lane & 31, hi = lane >> 5, g = h >> 2;
    const bool ywave = wid < 4; const int tb = wid & 1, pb = (wid >> 1) & 1, pb2 = wid & 1, nb = wid >> 1;
    LAS char* Ss = lds + 8 * IMG; LAS float* cumw = (LAS float*)(lds + 9 * IMG) + wid * 128;
    const int ldsb = (int)(unsigned)(size_t)lds;
    const int sa = tid >> 4, cB = (tid & 15) * 8, sx = tid >> 3, cX = (tid & 7) * 8;
    const int kst_a = KSWZ128(sa, cB * 2), kst_b = KSWZ128(32 + sa, cB * 2), vst_a = att::v_st(sa, cB), vst_b = att::v_st(32 + sa, cB), xst_d = att::v_st(sx, cX), xst_s = att::v_st(sx, 64 + cX);
    const int rdb = att::v_rd_base(lane);
    f32x16 sacc = {};
    { LAS v4u* z = (LAS v4u*)(Ss + tid * 32); z[0] = (v4u){0u, 0u, 0u, 0u}; z[1] = (v4u){0u, 0u, 0u, 0u}; }
    bf16x8 nb0, nb1, nc0, nc1, nx; float ndt; float cum2 = 0.f;
#define SSD_ROW0(ci) (b * LT + ((d == 0) ? (ci) : ((ci) < 4 ? 3 - (ci) : 71 - (ci))) * 64)
#define SSD_ROW(r0, s) ((r0) + ((d == 0) ? (s) : 63 - (s)))
#define SSD_LOAD(ci) do { const int r0_ = SSD_ROW0(ci); \
        nb0 = *(const bf16x8*)(xbc + (size_t)SSD_ROW(r0_, sa) * 2048 + 1024 + g * 128 + cB); nb1 = *(const bf16x8*)(xbc + (size_t)SSD_ROW(r0_, 32 + sa) * 2048 + 1024 + g * 128 + cB); \
        nc0 = *(const bf16x8*)(xbc + (size_t)SSD_ROW(r0_, sa) * 2048 + 1536 + g * 128 + cB); nc1 = *(const bf16x8*)(xbc + (size_t)SSD_ROW(r0_, 32 + sa) * 2048 + 1536 + g * 128 + cB); \
        nx = *(const bf16x8*)(xbc + (size_t)SSD_ROW(r0_, sx) * 2048 + h * 64 + cX); ndt = dtb[(size_t)SSD_ROW(r0_, lane) * 32 + d * 16 + h]; } while (0)
#define SSD_STAGE(buf, cum2n) do { float a2_ = ndt * Aneg2; \
        _Pragma("unroll") for (int off_ = 1; off_ < 64; off_ <<= 1) { const float v_ = __shfl_up(a2_, off_); if (lane >= off_) a2_ += v_; } \
        cum2n = a2_; cumw[(buf) * 64 + lane] = a2_; const float cT_ = __shfl(a2_, 63), cs_ = __shfl(a2_, sx & 63), dts_ = __shfl(ndt, sx & 63); \
        const float w2_ = dts_ * __builtin_amdgcn_exp2f(cT_ - cs_); float x8_[8], xd_[8], xs_[8]; unpack8(__builtin_bit_cast(v4u, nx), x8_); \
        _Pragma("unroll") for (int j_ = 0; j_ < 8; ++j_) { xd_[j_] = x8_[j_] * dts_; xs_[j_] = x8_[j_] * w2_; } \
        LAS char* Bk_ = lds + (buf) * IMG; LAS char* Bv_ = lds + (2 + (buf)) * IMG; LAS char* Xv_ = lds + (4 + (buf)) * IMG; LAS char* Ck_ = lds + (6 + (buf)) * IMG; \
        *(LAS bf16x8*)(Bk_ + kst_a) = nb0; *(LAS bf16x8*)(Bk_ + kst_b) = nb1; *(LAS bf16x8*)(Bv_ + vst_a) = nb0; *(LAS bf16x8*)(Bv_ + vst_b) = nb1; \
        *(LAS bf16x8*)(Ck_ + kst_a) = nc0; *(LAS bf16x8*)(Ck_ + kst_b) = nc1; \
        *(LAS v4u*)(Xv_ + xst_d) = pack8(xd_); *(LAS v4u*)(Xv_ + xst_s) = pack8(xs_); } while (0)
    SSD_LOAD(0); SSD_STAGE(0, cum2);
    __syncthreads();
    for (int ci = 0; ci < 68; ++ci) {
        const int cur = ci & 1; const int row0 = SSD_ROW0(ci);
        if (ci + 1 < 68) SSD_LOAD(ci + 1);
        f32x16 o = {}; bf16x8 Cc[8];
        if (ywave) { bf16x8 sf[8]; const LAS char* Ck = lds + (6 + cur) * IMG;
#pragma unroll
            for (int d0 = 0; d0 < 8; ++d0) { sf[d0] = *(const LAS bf16x8*)(Ss + KSWZ128(pb * 32 + r32, (d0 * 16 + hi * 8) * 2)); Cc[d0] = *(const LAS bf16x8*)(Ck + KSWZ128(tb * 32 + r32, (d0 * 16 + hi * 8) * 2)); }
            asm volatile("s_waitcnt lgkmcnt(0)" ::: "memory"); SBAR();
#pragma unroll
            for (int d0 = 0; d0 < 8; ++d0) o = __builtin_amdgcn_mfma_f32_32x32x16_bf16(Cc[d0], sf[d0], o, 0, 0, 0); }
        __syncthreads();
        {
            const float decT = __builtin_amdgcn_exp2f(__shfl(cum2, 63));
#pragma unroll
            for (int r = 0; r < 16; ++r) sacc[r] *= decT;
            const int vbx = ldsb + (4 + cur) * IMG + rdb + (2 + pb2) * 512, vbb = ldsb + (2 + cur) * IMG + rdb + nb * 512;
            const s16x4 xl0 = trr<0>(vbx), xh0 = trr<2048>(vbx), xl1 = trr<4096>(vbx), xh1 = trr<6144>(vbx), xl2 = trr<8192>(vbx), xh2 = trr<10240>(vbx), xl3 = trr<12288>(vbx), xh3 = trr<14336>(vbx);
            const s16x4 bl0 = trr<0>(vbb), bh0 = trr<2048>(vbb), bl1 = trr<4096>(vbb), bh1 = trr<6144>(vbb), bl2 = trr<8192>(vbb), bh2 = trr<10240>(vbb), bl3 = trr<12288>(vbb), bh3 = trr<14336>(vbb);
            asm volatile("s_waitcnt lgkmcnt(0)" ::: "memory"); SBAR();
            sacc = __builtin_amdgcn_mfma_f32_32x32x16_bf16(SSD_PK(xl0, xh0), SSD_PK(bl0, bh0), sacc, 0, 0, 0);
            sacc = __builtin_amdgcn_mfma_f32_32x32x16_bf16(SSD_PK(xl1, xh1), SSD_PK(bl1, bh1), sacc, 0, 0, 0);
            sacc = __builtin_amdgcn_mfma_f32_32x32x16_bf16(SSD_PK(xl2, xh2), SSD_PK(bl2, bh2), sacc, 0, 0, 0);
            sacc = __builtin_amdgcn_mfma_f32_32x32x16_bf16(SSD_PK(xl3, xh3), SSD_PK(bl3, bh3), sacc, 0, 0, 0);
#pragma unroll
            for (int r = 0; r < 16; ++r) *(LAS bf16*)(Ss + KSWZ128(pb2 * 32 + att::crow(r, hi), (nb * 32 + r32) * 2)) = (bf16)f2bf(sacc[r]);
        }
        if (ywave) {
            const LAS float* cw = cumw + cur * 64; const LAS char* Bk = lds + cur * IMG; const int vby = ldsb + (4 + cur) * IMG + rdb + pb * 512;
#pragma unroll
            for (int r = 0; r < 16; ++r) o[r] *= __builtin_amdgcn_exp2f(cw[tb * 32 + att::crow(r, hi)]);
            const float ct = __shfl(cum2, tb * 32 + r32);
#pragma unroll
            for (int sb = 0; sb < 2; ++sb) {
                if (sb <= tb) {
                    f32x16 p = {};
#pragma unroll
                    for (int d0 = 0; d0 < 8; ++d0) { const bf16x8 kf = *(const LAS bf16x8*)(Bk + KSWZ128(sb * 32 + r32, (d0 * 16 + hi * 8) * 2)); p = __builtin_amdgcn_mfma_f32_32x32x16_bf16(kf, Cc[d0], p, 0, 0, 0); }
#pragma unroll
                    for (int r = 0; r < 16; ++r) { const int sl = att::crow(r, hi); const float w = __builtin_amdgcn_exp2f(ct - cw[sb * 32 + sl]); const float v = p[r] * w; p[r] = (sb == tb && sl > r32) ? 0.f : v; }
                    bf16x8 paA, paB;
#define PK4(P, BASE, OUT) do { unsigned a0 = att::cvtpk(P[BASE + 0], P[BASE + 1]), a1 = att::cvtpk(P[BASE + 2], P[BASE + 3]); \
    unsigned b0 = att::cvtpk(P[BASE + 4], P[BASE + 5]), b1 = att::cvtpk(P[BASE + 6], P[BASE + 7]); \
    auto r0 = __builtin_amdgcn_permlane32_swap(a0, b0, false, false); auto r1 = __builtin_amdgcn_permlane32_swap(a1, b1, false, false); \
    v4u w = {r0[0], r1[0], r0[1], r1[1]}; OUT = __builtin_bit_cast(bf16x8, w); } while (0)
                    PK4(p, 0, paA); PK4(p, 8, paB);
#undef PK4
                    s16x4 l0, h0, l1, h1;
                    if (sb == 0) { l0 = trr<0>(vby); h0 = trr<2048>(vby); l1 = trr<4096>(vby); h1 = trr<6144>(vby); }
                    else { l0 = trr<8192>(vby); h0 = trr<10240>(vby); l1 = trr<12288>(vby); h1 = trr<14336>(vby); }
                    asm volatile("s_waitcnt lgkmcnt(0)" ::: "memory"); SBAR();
                    o = __builtin_amdgcn_mfma_f32_32x32x16_bf16(paA, SSD_PK(l0, h0), o, 0, 0, 0);
                    o = __builtin_amdgcn_mfma_f32_32x32x16_bf16(paB, SSD_PK(l1, h1), o, 0, 0, 0);
                }
            }
            bf16* yp = ssdy + ((size_t)d * M) * 1024 + h * 64 + pb * 32 + r32;
#pragma unroll
            for (int r = 0; r < 16; ++r) { const int t = tb * 32 + att::crow(r, hi); yp[(size_t)SSD_ROW(row0, t) * 1024] = (bf16)f2bf(o[r]); }
        }
        if (ci + 1 < 68) { float c2n; SSD_STAGE(cur ^ 1, c2n); cum2 = c2n; }
        __syncthreads();
    }
#undef SSD_ROW0
#undef SSD_ROW
#undef SSD_LOAD
#undef SSD_STAGE
}
}
__device__ __forceinline__ void ph_ssd_mfma(ArgsRef a, Ctx C, int l) {
    const bf16* xbc = (const bf16*)(a.ws + T_XBC); const float* dtb = (const float*)(a.ws + T_DT); bf16* ssdy = (bf16*)(a.ws + T_SSDY);
    const bool split = C.G >= 256;
    if (!split || C.vcu < 128)
    for (int it = C.vcu; it < 128; it += C.G) { const int h = it & 15, d = (it >> 4) & 1, b = it >> 5;
        const float Aneg2 = -__expf(a.in[I_SALOG][(l * 2 + d) * 16 + h]) * 1.4426950408889634f;
        ssd::ssd_item(xbc, dtb, ssdy, Aneg2, b, d, h, (LAS char*)C.lds, C.tid);
        __syncthreads(); }
    if (split) { if (C.vcu >= 128) { if (C.wave == 0) for (int it = C.vcu - 128; it < 128; it += C.G - 128) lru_s2_item(a, it, C.lane);
                                     conv_e(a, C, l, (C.vcu - 128) * NWAVES + C.wave, (C.G - 128) * NWAVES); } }
    else { for (int it = C.wave * C.G + C.vcu; it < 128; it += NWAVES * C.G) lru_s2_item(a, it, C.lane); conv_e(a, C, l, C.vcu * NWAVES + C.wave, C.G * NWAVES); }
}
__device__ __forceinline__ void ph_attn(ArgsRef a, Ctx C, int l) {
    const bf16* Qr = (const bf16*)(a.ws + T_QR); const bf16* Kr = (const bf16*)(a.ws + T_KR); const bf16* p = (const bf16*)(a.ws + WS_P); bf16* otmp = (bf16*)(a.ws + T_OTMP);
    unsigned* qhead = (unsigned*)(a.ws + WS_CTL) + CW_ATTQ + 64 * l; LAS unsigned* slot = (LAS unsigned*)(C.lds + RING_BYTES + 2048);
    const int nunits = 1024 + (l == DEPTH - 1 ? 0 : 64);
    for (;;) {
        if (C.tid == 0) *slot = __hip_atomic_fetch_add(qhead, 1u, RLX_AGENT);
        __syncthreads();
        const int u = (int)__builtin_amdgcn_readfirstlane(*slot);
        __syncthreads();
        if (u >= nunits) break;
        int qb, hm, b; bool isctx;
        if (u < 1024) { qb = u & 15; hm = (u >> 4) & 15; b = u >> 8; isctx = false; } else { const int u2 = u - 1024; qb = 0; hm = u2 & 15; b = u2 >> 4; isctx = true; }
        const int qrow0 = b * LT + (isctx ? 0 : LC) + qb * 256, kv0 = b * LT, seq = isctx ? LC : LT, hh = hm >> 1, qcol = hh * 128 + (hm & 1) * 64;
        att::attn_unit(Qr + (size_t)qrow0 * 1024 + qcol, Kr + (size_t)kv0 * 1024 + qcol, p + (size_t)kv0 * NP + P_V + hh * 128, otmp + (size_t)qrow0 * 2048 + hm * 128, seq, (LAS char*)C.lds, C.tid);
    }
}
__device__ __forceinline__ void ph_mixfin(ArgsRef a, Ctx C, int l) {
    const bf16* p = (const bf16*)(a.ws + WS_P); const bf16* xbc = (const bf16*)(a.ws + T_XBC); const bf16* ssdy = (const bf16*)(a.ws + T_SSDY); const bf16* otmp = (const bf16*)(a.ws + T_OTMP);
    bf16* br1 = (bf16*)(a.ws + WS_BR) + (size_t)M * 1024; bf16* br2 = br1 + (size_t)M * 1024;
    const float* sd = a.in[I_SD] + l * 16; const float* snw = a.in[I_SNW] + l * 1024; const float* anw = a.in[I_ANW] + l * 128; const float* lv = a.in[I_ALAM] + l * 256;
    const float lam_init = 0.8f - 0.6f * __expf(-0.3f * (float)l);
    const float lam = __expf(wave_sum(lv[C.lane] * lv[64 + C.lane])) - __expf(wave_sum(lv[128 + C.lane] * lv[192 + C.lane])) + lam_init;
    ROWLOOP {
        if (l == DEPTH - 1 && (r % LT) < LC) continue;
        float v[2][8]; float ss = 0.f;
#pragma unroll
        for (int it = 0; it < 2; ++it) { const int c = it * 512 + C.lane * 8; float x8[8], yf[8], yb[8], z8[8];
            unpack8(*(const v4u*)(xbc + (size_t)r * 2048 + c), x8); unpack8(*(const v4u*)(ssdy + (size_t)r * 1024 + c), yf); unpack8(*(const v4u*)(ssdy + ((size_t)M + r) * 1024 + c), yb);
            unpack8(*(const v4u*)(p + (size_t)r * NP + P_Z + c), z8); const float Dh = sd[c >> 6];
#pragma unroll
            for (int j = 0; j < 8; ++j) { const float y = Dh * x8[j] + yf[j] + yb[j]; const float vv = y * siluf_(z8[j]); v[it][j] = vv; ss += vv * vv; } }
        ss = wave_sum(ss); const float sc = 1.f / sqrtf(ss * (1.f / 1024.f) + LN_EPS);
#pragma unroll
        for (int it = 0; it < 2; ++it) { const int c = it * 512 + C.lane * 8; float o8[8];
#pragma unroll
            for (int j = 0; j < 8; ++j) o8[j] = v[it][j] * sc * snw[c + j];
            *(v4u*)(br1 + (size_t)r * 1024 + c) = pack8(o8); }
        const int hh = C.lane >> 3, d0 = (C.lane & 7) * 16; float od[16]; float s2 = 0.f;
#pragma unroll
        for (int hf = 0; hf < 2; ++hf) { float o0[8], o1[8]; unpack8(*(const v4u*)(otmp + (size_t)r * 2048 + (2 * hh) * 128 + d0 + hf * 8), o0); unpack8(*(const v4u*)(otmp + (size_t)r * 2048 + (2 * hh + 1) * 128 + d0 + hf * 8), o1);
#pragma unroll
            for (int j = 0; j < 8; ++j) { const float o = o0[j] - lam * o1[j]; od[hf * 8 + j] = o; s2 += o * o; } }
        s2 = sum8(s2);
        const float sc2 = (1.f - lam_init) / sqrtf(s2 * (1.f / 128.f) + LN_EPS);
#pragma unroll
        for (int hf = 0; hf < 2; ++hf) { float o8[8];
#pragma unroll
            for (int j = 0; j < 8; ++j) o8[j] = od[hf * 8 + j] * sc2 * anw[d0 + hf * 8 + j];
            *(v4u*)(br2 + (size_t)r * 1024 + hh * 128 + d0 + hf * 8) = pack8(o8); }
    }
}
struct RouteOut { int e0, e1; float w0, w1; };
__device__ __forceinline__ void lnmid_norms(f32x4 (&v)[8], float* xdst, bf16* hrow, const float* lng, const float* lnb, const float* sh, const float* sc, int lane) {
    float s = 0.f, q = 0.f;
#pragma unroll
    for (int jj = 0; jj < 8; ++jj) { s += (v[jj].x + v[jj].y) + (v[jj].z + v[jj].w); q += (v[jj].x * v[jj].x + v[jj].y * v[jj].y) + (v[jj].z * v[jj].z + v[jj].w * v[jj].w); }
    s = wave_sum(s); q = wave_sum(q);
    float mean = s * (1.f / D), rstd = 1.f / sqrtf(fmaxf(q * (1.f / D) - mean * mean, 0.f) + LN_EPS); s = 0.f; q = 0.f;
#pragma unroll
    for (int jj = 0; jj < 8; ++jj) { const int c = lane + 64 * jj; v[jj] = (v[jj] - mean) * rstd * ((const f32x4*)lng)[c] + ((const f32x4*)lnb)[c]; ((f32x4*)xdst)[c] = v[jj];
        s += (v[jj].x + v[jj].y) + (v[jj].z + v[jj].w); q += (v[jj].x * v[jj].x + v[jj].y * v[jj].y) + (v[jj].z * v[jj].z + v[jj].w * v[jj].w); }
    s = wave_sum(s); q = wave_sum(q);
    mean = s * (1.f / D); rstd = 1.f / sqrtf(fmaxf(q * (1.f / D) - mean * mean, 0.f) + LN_EPS);
    unsigned long long* o8 = (unsigned long long*)hrow;
#pragma unroll
    for (int jj = 0; jj < 8; ++jj) { const int c = lane + 64 * jj; v[jj] = (v[jj] - mean) * rstd * (((const f32x4*)sc)[c] + 1.f) + ((const f32x4*)sh)[c];
        o8[c] = (unsigned long long)pk2(v[jj].x, v[jj].y) | ((unsigned long long)pk2(v[jj].z, v[jj].w) << 32); }
}
__device__ __forceinline__ RouteOut route_pick(const float (&lg)[16], const float* rb) {
    float mx = lg[0];
#pragma unroll
    for (int e = 1; e < 16; ++e) mx = fmaxf(mx, lg[e]);
    float sm = 0.f, scs[16], sel[16];
#pragma unroll
    for (int e = 0; e < 16; ++e) { scs[e] = __expf(lg[e] - mx); sm += scs[e]; }
    const float ism = 1.f / sm;
#pragma unroll
    for (int e = 0; e < 16; ++e) { scs[e] *= ism; sel[e] = scs[e] + rb[e]; }
    int gbest = 0, i0b = 0, i1b = 0; float gsb = -1e30f;
#pragma unroll
    for (int g = 0; g < 4; ++g) { float best = sel[4 * g]; int bi = 0;
#pragma unroll
        for (int i = 1; i < 4; ++i) if (sel[4 * g + i] > best) { best = sel[4 * g + i]; bi = i; }
        float sb = -1e30f; int si = 0;
#pragma unroll
        for (int i = 0; i < 4; ++i) if (i != bi && sel[4 * g + i] > sb) { sb = sel[4 * g + i]; si = i; }
        const float gs = best + sb;
        if (gs > gsb) { gsb = gs; gbest = g; i0b = bi; i1b = si; } }
    RouteOut o; o.e0 = gbest * 4 + i0b; o.e1 = gbest * 4 + i1b; float w0 = 0.f, w1 = 0.f;
#pragma unroll
    for (int e = 0; e < 16; ++e) { w0 = (e == o.e0) ? scs[e] : w0; w1 = (e == o.e1) ? scs[e] : w1; }
    const float iw = 1.f / (w0 + w1); o.w0 = w0 * iw; o.w1 = w1 * iw;
    return o;
}
__device__ __forceinline__ void ph_lnmid(ArgsRef a, Ctx C, int l) {
    LAS float* wt = (LAS float*)C.lds;
    LAS unsigned* cnt = (LAS unsigned*)(C.lds + RING_BYTES + 1024); LAS unsigned* base = cnt + 16; LAS unsigned* park = cnt + 64;
    const float* wr = a.in[I_WR];
    for (int i = C.tid; i < D * NE; i += NTHR) wt[(i & 15) * D + (i >> 4)] = wr[i];
    if (C.tid < 16) cnt[C.tid] = 0u;
    __syncthreads();
    const bf16* y = (const bf16*)(a.ws + T_MACC); float* xs_ctx = (float*)(a.ws + WS_XSCTX); bf16* h = (bf16*)(a.ws + WS_H);
    const float* mod = (const float*)(a.ws + WS_MOD) + (size_t)l * 5 * NADA; const float* lng = a.in[I_LNG] + (size_t)(l * 2) * D; const float* lnb = a.in[I_LNB] + (size_t)(l * 2) * D;
    const float* rb = a.in[I_RB];
    int* tok_e = (int*)(a.ws + WS_ROUTE); float* tok_w = (float*)(tok_e + 2 * M); int* tok_idx = (int*)(tok_w + 2 * M);
    const int nrows = (l == DEPTH - 1) ? NB * LL : M, rstep = C.G * NWAVES;
#define LNM_ROW(i) ((l == DEPTH - 1) ? ((i) >> 12) * LT + LC + ((i) & 4095) : (i))
#define LNM_COMMIT(r_, o_) do { const unsigned x0 = __hip_atomic_fetch_add(&cnt[(o_).e0], 1u, __ATOMIC_RELAXED, __HIP_MEMORY_SCOPE_WORKGROUP), x1 = __hip_atomic_fetch_add(&cnt[(o_).e1], 1u, __ATOMIC_RELAXED, __HIP_MEMORY_SCOPE_WORKGROUP); \
        tok_e[2 * (r_)] = (o_).e0; tok_e[2 * (r_) + 1] = (o_).e1; tok_w[2 * (r_)] = (o_).w0; tok_w[2 * (r_) + 1] = (o_).w1; \
        LAS unsigned* pk = park + (C.wave * 16 + nrow) * 4; pk[0] = (unsigned)(o_).e0; pk[1] = (unsigned)(o_).e1; pk[2] = x0; pk[3] = x1; ++nrow; } while (0)
    int nrow = 0;
    for (int ri = C.vcu * NWAVES + C.wave; ri < nrows; ri += 2 * rstep) {
        const bool has2 = ri + rstep < nrows; const int r1 = LNM_ROW(ri), r2 = has2 ? LNM_ROW(ri + rstep) : r1;
        const int b1 = r1 / LT, j1 = r1 - b1 * LT, b2 = r2 / LT, j2 = r2 - b2 * LT; const bool c1 = j1 < LC, c2 = j2 < LC;
        f32x4 v1[8], v2[8];
#pragma unroll
        for (int jj = 0; jj < 8; ++jj) { const v2u w1 = ((const v2u*)(y + (size_t)r1 * D))[C.lane + 64 * jj], w2 = ((const v2u*)(y + (size_t)r2 * D))[C.lane + 64 * jj];
            v1[jj] = (f32x4){bflo(w1.x), bfhi(w1.x), bflo(w1.y), bfhi(w1.y)}; v2[jj] = (f32x4){bflo(w2.x), bfhi(w2.x), bflo(w2.y), bfhi(w2.y)}; }
        const float* sh1 = mod + (size_t)(c1 ? 4 : b1) * NADA + 3 * D; const float* sh2 = mod + (size_t)(c2 ? 4 : b2) * NADA + 3 * D;
        lnmid_norms(v1, c1 ? xs_ctx + ((size_t)b1 * LC + j1) * D : a.out + ((size_t)b1 * LL + (j1 - LC)) * D, h + (size_t)r1 * D, lng, lnb, sh1, sh1 + D, C.lane);
        lnmid_norms(v2, c2 ? xs_ctx + ((size_t)b2 * LC + j2) * D : a.out + ((size_t)b2 * LL + (j2 - LC)) * D, h + (size_t)r2 * D, lng, lnb, sh2, sh2 + D, C.lane);
        float lg1[16], lg2[16];
#pragma unroll
        for (int e = 0; e < 16; ++e) { float a1 = 0.f, a2 = 0.f;
#pragma unroll
            for (int jj = 0; jj < 8; ++jj) { const f32x4 w = *(const LAS f32x4*)(wt + e * D + (C.lane + 64 * jj) * 4);
                a1 += (v1[jj].x * w.x + v1[jj].y * w.y) + (v1[jj].z * w.z + v1[jj].w * w.w); a2 += (v2[jj].x * w.x + v2[jj].y * w.y) + (v2[jj].z * w.z + v2[jj].w * w.w); }
            lg1[e] = wave_sum(a1); lg2[e] = wave_sum(a2);
            if (e & 1) asm volatile("" ::: "memory"); }
        const RouteOut o1 = route_pick(lg1, rb), o2 = route_pick(lg2, rb);
        if (C.lane == 0) { LNM_COMMIT(r1, o1); if (has2) LNM_COMMIT(r2, o2); }
    }
    __syncthreads();
    if (C.tid < 16) base[C.tid] = __hip_atomic_fetch_add((unsigned*)(a.ws + WS_CTL) + CW_GCNT + l * 16 + C.tid, cnt[C.tid], RLX_AGENT);
    __syncthreads();
    { int n2 = 0;
      for (int ri = C.vcu * NWAVES + C.wave; ri < nrows; ri += rstep) { const int r = LNM_ROW(ri);
          if (C.lane == 0) { const LAS unsigned* pk = park + (C.wave * 16 + n2) * 4; tok_idx[2 * r] = (int)(pk[2] + base[pk[0] & 15u]); tok_idx[2 * r + 1] = (int)(pk[3] + base[pk[1] & 15u]); }
          ++n2; } }
#undef LNM_ROW
#undef LNM_COMMIT
}
__device__ __forceinline__ void ph_gather(ArgsRef a, Ctx C, int l) {
    LAS int* offs = (LAS int*)(C.lds + RING_BYTES + 1024);
    unsigned* ctl = (unsigned*)(a.ws + WS_CTL);
    LAS int* cnts = offs + 32;
    if (C.tid < 16) cnts[C.tid] = (int)__hip_atomic_load(ctl + CW_GCNT + l * 16 + C.tid, RLX_AGENT);
    __syncthreads();
    if (C.tid == 0) { int o = 0;
        for (int e = 0; e < 16; ++e) { offs[e] = o; o += ((cnts[e] + 127) >> 7) * 128; }
        offs[16] = o; if (blockIdx.x == 0) ctl[CW_NMT + l] = (unsigned)(o >> 7); }
    __syncthreads();
    if (blockIdx.x == 0) { const int nt = offs[16] >> 7;
        for (int t = C.tid; t < nt; t += NTHR) { int e = 0;
#pragma unroll
            for (int k = 1; k < 16; ++k) e += (t * 128 >= offs[k]) ? 1 : 0;
            ctl[CW_TILEE + l * 512 + t] = (unsigned)e; } }
    const int* tok_e = (const int*)(a.ws + WS_ROUTE); const int* tok_idx = tok_e + 4 * M; int* tok_pos = (int*)tok_e + 6 * M;
    const bf16* h = (const bf16*)(a.ws + WS_H); unsigned char* Xg = a.ws + WS_XG;
    const int gw = C.vcu * NWAVES + C.wave, NGW = C.G * NWAVES;
    int mypos = -1;
    { const int r = gw + (C.lane >> 1) * NGW, k = C.lane & 1;
      if (C.lane < 18 && r < M && !(l == DEPTH - 1 && (r % LT) < LC)) { const int e = tok_e[2 * r + k] & 15, idx = tok_idx[2 * r + k]; int pos = offs[e] + idx; pos = pos < 0 ? 0 : (pos >= MOE_ROWS ? MOE_ROWS - 1 : pos);
          tok_pos[2 * r + k] = pos; mypos = pos; } }
    v4u cur[4], nxt[4];
    { const int r0 = gw; if (r0 < M) {
#pragma unroll
        for (int q = 0; q < 4; ++q) nxt[q] = ((const v4u*)(h + (size_t)r0 * D))[C.lane + 64 * q]; } }
#pragma unroll 1
    for (int j = 0; j < 9; ++j) { const int r = gw + j * NGW; if (r >= M) break;
#pragma unroll
        for (int q = 0; q < 4; ++q) cur[q] = nxt[q];
        if (r + NGW < M) {
#pragma unroll
            for (int q = 0; q < 4; ++q) nxt[q] = ((const v4u*)(h + (size_t)(r + NGW) * D))[C.lane + 64 * q]; }
        const int p0 = __shfl(mypos, 2 * j), p1 = __shfl(mypos, 2 * j + 1);
        if (p0 < 0) continue;
        v2u* d0 = (v2u*)(Xg + (size_t)p0 * D); v2u* d1 = (v2u*)(Xg + (size_t)p1 * D);
#pragma unroll
        for (int q = 0; q < 4; ++q) { float x8[8]; unpack8(cur[q], x8); const v2u w = pack8_fp8(x8); d0[C.lane + 64 * q] = w; d1[C.lane + 64 * q] = w; }
    }
    __syncthreads();
}
__device__ __forceinline__ void ph_final(ArgsRef a, Ctx C, int l) {
    const int* tok_pos = (const int*)(a.ws + WS_ROUTE) + 6 * M; const float* tok_w = (const float*)(a.ws + WS_ROUTE) + 2 * M;
    const bf16* fs = (const bf16*)(a.ws + WS_FS); float* xs_ctx = (float*)(a.ws + WS_XSCTX);
    const float* mod = (const float*)(a.ws + WS_MOD) + (size_t)l * 5 * NADA; const float* lng = a.in[I_LNG] + (size_t)(l * 2 + 1) * D; const float* lnb = a.in[I_LNB] + (size_t)(l * 2 + 1) * D;
    const int nrows = (l == DEPTH - 1) ? NB * LL : M, rstep = C.G * NWAVES;
#define FIN_ROW(i) ((l == DEPTH - 1) ? ((i) >> 12) * LT + LC + ((i) & 4095) : (i))
#define FIN_XROW(r_) (((r_) % LT) < LC ? xs_ctx + ((size_t)((r_) / LT) * LC + ((r_) % LT)) * D : a.out + ((size_t)((r_) / LT) * LL + (((r_) % LT) - LC)) * D)
    f32x4 xn[8]; v2u f0n[8], f1n[8]; float w0n = 0.f, w1n = 0.f; int ri = C.vcu * NWAVES + C.wave;
#define FIN_LOAD(i) do { const int r_ = FIN_ROW(i); const float* xr_ = FIN_XROW(r_); const v2u* p0_ = (const v2u*)(fs + (size_t)tok_pos[2 * r_] * D); const v2u* p1_ = (const v2u*)(fs + (size_t)tok_pos[2 * r_ + 1] * D); \
        w0n = tok_w[2 * r_]; w1n = tok_w[2 * r_ + 1]; \
        _Pragma("unroll") for (int jj = 0; jj < 8; ++jj) { const int q = C.lane + 64 * jj; xn[jj] = ((const f32x4*)xr_)[q]; f0n[jj] = p0_[q]; f1n[jj] = p1_[q]; } } while (0)
    if (ri < nrows) FIN_LOAD(ri);
    for (; ri < nrows; ri += rstep) { const int r = FIN_ROW(ri); const int b = r / LT, j = r - b * LT; const bool isctx = j < LC;
        float* xrow = isctx ? xs_ctx + ((size_t)b * LC + j) * D : a.out + ((size_t)b * LL + (j - LC)) * D;
        const float* g2 = mod + (size_t)(isctx ? 4 : b) * NADA + 5 * D;
        f32x4 v[8]; float s = 0.f, s2 = 0.f; const float w0 = w0n, w1 = w1n;
#pragma unroll
        for (int jj = 0; jj < 8; ++jj) { const int q = C.lane + 64 * jj; const v2u a0 = f0n[jj], a1 = f1n[jj];
            const f32x4 f = (f32x4){bflo(a0.x), bfhi(a0.x), bflo(a0.y), bfhi(a0.y)} * w0 + (f32x4){bflo(a1.x), bfhi(a1.x), bflo(a1.y), bfhi(a1.y)} * w1;
            v[jj] = xn[jj] * DN_ALPHA + ((const f32x4*)g2)[q] * f; s += (v[jj].x + v[jj].y) + (v[jj].z + v[jj].w); s2 += (v[jj].x * v[jj].x + v[jj].y * v[jj].y) + (v[jj].z * v[jj].z + v[jj].w * v[jj].w); }
        if (ri + rstep < nrows) FIN_LOAD(ri + rstep);
        const float mean = wave_sum(s) * (1.f / D), rstd = 1.f / sqrtf(fmaxf(wave_sum(s2) * (1.f / D) - mean * mean, 0.f) + LN_EPS);
        float s3 = 0.f, s4 = 0.f;
#pragma unroll
        for (int jj = 0; jj < 8; ++jj) { const int q = C.lane + 64 * jj; v[jj] = (v[jj] - mean) * rstd * ((const f32x4*)lng)[q] + ((const f32x4*)lnb)[q]; ((f32x4*)xrow)[q] = v[jj];
            s3 += (v[jj].x + v[jj].y) + (v[jj].z + v[jj].w); s4 += (v[jj].x * v[jj].x + v[jj].y * v[jj].y) + (v[jj].z * v[jj].z + v[jj].w * v[jj].w); }
        if (l < DEPTH - 1) {
            const float* sh = mod + (size_t)5 * NADA + (size_t)(isctx ? 4 : b) * NADA; const float* sc = sh + D;
            const float mean2 = wave_sum(s3) * (1.f / D), rstd2 = 1.f / sqrtf(fmaxf(wave_sum(s4) * (1.f / D) - mean2 * mean2, 0.f) + LN_EPS);
            unsigned long long* o8 = (unsigned long long*)((bf16*)(a.ws + WS_H) + (size_t)r * D);
#pragma unroll
            for (int jj = 0; jj < 8; ++jj) { const int q = C.lane + 64 * jj; const f32x4 o = (v[jj] - mean2) * rstd2 * (((const f32x4*)sc)[q] + 1.f) + ((const f32x4*)sh)[q];
                o8[q] = (unsigned long long)pk2(o.x, o.y) | ((unsigned long long)pk2(o.z, o.w) << 32); } }
    }
#undef FIN_LOAD
#undef FIN_ROW
#undef FIN_XROW
}

constexpr int NPL = 15, NPH = 2 + DEPTH * NPL;
__global__ void __launch_bounds__(NTHR, 2) fwd(Args args) {
    extern __shared__ __attribute__((aligned(16))) unsigned char lds_raw[];
    Ctx C; C.lds = (LAS unsigned char*)lds_raw; C.tid = threadIdx.x; C.lane = C.tid & 63; C.wave = __builtin_amdgcn_readfirstlane(C.tid >> 6);
    C.G = gridDim.x; { const int bx = blockIdx.x; C.vcu = (C.G % 8 == 0) ? (bx % 8) * (C.G / 8) + bx / 8 : bx; }
    for (int u = C.tid; u < (LDS_BYTES - RING_BYTES) / 4; u += NTHR) ((LAS unsigned*)(C.lds + RING_BYTES))[u] = 0u;
    __syncthreads();
    const __attribute__((address_space(4))) Args* kargs = (const __attribute__((address_space(4))) Args*)__builtin_amdgcn_kernarg_segment_ptr();
    unsigned* ctl0 = (unsigned*)(kargs->ws + WS_CTL);
    XcdBarrier bar; bar.bar = ctl0 + CW_BAR; bar.x = 0; bar.st = nullptr;
    if (MK_N_LAUNCHES == 1) bar = xcd_barrier_post(ctl0 + CW_BAR, (volatile LAS unsigned*)(C.lds + MISC_OFF) + 8);
    const int lo = kargs->ph_lo, hi = kargs->ph_hi;
#ifndef PHMASK
#define PHMASK 0xFFFFFFFFu
#endif
#define EN(k) ((PHMASK >> (k)) & 1u)
#define IN(k) (lo <= (k) && (k) < hi)
#define SEAM(k) do { if (MK_N_LAUNCHES == 1 && IN(k) && IN((k) + 1)) xcd_barrier(bar); } while (0)
    const int cblk = (int)blockIdx.x;
#define PH_CTX Ctx Cq = C; { int t_ = C.tid; asm volatile("" : "+v"(t_)); Cq.tid = t_; Cq.lane = t_ & 63; Cq.wave = __builtin_amdgcn_readfirstlane(t_ >> 6); } \
    const __attribute__((address_space(4))) Args* ap_ = kargs; asm volatile("" : "+s"(ap_)); ArgsRef A = *ap_; unsigned char* ws = A.ws; unsigned* ctl = (unsigned*)(ws + WS_CTL); (void)ctl

    if (EN(0) && IN(0)) { PH_CTX; ph_modp(A, Cq); ph_conva(A, Cq, 0); }
    SEAM(0);
    if (EN(1) && IN(1)) { PH_CTX; ph_modr(A, Cq); }
    SEAM(1);
    { constexpr int l = 0; constexpr int pb = 2 + l * NPL;
        if (l == 0) { if (EN(2) && IN(pb + 0)) { PH_CTX; ph_ln1(A, Cq, l); } SEAM(pb + 0); }
        if (EN(3) && IN(pb + 1)) {
            PH_CTX;
            const pg8::Gemm g{D, D, D}; const SchedIn S{Cq.G, cblk, l == DEPTH - 1, (const char*)(ws + WS_H), (const char*)(ws + WS_WIN)};
            const EpiP E{(bf16*)(ws + WS_P)};
            pg8::gemm_phase<EpiP, SchedIn, true, true>(Cq.lds, Cq.tid, g, S, E); }
        SEAM(pb + 1);
        if (EN(4) && IN(pb + 2)) { PH_CTX; ph_prep(A, Cq, l); }
        SEAM(pb + 2);
        if (EN(5) && IN(pb + 3)) {
            PH_CTX;
            const pg8::Gemm g{256, 1024, 256}; const SchedLru S{Cq.G, cblk, (const char*)(ws + T_XC), (const char*)(ws + WS_WG)};
            const EpiLru E{(const bf16*)(ws + T_XC), A.in[I_LGB] + (size_t)l * 4096, A.in[I_LLAM] + (size_t)l * 2048, (bf16*)(ws + T_LA), (bf16*)(ws + T_BB)};
            pg8::gemm_phase<EpiLru, SchedLru, true, true>(Cq.lds, Cq.tid, g, S, E); }
        SEAM(pb + 3);
        if (EN(6) && IN(pb + 4)) { PH_CTX; ph_lru_s1(A, Cq); }
        SEAM(pb + 4);
        if (EN(7) && IN(pb + 5)) { PH_CTX; ph_ssd_mfma(A, Cq, l); }
        if (EN(8) && IN(pb + 5)) { PH_CTX; __syncthreads(); ph_attn(A, Cq, l); }
        SEAM(pb + 5);
        if (EN(9) && IN(pb + 7)) { PH_CTX; ph_lru_s3(A, Cq, l); ph_mixfin(A, Cq, l); }
        SEAM(pb + 7);
        if (EN(10) && IN(pb + 8)) {
            PH_CTX;
            const pg8::Gemm g{1024, 1024, 1024}; const SchedMerge S{Cq.G, cblk, (const char*)(ws + WS_BR), (const char*)(ws + WS_WBR), l == DEPTH - 1};
            const EpiMerge E{(const bf16*)(ws + WS_P), (bf16*)(ws + T_MB)};
            pg8::gemm_phase<EpiMerge, SchedMerge, true, true>(Cq.lds, Cq.tid, g, S, E); }
        SEAM(pb + 8);
        if (EN(11) && IN(pb + 9)) {
            PH_CTX;
            const pg8::Gemm g{D, D, D}; const SchedPlain S{l == DEPTH - 1 ? 64 : M / 256, D / 256, Cq.G, cblk, (const char*)(ws + T_MB), (const char*)(ws + WS_WOUT), (size_t)256 * D * 2, (size_t)256 * D * 2, l == DEPTH - 1};
            const EpiWout E{l == 0 ? A.in[I_X] : A.out, l == 0 ? A.in[I_CTX] : (const float*)(ws + WS_XSCTX), (const float*)(ws + WS_MOD) + (size_t)l * 5 * NADA + 2 * D, (bf16*)(ws + T_MACC)};
            pg8::gemm_phase<EpiWout, SchedPlain, true, true>(Cq.lds, Cq.tid, g, S, E); }
        SEAM(pb + 9);
        if (EN(12) && IN(pb + 10)) { PH_CTX; ph_lnmid(A, Cq, l); }
        SEAM(pb + 10);
        if (EN(13) && IN(pb + 11)) { PH_CTX; ph_gather(A, Cq, l); }
        SEAM(pb + 11);
        if (EN(14) && IN(pb + 12)) {
            PH_CTX;
            int nmt = (int)__builtin_amdgcn_readfirstlane(__hip_atomic_load(ctl + CW_NMT + l, RLX_AGENT)); nmt = nmt > MOE_TILES ? MOE_TILES : nmt;
            const pg8::Gemm g{D / 2, D / 2, D / 2}; const SchedMoe S{nmt, 11, Cq.G, cblk, (const char*)(ws + WS_XG), (const char*)(ws + WS_EGU), (size_t)128 * D, (size_t)2816 * D, (size_t)256 * D, ctl + CW_TILEE + l * 512};
            const EpiMoe1 E{ws + WS_ACT};
            pg8::gemm_phase<EpiMoe1, SchedMoe, true, true, true, true>(Cq.lds, Cq.tid, g, S, E); }
        SEAM(pb + 12);
        if (EN(15) && IN(pb + 13)) {
            PH_CTX;
            int nmt = (int)__builtin_amdgcn_readfirstlane(__hip_atomic_load(ctl + CW_NMT + l, RLX_AGENT)); nmt = nmt > MOE_TILES ? MOE_TILES : nmt;
            const pg8::Gemm g{DEP / 2, DEP / 2, DEP / 2}; const SchedMoe S{nmt, 8, Cq.G, cblk, (const char*)(ws + WS_ACT), (const char*)(ws + WS_ED), (size_t)128 * DEP, (size_t)D * DEP, (size_t)256 * DEP, ctl + CW_TILEE + l * 512};
            const EpiMoe2 E{(bf16*)(ws + WS_FS)};
            pg8::gemm_phase<EpiMoe2, SchedMoe, true, true, true, true>(Cq.lds, Cq.tid, g, S, E); }
        SEAM(pb + 13);
        if (EN(16) && IN(pb + 14)) { PH_CTX; ph_final(A, Cq, l); if (l < DEPTH - 1) ph_conva(A, Cq, l + 1); }
        if (l < DEPTH - 1) SEAM(pb + 14);
    }
    { constexpr int l = 1; constexpr int pb = 2 + l * NPL;
        if (l == 0) { if (EN(2) && IN(pb + 0)) { PH_CTX; ph_ln1(A, Cq, l); } SEAM(pb + 0); }
        if (EN(3) && IN(pb + 1)) {
            PH_CTX;
            const pg8::Gemm g{D, D, D}; const SchedIn S{Cq.G, cblk, l == DEPTH - 1, (const char*)(ws + WS_H), (const char*)(ws + WS_WIN)};
            const EpiP E{(bf16*)(ws + WS_P)};
            pg8::gemm_phase<EpiP, SchedIn, true, true>(Cq.lds, Cq.tid, g, S, E); }
        SEAM(pb + 1);
        if (EN(4) && IN(pb + 2)) { PH_CTX; ph_prep(A, Cq, l); }
        SEAM(pb + 2);
        if (EN(5) && IN(pb + 3)) {
            PH_CTX;
            const pg8::Gemm g{256, 1024, 256}; const SchedLru S{Cq.G, cblk, (const char*)(ws + T_XC), (const char*)(ws + WS_WG)};
            const EpiLru E{(const bf16*)(ws + T_XC), A.in[I_LGB] + (size_t)l * 4096, A.in[I_LLAM] + (size_t)l * 2048, (bf16*)(ws + T_LA), (bf16*)(ws + T_BB)};
            pg8::gemm_phase<EpiLru, SchedLru, true, true>(Cq.lds, Cq.tid, g, S, E); }
        SEAM(pb + 3);
        if (EN(6) && IN(pb + 4)) { PH_CTX; ph_lru_s1(A, Cq); }
        SEAM(pb + 4);
        if (EN(7) && IN(pb + 5)) { PH_CTX; ph_ssd_mfma(A, Cq, l); }
        if (EN(8) && IN(pb + 5)) { PH_CTX; __syncthreads(); ph_attn(A, Cq, l); }
        SEAM(pb + 5);
        if (EN(9) && IN(pb + 7)) { PH_CTX; ph_lru_s3(A, Cq, l); ph_mixfin(A, Cq, l); }
        SEAM(pb + 7);
        if (EN(10) && IN(pb + 8)) {
            PH_CTX;
            const pg8::Gemm g{1024, 1024, 1024}; const SchedMerge S{Cq.G, cblk, (const char*)(ws + WS_BR), (const char*)(ws + WS_WBR), l == DEPTH - 1};
            const EpiMerge E{(const bf16*)(ws + WS_P), (bf16*)(ws + T_MB)};
            pg8::gemm_phase<EpiMerge, SchedMerge, true, true>(Cq.lds, Cq.tid, g, S, E); }
        SEAM(pb + 8);
        if (EN(11) && IN(pb + 9)) {
            PH_CTX;
            const pg8::Gemm g{D, D, D}; const SchedPlain S{l == DEPTH - 1 ? 64 : M / 256, D / 256, Cq.G, cblk, (const char*)(ws + T_MB), (const char*)(ws + WS_WOUT), (size_t)256 * D * 2, (size_t)256 * D * 2, l == DEPTH - 1};
            const EpiWout E{l == 0 ? A.in[I_X] : A.out, l == 0 ? A.in[I_CTX] : (const float*)(ws + WS_XSCTX), (const float*)(ws + WS_MOD) + (size_t)l * 5 * NADA + 2 * D, (bf16*)(ws + T_MACC)};
            pg8::gemm_phase<EpiWout, SchedPlain, true, true>(Cq.lds, Cq.tid, g, S, E); }
        SEAM(pb + 9);
        if (EN(12) && IN(pb + 10)) { PH_CTX; ph_lnmid(A, Cq, l); }
        SEAM(pb + 10);
        if (EN(13) && IN(pb + 11)) { PH_CTX; ph_gather(A, Cq, l); }
        SEAM(pb + 11);
        if (EN(14) && IN(pb + 12)) {
            PH_CTX;
            int nmt = (int)__builtin_amdgcn_readfirstlane(__hip_atomic_load(ctl + CW_NMT + l, RLX_AGENT)); nmt = nmt > MOE_TILES ? MOE_TILES : nmt;
            const pg8::Gemm g{D / 2, D / 2, D / 2}; const SchedMoe S{nmt, 11, Cq.G, cblk, (const char*)(ws + WS_XG), (const char*)(ws + WS_EGU), (size_t)128 * D, (size_t)2816 * D, (size_t)256 * D, ctl + CW_TILEE + l * 512};
            const EpiMoe1 E{ws + WS_ACT};
            pg8::gemm_phase<EpiMoe1, SchedMoe, true, true, true, true>(Cq.lds, Cq.tid, g, S, E); }
        SEAM(pb + 12);
        if (EN(15) && IN(pb + 13)) {
            PH_CTX;
            int nmt = (int)__builtin_amdgcn_readfirstlane(__hip_atomic_load(ctl + CW_NMT + l, RLX_AGENT)); nmt = nmt > MOE_TILES ? MOE_TILES : nmt;
            const pg8::Gemm g{DEP / 2, DEP / 2, DEP / 2}; const SchedMoe S{nmt, 8, Cq.G, cblk, (const char*)(ws + WS_ACT), (const char*)(ws + WS_ED), (size_t)128 * DEP, (size_t)D * DEP, (size_t)256 * DEP, ctl + CW_TILEE + l * 512};
            const EpiMoe2 E{(bf16*)(ws + WS_FS)};
            pg8::gemm_phase<EpiMoe2, SchedMoe, true, true, true, true>(Cq.lds, Cq.tid, g, S, E); }
        SEAM(pb + 13);
        if (EN(16) && IN(pb + 14)) { PH_CTX; ph_final(A, Cq, l); if (l < DEPTH - 1) ph_conva(A, Cq, l + 1); }
        if (l < DEPTH - 1) SEAM(pb + 14);
    }
#undef IN
#undef SEAM
}

extern "C" void kernel_launch(void* const* d_in, const int* in_sizes, int n_in, void* d_out, int out_size, void* d_ws, size_t ws_size, hipStream_t stream) {
    static int grid = 0;
    if (grid == 0) {
        if (n_in != 29 || out_size != NB * LL * D || ws_size < WS_END) { fprintf(stderr, "kernel_launch: unexpected shapes: n_in %d out %d ws %zu (need %zu)\n", n_in, out_size, ws_size, (size_t)WS_END); grid = -1; return; }
        int dev = 0, cus = 0, per_cu = 0;
        if (hipGetDevice(&dev) != hipSuccess || hipDeviceGetAttribute(&cus, hipDeviceAttributeMultiprocessorCount, dev) != hipSuccess) { grid = -1; return; }
        if (hipFuncSetAttribute((const void*)fwd, hipFuncAttributeMaxDynamicSharedMemorySize, LDS_BYTES) != hipSuccess) { fprintf(stderr, "kernel_launch: hipFuncSetAttribute failed\n"); grid = -1; return; }
        if (hipOccupancyMaxActiveBlocksPerMultiprocessor(&per_cu, (const void*)fwd, NTHR, LDS_BYTES) != hipSuccess || per_cu < 1) fprintf(stderr, "kernel_launch: occupancy query says %d\n", per_cu);
        (void)hipGetLastError();
        grid = cus;
    }
    if (grid < 0) return;
    if (hipMemsetAsync((char*)d_ws + WS_CTL, 0, CTL_ZERO_BYTES, stream) != hipSuccess) return;
    Args a{};
    for (int i = 0; i < 29; ++i) a.in[i] = (const float*)d_in[i];
    a.out = (float*)d_out; a.ws = (unsigned char*)d_ws; a.li = 0; a.pad = 0;
    if (MK_N_LAUNCHES == 1) { a.ph_lo = 0; a.ph_hi = NPH; hipLaunchKernelGGL(fwd, dim3(grid), dim3(NTHR), LDS_BYTES, stream, a); }
    else for (int k = 0; k < NPH; ++k) { a.ph_lo = k; a.ph_hi = k + 1; hipLaunchKernelGGL(fwd, dim3(grid), dim3(NTHR), LDS_BYTES, stream, a);
#ifdef REPMASK
        { const int bit = k < 2 ? k : 2 + (k - 2) % NPL; if ((REPMASK >> bit) & 1u) hipLaunchKernelGGL(fwd, dim3(grid), dim3(NTHR), LDS_BYTES, stream, a); }
#endif
    }
    const hipError_t le = hipPeekAtLastError();
    if (le != hipSuccess) fprintf(stderr, "kernel_launch: launch failed: %s\n", hipGetErrorName(le));
}
```

```cpp
#include <hip/hip_runtime.h>
#include <cstdio>
#include <cstdint>

#define GAS __attribute__((address_space(1)))
#define LAS __attribute__((address_space(3)))
typedef unsigned short bf16;
typedef unsigned v4u __attribute__((ext_vector_type(4)));
typedef unsigned v2u __attribute__((ext_vector_type(2)));
typedef float f32x4 __attribute__((ext_vector_type(4)));
typedef float f32x2 __attribute__((ext_vector_type(2)));
typedef short bf16x8 __attribute__((ext_vector_type(8)));
typedef GAS unsigned gu32;

#ifndef MK_N_LAUNCHES
#define MK_N_LAUNCHES 1
#endif

constexpr int NB = 4, LC = 256, LL = 4096, LT = LC + LL, M = NB * LT;
constexpr int D = 2048, NADA = 6 * D, DEPTH = 2;
constexpr int DIN = 14368, NP = 14592;
constexpr int P_LRUX = 0, P_LRUG = 1024, P_Z = 2048, P_XBC = 3072, P_Q = 5120, P_K = 6144, P_V = 7168, P_G = 8192, P_DT = 14336;
constexpr int NE = 16, DE = 1408, MOE_ROWS = 39168, MOE_TILES = MOE_ROWS / 128;
constexpr float LN_EPS = 1e-6f;
constexpr float DN_ALPHA = 1.4142135623730951f;
constexpr float QSCALE = 0.125f * 1.4426950408889634f;
constexpr float WSC_GU = 64.f, WSC_D = 128.f;
constexpr int DEP = 1536;
constexpr int NCH = 136;

constexpr size_t MiB = 1u << 20;
constexpr size_t WS_CTL = 0, CTL_ZERO_BYTES = 1 * MiB;
constexpr size_t WS_MODP = 1 * MiB, WS_MOD = 9 * MiB, WS_ROUTE = 10 * MiB, WS_XSCTX = 11 * MiB;
constexpr size_t WS_WIN = 19 * MiB, WS_WBR = 76 * MiB, WS_WOUT = 88 * MiB, WS_WG = 96 * MiB;
constexpr size_t WS_P = 98 * MiB;
constexpr size_t WS_XG = WS_P, WS_ACT = WS_P + 153 * MiB, WS_FS = WS_P + 259 * MiB;
constexpr size_t WS_H = 583 * MiB, WS_BR = 651 * MiB, WS_T = 753 * MiB;
constexpr size_t T_XC = WS_T, T_XBC = WS_T + 34 * MiB, T_DT = WS_T + 102 * MiB, T_QR = WS_T + 105 * MiB, T_KR = WS_T + 139 * MiB;
constexpr size_t T_LA = WS_T + 173 * MiB, T_BB = WS_T + 241 * MiB, T_AGGA = WS_T + 309 * MiB, T_AGGB = WS_T + 314 * MiB, T_CIN = WS_T + 319 * MiB;
constexpr size_t T_SSDY = WS_T + 324 * MiB, T_OTMP = WS_T + 392 * MiB;
constexpr size_t T_MACC = WS_T, T_MB = WS_T + 136 * MiB;
constexpr size_t WS_EGU = WS_T + 468 * MiB, WS_ED = WS_EGU + 176 * MiB;
constexpr size_t WS_END = WS_ED + 88 * MiB;
static_assert(WS_WIN + (size_t)NP * D * 2 <= WS_WBR && WS_WBR + (size_t)3 * D * 1024 * 2 <= WS_WOUT && WS_WOUT + (size_t)D * D * 2 <= WS_WG && WS_WG + (size_t)4096 * 256 * 2 <= WS_P, "A-set map");
static_assert(WS_P + (size_t)M * NP * 2 <= WS_H && WS_FS + (size_t)MOE_ROWS * D * 2 <= WS_H && WS_XG + (size_t)MOE_ROWS * D * 2 <= WS_ACT && WS_ACT + (size_t)MOE_ROWS * DE * 2 <= WS_FS, "p map");
static_assert(WS_H + (size_t)M * D * 2 <= WS_BR && WS_BR + (size_t)3 * M * 1024 * 2 <= WS_T, "h/br map");
static_assert(T_OTMP + (size_t)M * D * 2 <= WS_EGU && WS_EGU + (size_t)NE * 2816 * D * 2 <= WS_ED && WS_ED + (size_t)NE * D * DE * 2 <= WS_END && T_MACC + (size_t)M * D * 4 <= T_MB && T_MB + (size_t)M * D * 2 <= WS_EGU, "T map");
static_assert(T_AGGA + (size_t)2 * NB * NCH * 1024 * 4 <= T_AGGB && T_AGGB + (size_t)2 * NB * NCH * 1024 * 4 <= T_CIN && T_CIN + (size_t)2 * NB * NCH * 1024 * 4 <= T_SSDY, "agg map");
constexpr int CW_TMO = 0, CW_BAR = 4096, CW_GCNT = 16384  , CW_NMT = 16384 + 64  , CW_TILEE = 20480  , CW_ATTQ = 16384 + 1024  ;

constexpr int RING_BYTES = 155648, MISC_OFF = RING_BYTES + 320, LDS_BYTES = 163840;
constexpr int NWAVES = 8, NTHR = 512;

#define LDS_WAIT() asm volatile("s_waitcnt lgkmcnt(0)" ::: "memory")
#define VM_WAIT() asm volatile("s_waitcnt vmcnt(0)" ::: "memory")
#define RLX_AGENT __ATOMIC_RELAXED, __HIP_MEMORY_SCOPE_AGENT
__device__ __forceinline__ unsigned f2bf(float f) { unsigned u = __builtin_bit_cast(unsigned, f); return (u + 0x7fffu + ((u >> 16) & 1u)) >> 16; }
__device__ __forceinline__ unsigned pk2(float lo, float hi) { return f2bf(lo) | (f2bf(hi) << 16); }
__device__ __forceinline__ float bflo(unsigned w) { return __builtin_bit_cast(float, w << 16); }
__device__ __forceinline__ float bfhi(unsigned w) { return __builtin_bit_cast(float, w & 0xffff0000u); }
__device__ __forceinline__ void unpack8(v4u w, float (&o)[8]) { o[0] = bflo(w.x); o[1] = bfhi(w.x); o[2] = bflo(w.y); o[3] = bfhi(w.y); o[4] = bflo(w.z); o[5] = bfhi(w.z); o[6] = bflo(w.w); o[7] = bfhi(w.w); }
__device__ __forceinline__ v4u pack8(const float (&o)[8]) { v4u w; w.x = pk2(o[0], o[1]); w.y = pk2(o[2], o[3]); w.z = pk2(o[4], o[5]); w.w = pk2(o[6], o[7]); return w; }
__device__ __forceinline__ float clamp8(float v) { return fminf(fmaxf(v, -448.f), 448.f); }
__device__ __forceinline__ v2u pack8_fp8(const float (&o)[8]) {
    int w0 = 0, w1 = 0;
    w0 = __builtin_amdgcn_cvt_pk_fp8_f32(clamp8(o[0]), clamp8(o[1]), w0, false); w0 = __builtin_amdgcn_cvt_pk_fp8_f32(clamp8(o[2]), clamp8(o[3]), w0, true);
    w1 = __builtin_amdgcn_cvt_pk_fp8_f32(clamp8(o[4]), clamp8(o[5]), w1, false); w1 = __builtin_amdgcn_cvt_pk_fp8_f32(clamp8(o[6]), clamp8(o[7]), w1, true);
    return (v2u){(unsigned)w0, (unsigned)w1}; }
#define DPP_ADD(v, ctrl) v += __int_as_float(__builtin_amdgcn_update_dpp(0, __float_as_int(v), ctrl, 0xF, 0xF, true))
__device__ __forceinline__ float wave_sum(float v) {
    DPP_ADD(v, 0xB1); DPP_ADD(v, 0x4E); DPP_ADD(v, 0x141); DPP_ADD(v, 0x140);
    { const auto r = __builtin_amdgcn_permlane16_swap(__float_as_uint(v), __float_as_uint(v), false, false); const unsigned r0 = r[0], r1 = r[1]; v = __uint_as_float(r0) + __uint_as_float(r1); }
    { const auto r = __builtin_amdgcn_permlane32_swap(__float_as_uint(v), __float_as_uint(v), false, false); const unsigned r0 = r[0], r1 = r[1]; v = __uint_as_float(r0) + __uint_as_float(r1); }
    return v;
}
__device__ __forceinline__ float sum8(float v) { DPP_ADD(v, 0xB1); DPP_ADD(v, 0x4E); DPP_ADD(v, 0x141); return v; }
__device__ __forceinline__ float sigmoidf_(float x) { return 1.f / (1.f + __expf(-x)); }
__device__ __forceinline__ float siluf_(float x) { return x / (1.f + __expf(-x)); }
__device__ __forceinline__ float softplusf_(float x) { return x > 20.f ? x : log1pf(__expf(x)); }
__device__ __forceinline__ float gelu_tanh(float x) { const float u = 0.7978845608028654f * (x + 0.044715f * x * x * x); const float e = __expf(2.f * u); const float t = 1.f - 2.f / (e + 1.f); return 0.5f * x * (1.f + t); }

namespace pg8 {
constexpr int BM = 256, BK = 64, HALF = 128, HTB = HALF * BK * 2, STAGE_BYTES = 8 * HTB;
__host__ __device__ __forceinline__ int lds_byte(int r, int c) { const int st = (r >> 4) * 2 + (c >> 5), rr = r & 15, cc = c & 31, ob = rr * 64 + cc * 2; return st * 1024 + (ob ^ (((ob >> 9) & 1) << 5)); }
__host__ __device__ __forceinline__ void stage_rc(int b, int& R, int& C) { const int st = b / 1024, sb = b % 1024, swz = sb ^ (((sb >> 9) & 1) << 5); R = (st >> 1) * 16 + swz / 64; C = (st & 1) * 32 + (swz % 64) / 2; }
__host__ __device__ __forceinline__ int perm32(int rho) { const int n = rho >> 4, i = rho & 15; return 8 * (i >> 2) + 4 * n + (i & 3); }

struct Unit { int pm, pn, aux; const char* a; const char* b; };
struct Gemm { int K, lda, ldb; };

__device__ __forceinline__ bool tile_of(long L, int nM, int nN, int& pm, int& pn) {
    const int nwg = nM * nN; if (L >= nwg) return false;
    int wgid = (int)L; { const int q = nwg / 8, r = nwg % 8, xcd = wgid % 8, off = wgid / 8; wgid = (xcd < r ? xcd * (q + 1) : r * (q + 1) + (xcd - r) * q) + off; }
    const int nig = 8 * nN, gid = wgid / nig, fm = gid * 8, gsz = (nM - fm) < 8 ? (nM - fm) : 8;
    pm = fm + ((wgid % nig) % gsz); pn = (wgid % nig) / gsz; return true;
}

__device__ __forceinline__ unsigned cvt_pk_bf16(float lo, float hi) { unsigned r; asm volatile("v_cvt_pk_bf16_f32 %0, %1, %2" : "=v"(r) : "v"(lo), "v"(hi)); return r; }

typedef int v8i __attribute__((ext_vector_type(8)));
typedef int v4i __attribute__((ext_vector_type(4)));
template <class Epi, class Sched, bool ALIGN_EPI = false, bool SP2 = false, bool FP8 = false, bool HALFM = false>
__device__ __forceinline__ void gemm_phase(LAS unsigned char* lds, const int tid, const Gemm g, const Sched& S, const Epi& E) {
    const int wid = __builtin_amdgcn_readfirstlane(tid >> 6), lane = tid & 63, wr = wid >> 2, wc = wid & 3, fr = lane & 15, fq = lane >> 4;
    const int K = g.K, nt = K / BK;
    unsigned voffA[2], voffB[2];
#pragma unroll
    for (int i = 0; i < 2; ++i) { int R, C; stage_rc(tid * 16 + i * 8192, R, C); const int Rb = Epi::PERM ? ((R & ~31) + perm32(R & 31)) : R;
        voffA[i] = (unsigned)(R * g.lda + C) * 2u; voffB[i] = (unsigned)(Rb * g.ldb + C) * 2u; }
    const size_t kstep = (size_t)(BK * 2);
    static_assert(!HALFM || SP2, "HALFM is written for the SP2 loop");
    const size_t hstepA = HALFM ? (size_t)0 : (size_t)HALF * g.lda * 2, hstepB = (size_t)HALF * g.ldb * 2;
    const unsigned ldsw = (unsigned)wid * 1024u;
    const int aoff = lds_byte(wr * 64 + fr, fq * 8), boff = lds_byte(wc * 32 + fr, fq * 8);
#define PG8_SA(b, h) (((b) * 2 + (h)) * HTB)
#define PG8_SB(b, h) ((4 + (b) * 2 + (h)) * HTB)
#define PG8_STAGE(bufoff, gbase, voff) do { _Pragma("unroll") for (int _i = 0; _i < 2; ++_i) \
        __builtin_amdgcn_global_load_lds((const unsigned*)((const char*)(gbase) + (voff)[_i]), (LAS unsigned*)(lds + (bufoff) + ldsw + _i * 8192), 16, 0, 0); } while (0)
#define PG8_LDA(dst, b, h) do { _Pragma("unroll") for (int m = 0; m < 4; ++m) { if constexpr (FP8) { const v4i lo_ = *(const LAS v4i*)(lds + PG8_SA(b, h) + aoff + m * 2048), hi_ = *(const LAS v4i*)(lds + PG8_SA(b, h) + aoff + m * 2048 + 1024); dst##8[m] = __builtin_shufflevector(lo_, hi_, 0, 1, 2, 3, 4, 5, 6, 7); } \
        else { _Pragma("unroll") for (int k = 0; k < 2; ++k) dst[m][k] = *(const LAS bf16x8*)(lds + PG8_SA(b, h) + aoff + m * 2048 + k * 1024); } } } while (0)
#define PG8_LDB(dst, b, h) do { _Pragma("unroll") for (int n = 0; n < 2; ++n) { if constexpr (FP8) { const v4i lo_ = *(const LAS v4i*)(lds + PG8_SB(b, h) + boff + n * 2048), hi_ = *(const LAS v4i*)(lds + PG8_SB(b, h) + boff + n * 2048 + 1024); dst##8[n] = __builtin_shufflevector(lo_, hi_, 0, 1, 2, 3, 4, 5, 6, 7); } \
        else { _Pragma("unroll") for (int k = 0; k < 2; ++k) dst[n][k] = *(const LAS bf16x8*)(lds + PG8_SB(b, h) + boff + n * 2048 + k * 1024); } } } while (0)
#define PG8_MMA(ai, bj, At, Bt) do { __builtin_amdgcn_s_setprio(1); _Pragma("unroll") for (int m = 0; m < 4; ++m) _Pragma("unroll") for (int n = 0; n < 2; ++n) { \
        if constexpr (FP8) acc[ai][bj][m][n] = __builtin_amdgcn_mfma_scale_f32_16x16x128_f8f6f4(Bt##8[n], At##8[m], acc[ai][bj][m][n], 0, 0, 0, 0x7f7f7f7f, 0, 0x7f7f7f7f); \
        else { _Pragma("unroll") for (int k = 0; k < 2; ++k) acc[ai][bj][m][n] = __builtin_amdgcn_mfma_f32_16x16x32_bf16(Bt[n][k], At[m][k], acc[ai][bj][m][n], 0, 0, 0); } } \
        __builtin_amdgcn_s_setprio(0); } while (0)
#define PG8_WAIT_V(n) asm volatile("s_waitcnt vmcnt(" #n ")" ::: "memory")
#define PG8_WAIT_L(n) asm volatile("s_waitcnt lgkmcnt(" #n ")" ::: "memory")
#define PG8_BAR __builtin_amdgcn_s_barrier()
#define PG8_SCHED __builtin_amdgcn_sched_barrier(0)
    Unit cur, nxt; int ui = 0;
    if (!S.next(0, cur)) return;
    f32x4 acc[2][2][4][2];
#pragma unroll
    for (int a = 0; a < 2; ++a)
#pragma unroll
        for (int b = 0; b < 2; ++b)
#pragma unroll
            for (int m = 0; m < 4; ++m)
#pragma unroll
                for (int n = 0; n < 2; ++n) acc[a][b][m][n] = (f32x4){0.f, 0.f, 0.f, 0.f};
    bf16x8 At[4][2], B0[2][2], B1[2][2]; v8i At8[4], B08[2], B18[2];
    const char* cA = cur.a; const char* cB = cur.b;
    S.a_ready(cur);
    if constexpr (SP2) {
        PG8_STAGE(PG8_SB(0, 0), cB, voffB); PG8_STAGE(PG8_SB(0, 1), cB + hstepB, voffB); PG8_STAGE(PG8_SA(0, 0), cA, voffA); PG8_STAGE(PG8_SA(0, 1), cA + hstepA, voffA);
        if (wr == 1) PG8_BAR;
        PG8_WAIT_V(2); PG8_BAR;
        PG8_STAGE(PG8_SB(1, 0), cB + kstep, voffB); PG8_STAGE(PG8_SA(1, 0), cA + kstep, voffA); PG8_STAGE(PG8_SB(1, 1), cB + hstepB + kstep, voffB);
        PG8_WAIT_V(6); PG8_BAR;
    } else {
        PG8_STAGE(PG8_SB(0, 0), cB, voffB); PG8_STAGE(PG8_SA(0, 0), cA, voffA); PG8_STAGE(PG8_SB(0, 1), cB + hstepB, voffB); PG8_STAGE(PG8_SA(0, 1), cA + hstepA, voffA);
        if (wr == 1) PG8_BAR;
        PG8_WAIT_V(4); PG8_BAR;
        PG8_STAGE(PG8_SB(1, 0), cB + kstep, voffB); PG8_STAGE(PG8_SA(1, 0), cA + kstep, voffA); PG8_STAGE(PG8_SB(1, 1), cB + hstepB + kstep, voffB);
        PG8_WAIT_V(6); PG8_BAR;
    }
    for (;;) {
        const bool has_next = S.next(ui + 1, nxt);
        const char* nA = has_next ? nxt.a : cA; const char* nB = has_next ? nxt.b : cB;
#pragma unroll 1
        for (int t = 0; t < nt; t += 2) {
            const bool last = (t == nt - 2);
            const char* a1 = cA + (size_t)(t + 1) * kstep;
            const char* a2 = last ? nA : cA + (size_t)(t + 2) * kstep; const char* b2 = last ? nB : cB + (size_t)(t + 2) * kstep;
            const char* a3 = a2 + kstep; const char* b3 = b2 + kstep;
            if (last && has_next) S.a_ready(nxt);
            if constexpr (SP2) {
            PG8_LDB(B0, 0, 0); PG8_LDB(B1, 0, 1); PG8_SCHED; PG8_LDA(At, 0, 0); PG8_STAGE(PG8_SA(1, 1), a1 + hstepA, voffA);
            PG8_WAIT_V(8); PG8_WAIT_L(0); PG8_BAR; PG8_MMA(0, 0, At, B0); PG8_MMA(0, 1, At, B1); PG8_BAR; PG8_SCHED;
            if constexpr (!HALFM) PG8_LDA(At, 0, 1);
            PG8_STAGE(PG8_SB(0, 0), b2, voffB); PG8_STAGE(PG8_SB(0, 1), b2 + hstepB, voffB); PG8_STAGE(PG8_SA(0, 0), a2, voffA);
            PG8_WAIT_V(8); PG8_WAIT_L(0); PG8_BAR; if constexpr (!HALFM) { PG8_MMA(1, 0, At, B0); PG8_MMA(1, 1, At, B1); } PG8_BAR; PG8_SCHED;
            PG8_LDB(B0, 1, 0); PG8_LDB(B1, 1, 1); PG8_SCHED; PG8_LDA(At, 1, 0); PG8_STAGE(PG8_SA(0, 1), a2 + hstepA, voffA);
            PG8_WAIT_V(8); PG8_WAIT_L(0); PG8_BAR; PG8_MMA(0, 0, At, B0); PG8_MMA(0, 1, At, B1); PG8_BAR; PG8_SCHED;
            if constexpr (!HALFM) PG8_LDA(At, 1, 1);
            PG8_STAGE(PG8_SB(1, 0), b3, voffB); PG8_STAGE(PG8_SB(1, 1), b3 + hstepB, voffB); PG8_STAGE(PG8_SA(1, 0), a3, voffA);
            PG8_WAIT_V(8); PG8_WAIT_L(0); PG8_BAR; if constexpr (!HALFM) { PG8_MMA(1, 0, At, B0); PG8_MMA(1, 1, At, B1); } PG8_BAR; PG8_SCHED;
            } else {
            PG8_LDB(B0, 0, 0); PG8_SCHED; PG8_LDA(At, 0, 0); PG8_STAGE(PG8_SA(1, 1), a1 + hstepA, voffA);
            PG8_WAIT_L(8); PG8_BAR; PG8_WAIT_L(0); PG8_MMA(0, 0, At, B0); PG8_BAR; PG8_SCHED;
            PG8_LDB(B1, 0, 1); PG8_STAGE(PG8_SB(0, 0), b2, voffB);
            PG8_BAR; PG8_WAIT_L(0); PG8_MMA(0, 1, At, B1); PG8_BAR;
            PG8_LDA(At, 0, 1); PG8_STAGE(PG8_SA(0, 0), a2, voffA);
            PG8_BAR; PG8_WAIT_L(0); PG8_MMA(1, 0, At, B0); PG8_BAR; PG8_SCHED;
            PG8_STAGE(PG8_SB(0, 1), b2 + hstepB, voffB);
            PG8_WAIT_V(6); PG8_BAR; PG8_MMA(1, 1, At, B1); PG8_BAR;
            PG8_LDB(B0, 1, 0); PG8_SCHED; PG8_LDA(At, 1, 0); PG8_STAGE(PG8_SA(0, 1), a2 + hstepA, voffA);
            PG8_WAIT_L(8); PG8_BAR; PG8_WAIT_L(0); PG8_MMA(0, 0, At, B0); PG8_BAR; PG8_SCHED;
            PG8_LDB(B1, 1, 1); PG8_STAGE(PG8_SB(1, 0), b3, voffB);
            PG8_BAR; PG8_WAIT_L(0); PG8_MMA(0, 1, At, B1); PG8_BAR;
            PG8_LDA(At, 1, 1); PG8_STAGE(PG8_SA(1, 0), a3, voffA);
            PG8_BAR; PG8_WAIT_L(0); PG8_MMA(1, 0, At, B0); PG8_BAR; PG8_SCHED;
            PG8_STAGE(PG8_SB(1, 1), b3 + hstepB, voffB);
            PG8_WAIT_V(6); PG8_BAR; PG8_MMA(1, 1, At, B1); PG8_BAR;
            }
        }
        if constexpr (ALIGN_EPI) { if (wr == 0) PG8_BAR; }
        const bool carry = E(acc, cur, wr, wc, fr, fq); S.done(cur);
        if (!has_next) break;
        if (!carry)
#pragma unroll
        for (int a = 0; a < 2; ++a)
#pragma unroll
            for (int b = 0; b < 2; ++b)
#pragma unroll
                for (int m = 0; m < 4; ++m)
#pragma unroll
                    for (int n = 0; n < 2; ++n) acc[a][b][m][n] = (f32x4){0.f, 0.f, 0.f, 0.f};
        cur = nxt; cA = nA; cB = nB; ++ui;
        if constexpr (ALIGN_EPI) { if (wr == 1) PG8_BAR; }
    }
    PG8_WAIT_V(0);
    if constexpr (!ALIGN_EPI) { if (wr == 0) PG8_BAR; }
    PG8_BAR;
#undef PG8_SA
#undef PG8_SB
#undef PG8_STAGE
#undef PG8_LDA
#undef PG8_LDB
#undef PG8_MMA
#undef PG8_WAIT_V
#undef PG8_WAIT_L
#undef PG8_BAR
#undef PG8_SCHED
}
}

struct SchedPlain {
    int nM, nN, G, c; const char* A; const char* B; size_t a_tile, b_tile; int skipctx;
    __device__ __forceinline__ bool next(int i, pg8::Unit& u) const {
        if (!pg8::tile_of((long)i * G + c, nM, nN, u.pm, u.pn)) return false;
        if (skipctx) u.pm = (u.pm >> 4) * 17 + 1 + (u.pm & 15);
        u.aux = 0; u.a = A + (size_t)u.pm * a_tile; u.b = B + (size_t)u.pn * b_tile; return true; }
    __device__ __forceinline__ void a_ready(const pg8::Unit&) const {}
    __device__ __forceinline__ void done(const pg8::Unit&) const {}
};
struct SchedIn {
    int G, c, last; const char* A; const char* B;
    __device__ __forceinline__ bool next(int i, pg8::Unit& u) const {
        const long L = (long)i * G + c;
        if (!last) { if (!pg8::tile_of(L, M / 256, NP / 256, u.pm, u.pn)) return false; }
        else if (L < 64 * 57) { pg8::tile_of(L, 64, NP / 256, u.pm, u.pn); u.pm = (u.pm >> 4) * 17 + 1 + (u.pm & 15); }
        else { const int r = (int)(L - 64 * 57); if (r >= 4 * 21) return false; const int k = r % 21; u.pm = (r / 21) * 17;
            u.pn = k < 4 ? k : (k < 12 ? 8 + k : (k < 20 ? 12 + k : 56)); }
        u.aux = 0; u.a = A + (size_t)u.pm * 256 * D * 2; u.b = B + (size_t)u.pn * 256 * D * 2; return true; }
    __device__ __forceinline__ void a_ready(const pg8::Unit&) const {}
    __device__ __forceinline__ void done(const pg8::Unit&) const {}
};
struct SchedLru {
    int G, c; const char* xc; const char* wg;
    __device__ __forceinline__ bool next(int i, pg8::Unit& u) const {
        if (!pg8::tile_of((long)i * G + c, M / 256, 16, u.pm, u.pn)) return false;
        u.aux = 0; u.a = xc + (size_t)u.pm * 256 * 1024 * 2 + (size_t)((u.pn & 7) >> 1) * 256 * 2; u.b = wg + (size_t)u.pn * 256 * 256 * 2; return true; }
    __device__ __forceinline__ void a_ready(const pg8::Unit&) const {}
    __device__ __forceinline__ void done(const pg8::Unit&) const {}
};
struct SchedMerge {
    int G, c; const char* br; const char* wbr; int skipctx;
    __device__ __forceinline__ bool next(int i, pg8::Unit& u) const {
        const int T = i / 3, k = i - 3 * T;
        if (!pg8::tile_of((long)T * G + c, skipctx ? 64 : M / 256, D / 256, u.pm, u.pn)) return false;
        if (skipctx) u.pm = (u.pm >> 4) * 17 + 1 + (u.pm & 15);
        u.aux = k; u.a = br + ((size_t)k * M + (size_t)u.pm * 256) * 1024 * 2; u.b = wbr + ((size_t)k * D + (size_t)u.pn * 256) * 1024 * 2; return true; }
    __device__ __forceinline__ void a_ready(const pg8::Unit&) const {}
    __device__ __forceinline__ void done(const pg8::Unit&) const {}
};
struct SchedMoe {
    int nM, nN, G, c; const char* A; const char* W; size_t a_tile, w_exp, w_tile; const unsigned* tile_e;
    __device__ __forceinline__ bool next(int i, pg8::Unit& u) const {
        if (!pg8::tile_of((long)i * G + c, nM, nN, u.pm, u.pn)) return false;
        const int e = (int)(__builtin_amdgcn_readfirstlane(tile_e[u.pm & 511]) & 15u);
        u.aux = e; u.a = A + (size_t)u.pm * a_tile; u.b = W + (size_t)e * w_exp + (size_t)u.pn * w_tile; return true; }
    __device__ __forceinline__ void a_ready(const pg8::Unit&) const {}
    __device__ __forceinline__ void done(const pg8::Unit&) const {}
};

typedef f32x4 (&AccRef)[2][2][4][2];
struct EpiP {
    static constexpr bool PERM = true; bf16* O;
    __device__ __forceinline__ bool operator()(AccRef acc, const pg8::Unit& u, int wr, int wc, int fr, int fq) const {
        const int row0 = u.pm * 256 + wr * 64 + fr, col0 = u.pn * 256 + wc * 32 + 8 * fq;
#pragma unroll
        for (int ai = 0; ai < 2; ++ai)
#pragma unroll
            for (int m = 0; m < 4; ++m) { bf16* rowp = O + (size_t)(row0 + ai * 128 + m * 16) * NP + col0;
#pragma unroll
                for (int bj = 0; bj < 2; ++bj) { const f32x4 v0 = acc[ai][bj][m][0], v1 = acc[ai][bj][m][1]; v4u w;
                    w.x = pg8::cvt_pk_bf16(v0[0], v0[1]); w.y = pg8::cvt_pk_bf16(v0[2], v0[3]); w.z = pg8::cvt_pk_bf16(v1[0], v1[1]); w.w = pg8::cvt_pk_bf16(v1[2], v1[3]);
                    *(v4u*)(rowp + bj * 128) = w; } }
        return false;
    }
};
struct EpiLru {
    static constexpr bool PERM = true; const bf16* xc; const float* gate_b; const float* lam; bf16* la; bf16* bb;
    __device__ __forceinline__ bool operator()(AccRef acc, const pg8::Unit& u, int wr, int wc, int fr, int fq) const {
        const int d = u.pn >> 3, blk = u.pn & 7, c0 = blk * 128 + wc * 32 + 8 * fq;
        float br[8], bi[8], sp[8];
#pragma unroll
        for (int n = 0; n < 2; ++n) { const f32x4 b0 = *(const f32x4*)(gate_b + (d * 2 + 0) * 1024 + c0 + 4 * n), b1 = *(const f32x4*)(gate_b + (d * 2 + 1) * 1024 + c0 + 4 * n), lm = *(const f32x4*)(lam + d * 1024 + c0 + 4 * n);
#pragma unroll
            for (int j = 0; j < 4; ++j) { br[4 * n + j] = b0[j]; bi[4 * n + j] = b1[j]; sp[4 * n + j] = softplusf_(-lm[j]) * (8.f * 1.4426950408889634f); } }
        v4u xw[2][4];
#pragma unroll
        for (int ai = 0; ai < 2; ++ai)
#pragma unroll
            for (int m = 0; m < 4; ++m) xw[ai][m] = *(const v4u*)(xc + (size_t)(u.pm * 256 + ai * 128 + wr * 64 + m * 16 + fr) * 1024 + c0);
#pragma unroll
        for (int ai = 0; ai < 2; ++ai)
#pragma unroll
            for (int m = 0; m < 4; ++m) { const int row = u.pm * 256 + ai * 128 + wr * 64 + m * 16 + fr;
                float x8[8], lo[8], bo[8]; unpack8(xw[ai][m], x8);
#pragma unroll
                for (int j = 0; j < 8; ++j) { const float ea = __expf(-(acc[ai][0][m][j >> 2][j & 3] + br[j])), eb = __expf(-(acc[ai][1][m][j >> 2][j & 3] + bi[j]));
                    const float inv = __builtin_amdgcn_rcpf((1.f + ea) * (1.f + eb)), r = (1.f + eb) * inv, ig = (1.f + ea) * inv, la2 = -r * sp[j];
                    lo[j] = la2; bo[j] = __builtin_amdgcn_sqrtf(fmaxf(1.f - __builtin_amdgcn_exp2f(2.f * la2), 0.f)) * ig * x8[j]; }
                *(v4u*)(la + ((size_t)d * M + row) * 1024 + c0) = pack8(lo); *(v4u*)(bb + ((size_t)d * M + row) * 1024 + c0) = pack8(bo); }
        return false;
    }
};
struct EpiMerge {
    static constexpr bool PERM = true; const bf16* p; bf16* mb;
    __device__ __forceinline__ bool operator()(AccRef acc, const pg8::Unit& u, int wr, int wc, int fr, int fq) const {
        const int k = u.aux, col0 = u.pn * 256 + wc * 32 + 8 * fq; const int k2 = k < 2 ? k + 1 : k;
#pragma unroll
        for (int ai = 0; ai < 2; ++ai) {
            v4u wa[4][2], wb[4][2];
#pragma unroll
            for (int m = 0; m < 4; ++m)
#pragma unroll
                for (int bj = 0; bj < 2; ++bj) { const bf16* gp = p + (size_t)(u.pm * 256 + ai * 128 + wr * 64 + m * 16 + fr) * NP + P_G + col0 + bj * 128;
                    wa[m][bj] = *(const v4u*)(gp + k * D); wb[m][bj] = *(const v4u*)(gp + k2 * D); }
#pragma unroll
            for (int m = 0; m < 4; ++m) { const int row = u.pm * 256 + ai * 128 + wr * 64 + m * 16 + fr;
#pragma unroll
                for (int bj = 0; bj < 2; ++bj) { const int col = col0 + bj * 128; float ga[8]; unpack8(wa[m][bj], ga);
                    if (k < 2) { float gb[8]; unpack8(wb[m][bj], gb);
#pragma unroll
                        for (int j = 0; j < 8; ++j) { const float ea = __expf(-fminf(fmaxf(ga[j], -30.f), 30.f)), eb = __expf(-fminf(fmaxf(gb[j], -30.f), 30.f));
                            acc[ai][bj][m][j >> 2][j & 3] *= (1.f + eb) * __builtin_amdgcn_rcpf(1.f + ea); } }
                    else { float t[8];
#pragma unroll
                        for (int j = 0; j < 8; ++j) t[j] = sigmoidf_(ga[j]) * acc[ai][bj][m][j >> 2][j & 3];
                        *(v4u*)(mb + (size_t)row * D + col) = pack8(t); } } } }
        return k < 2;
    }
};
struct EpiWout {
    static constexpr bool PERM = true; const float* res_lat; const float* res_ctx; const float* g1; float* y;
    __device__ __forceinline__ bool operator()(AccRef acc, const pg8::Unit& u, int wr, int wc, int fr, int fq) const {
        const int b = u.pm / 17, jt = u.pm - 17 * b; const bool isctx = (jt == 0); const int mrow = isctx ? 4 : b, col0 = u.pn * 256 + wc * 32 + 8 * fq;
        f32x4 gv[2][2];
#pragma unroll
        for (int bj = 0; bj < 2; ++bj)
#pragma unroll
            for (int n = 0; n < 2; ++n) gv[bj][n] = *(const f32x4*)(g1 + (size_t)mrow * NADA + col0 + bj * 128 + 4 * n);
#pragma unroll
        for (int ai = 0; ai < 2; ++ai) {
            f32x4 rv[4][2][2];
#pragma unroll
            for (int m = 0; m < 4; ++m) { const int j = jt * 256 + ai * 128 + wr * 64 + m * 16 + fr;
                const float* rp = isctx ? res_ctx + ((size_t)b * LC + j) * D : res_lat + ((size_t)b * LL + (j - LC)) * D;
#pragma unroll
                for (int bj = 0; bj < 2; ++bj)
#pragma unroll
                    for (int n = 0; n < 2; ++n) rv[m][bj][n] = *(const f32x4*)(rp + col0 + bj * 128 + 4 * n); }
#pragma unroll
            for (int m = 0; m < 4; ++m) { const int j = jt * 256 + ai * 128 + wr * 64 + m * 16 + fr; const size_t row = (size_t)b * LT + j;
#pragma unroll
                for (int bj = 0; bj < 2; ++bj)
#pragma unroll
                    for (int n = 0; n < 2; ++n) *(f32x4*)(y + row * D + col0 + bj * 128 + 4 * n) = rv[m][bj][n] * DN_ALPHA + gv[bj][n] * acc[ai][bj][m][n]; } }
        return false;
    }
};
struct EpiMoe1 {
    static constexpr bool PERM = true; unsigned char* act;
    __device__ __forceinline__ bool operator()(AccRef acc, const pg8::Unit& u, int wr, int wc, int fr, int fq) const {
        const int col = u.pn * 128 + wc * 32 + 8 * fq;
#pragma unroll
        for (int m = 0; m < 4; ++m) { const int row = u.pm * 128 + wr * 64 + m * 16 + fr; float t[8];
#pragma unroll
            for (int j = 0; j < 8; ++j) t[j] = siluf_(acc[0][0][m][j >> 2][j & 3] * (1.f / WSC_GU)) * (acc[0][1][m][j >> 2][j & 3] * (1.f / WSC_GU));
            *(v2u*)(act + (size_t)row * DEP + col) = pack8_fp8(t);
            if (u.pn == 10) *(v2u*)(act + (size_t)row * DEP + col + 128) = (v2u){0u, 0u}; }
        return false;
    }
};
struct EpiMoe2 {
    static constexpr bool PERM = true; bf16* fs;
    __device__ __forceinline__ bool operator()(AccRef acc, const pg8::Unit& u, int wr, int wc, int fr, int fq) const {
        const int col0 = u.pn * 256 + wc * 32 + 8 * fq;
#pragma unroll
        for (int m = 0; m < 4; ++m) { const int row = u.pm * 128 + wr * 64 + m * 16 + fr;
#pragma unroll
            for (int bj = 0; bj < 2; ++bj) { const f32x4 v0 = acc[0][bj][m][0] * (1.f / WSC_D), v1 = acc[0][bj][m][1] * (1.f / WSC_D); v4u w;
                w.x = pg8::cvt_pk_bf16(v0[0], v0[1]); w.y = pg8::cvt_pk_bf16(v0[2], v0[3]); w.z = pg8::cvt_pk_bf16(v1[0], v1[1]); w.w = pg8::cvt_pk_bf16(v1[2], v1[3]);
                *(v4u*)(fs + (size_t)row * D + col0 + bj * 128) = w; } }
        return false;
    }
};

#define XB_TMO      128
#define XB_XCNT(j)  (256  + 64 * (j))
#define XB_XSUB(j)  (1280 + 64 * (j))
#define XB_XGEN(j)  (2304 + 64 * (j))
#define XB_TOP      3328
#define XB_TOPGEN   3392
#define XCD_BAR_WORDS 3456
#define XB_SPIN_CAP (1u << 22)

__device__ __forceinline__ unsigned xb_ld(unsigned* p)              { return __hip_atomic_load(p, __ATOMIC_RELAXED, __HIP_MEMORY_SCOPE_AGENT); }
__device__ __forceinline__ unsigned xb_add(unsigned* p, unsigned v) { return __hip_atomic_fetch_add(p, v, __ATOMIC_RELAXED, __HIP_MEMORY_SCOPE_AGENT); }
__device__ __forceinline__ unsigned xb_xcc_id() { return (unsigned)__builtin_amdgcn_s_getreg((3 << 11) | 20) & 0xFu; }
#define XB_SPIN(cond, bar) do { unsigned _sp = 0; while (cond) { __builtin_amdgcn_s_sleep(1); \
    if ((++_sp & 255u) == 0u) { if (xb_ld(&(bar)[XB_TMO])) break; if (_sp > XB_SPIN_CAP) { atomicAdd(&(bar)[XB_TMO], 1u); break; } } } } while (0)

struct XcdBarrier { unsigned* bar; unsigned x; volatile LAS unsigned* st; };

__device__ __forceinline__ XcdBarrier xcd_barrier_post(unsigned* bar, volatile LAS unsigned* st) {
    XcdBarrier b; b.bar = bar; b.x = xb_xcc_id(); b.st = st;
    if (threadIdx.x == 0) (void)xb_add(&bar[XB_XCNT(b.x)], 1u);
    return b;
}
__device__ __forceinline__ void xcd_barrier_complete(unsigned* bar, unsigned x, unsigned& nloc, unsigned& nx) {
    const unsigned G = gridDim.x * gridDim.y * gridDim.z;
    unsigned sum, cnt, mine, sp = 0u;
    for (;;) {
        sum = 0u; cnt = 0u; mine = 0u;
#pragma unroll
        for (unsigned j = 0; j < 16; ++j) { const unsigned c = xb_ld(&bar[XB_XCNT(j)]); sum += c; cnt += (c > 0u) ? 1u : 0u; mine = (j == x) ? c : mine; }
        if (sum == G) break;
        __builtin_amdgcn_s_sleep(1);
        if ((++sp & 255u) == 0u) { if (xb_ld(&bar[XB_TMO])) break; if (sp > XB_SPIN_CAP) { atomicAdd(&bar[XB_TMO], 1u); break; } }
    }
    nloc = mine > 0u ? mine : 1u; nx = cnt > 0u ? cnt : 1u;
}
__device__ __forceinline__ void xcd_barrier(const XcdBarrier& b) {
    asm volatile("s_waitcnt vmcnt(0)" ::: "memory");
    __syncthreads();
    if (threadIdx.x == 0) {
        unsigned* bar = b.bar;
        __builtin_amdgcn_s_waitcnt(0);
        unsigned nloc = b.st[0], nx = b.st[1];
        if (nloc == 0u) { xcd_barrier_complete(bar, b.x, nloc, nx); b.st[0] = nloc; b.st[1] = nx; }
        const unsigned old = xb_add(&bar[XB_XSUB(b.x)], 1u);
        const unsigned gen = old / nloc;
        if (old + 1u == (gen + 1u) * nloc) {
            __builtin_amdgcn_fence(__ATOMIC_RELEASE, "agent");
            asm volatile("s_waitcnt vmcnt(0)" ::: "memory");
            const unsigned og = xb_add(&bar[XB_TOP], 1u);
            const unsigned tg = og / nx;
            if (og + 1u == (tg + 1u) * nx) xb_add(&bar[XB_TOPGEN], 1u);
            else XB_SPIN(xb_ld(&bar[XB_TOPGEN]) == tg, bar);
            __builtin_amdgcn_fence(__ATOMIC_ACQUIRE, "agent");
            xb_add(&bar[XB_XGEN(b.x)], 1u);
            asm volatile("s_waitcnt vmcnt(0)" ::: "memory");
        } else {
            XB_SPIN(xb_ld(&bar[XB_XGEN(b.x)]) == gen, bar);
            __builtin_amdgcn_fence(__ATOMIC_ACQUIRE, "agent");
            asm volatile("s_waitcnt vmcnt(0)" ::: "memory");
        }
    }
    __syncthreads();
}

struct Args { const float* in[29]; float* out; unsigned char* ws; int ph_lo, ph_hi, li, pad; };
struct Ctx { LAS unsigned char* lds; int tid, lane, wave, vcu, G; };
typedef const __attribute__((address_space(4))) Args& ArgsRef;
enum { I_X = 0, I_C, I_CTX, I_CCTX, I_WADA, I_BADA, I_WIN, I_LCW, I_LCB, I_LGW, I_LGB, I_LLAM, I_SCW, I_SCB, I_SALOG, I_SDTB, I_SD, I_SNW, I_ALAM, I_ANW, I_WBR, I_WOUT, I_LNG, I_LNB, I_WR, I_RB, I_WG, I_WU, I_WD };
#define ROWLOOP for (int r = C.vcu * NWAVES + C.wave; r < M; r += C.G * NWAVES)

__device__ __forceinline__ void ph_modp(ArgsRef a, Ctx C) {
    LAS float* sil = (LAS float*)C.lds;
    const float* c = a.in[I_C]; const float* cctx = a.in[I_CCTX];
    for (int i = C.tid; i < 5 * D; i += NTHR) { const float v = i < 4 * D ? c[i] : cctx[i - 4 * D]; sil[i] = siluf_(v); }
    __syncthreads();
    const float* w_ada = a.in[I_WADA]; float* modp = (float*)(a.ws + WS_MODP);
    for (int it = C.vcu * NWAVES + C.wave; it < 2 * 48 * 16; it += C.G * NWAVES) {
        const int l = it / 768, rem = it % 768, cb = rem / 16, ks = rem % 16, col = cb * 256 + C.lane * 4;
        const float* wp = w_ada + ((size_t)l * D + ks * 128) * NADA + col;
        f32x4 acc[5];
#pragma unroll
        for (int r = 0; r < 5; ++r) acc[r] = (f32x4){0.f, 0.f, 0.f, 0.f};
#pragma unroll 8
        for (int k = 0; k < 128; ++k) { const f32x4 w = *(const f32x4*)(wp + (size_t)k * NADA);
#pragma unroll
            for (int r = 0; r < 5; ++r) acc[r] += w * sil[r * D + ks * 128 + k]; }
#pragma unroll
        for (int r = 0; r < 5; ++r) *(f32x4*)(modp + ((size_t)(l * 16 + ks) * 5 + r) * NADA + col) = acc[r];
    }
    __syncthreads();
}
__device__ __forceinline__ void ph_modr(ArgsRef a, Ctx C) {
    const float* modp = (const float*)(a.ws + WS_MODP); float* mod = (float*)(a.ws + WS_MOD); const float* b_ada = a.in[I_BADA];
    for (int i = C.vcu * NTHR + C.tid; i < 2 * 5 * NADA; i += C.G * NTHR) {
        const int l = i / (5 * NADA), rem = i % (5 * NADA), n = rem % NADA; float s = b_ada[l * NADA + n];
#pragma unroll
        for (int ks = 0; ks < 16; ++ks) s += modp[(size_t)(l * 16 + ks) * 5 * NADA + rem];
        mod[i] = s; }
}
__device__ __forceinline__ void tr_item(const float* W, int N, bf16* WT, int K, int k0, int n0, int drow0, LAS float* scr, int lane) {
#pragma unroll 8
    for (int i = 0; i < 32; ++i) { const int kk = 2 * i + (lane >> 5); scr[kk * 33 + (lane & 31)] = W[(size_t)(k0 + kk) * N + n0 + (lane & 31)]; }
    LDS_WAIT(); asm volatile("" ::: "memory");
    const int c = lane & 7;
#pragma unroll
    for (int j = 0; j < 4; ++j) { const int n = (lane >> 3) + 8 * j; const LAS float* s = scr + (8 * c) * 33 + n;
        v4u o; o.x = pk2(s[0 * 33], s[1 * 33]); o.y = pk2(s[2 * 33], s[3 * 33]); o.z = pk2(s[4 * 33], s[5 * 33]); o.w = pk2(s[6 * 33], s[7 * 33]);
        *(GAS v4u*)(WT + (size_t)(drow0 + n) * K + k0 + 8 * c) = o; }
    LDS_WAIT(); asm volatile("" ::: "memory");
}
__device__ __forceinline__ void ph_conva(ArgsRef a, Ctx C, int l) {
    LAS float* scr = (LAS float*)(C.lds + C.wave * 8448);
    bf16* Wt_in = (bf16*)(a.ws + WS_WIN); bf16* Wt_br = (bf16*)(a.ws + WS_WBR); bf16* Wt_out = (bf16*)(a.ws + WS_WOUT); bf16* Wg = (bf16*)(a.ws + WS_WG);
    constexpr int I_IN = 32 * 449, I_BRN = 3 * 16 * 64, I_OUTN = 32 * 64, I_PAD = NP - DIN, I_WGN = 4096;
    for (int it = C.vcu * NWAVES + C.wave; it < I_IN + I_BRN + I_OUTN + I_PAD + I_WGN; it += C.G * NWAVES) {
        int r = it;
        if (r < I_IN) { const int kb = r / 449, nb = r % 449, n0 = nb * 32, drow0 = n0 < 5120 ? n0 : (n0 == 5120 ? P_DT : n0 - 32);
            tr_item(a.in[I_WIN] + (size_t)l * D * DIN, DIN, Wt_in, D, kb * 64, n0, drow0, scr, C.lane); continue; }
        r -= I_IN;
        if (r < I_BRN) { const int k = r / 1024, r2 = r % 1024, kb = r2 / 64, nb = r2 % 64;
            tr_item(a.in[I_WBR] + (size_t)(l * 3 + k) * 1024 * D, D, Wt_br + (size_t)k * D * 1024, 1024, kb * 64, nb * 32, nb * 32, scr, C.lane); continue; }
        r -= I_BRN;
        if (r < I_OUTN) { const int kb = r / 64, nb = r % 64; tr_item(a.in[I_WOUT] + (size_t)l * D * D, D, Wt_out, D, kb * 64, nb * 32, nb * 32, scr, C.lane); continue; }
        r -= I_OUTN;
        if (r < I_PAD) { bf16* row = Wt_in + (size_t)(DIN + r) * D;
#pragma unroll
            for (int q = 0; q < 4; ++q) *(v4u*)(row + C.lane * 8 + q * 512) = (v4u){0u, 0u, 0u, 0u};
            continue; }
        r -= I_PAD;
        {
            const int pn = r >> 8, n = r & 255, d = pn >> 3, blk = pn & 7, g = n >> 7, cl = n & 127, half = blk & 1;
            const float* gw = a.in[I_LGW] + ((((size_t)(l * 2 + d) * 2 + g) * 8 + blk) * 128) * 128 + cl;
            const int k0 = C.lane * 4; float v[4];
#pragma unroll
            for (int j = 0; j < 4; ++j) { const int k = k0 + j; v[j] = ((k >> 7) == half) ? gw[(size_t)(k & 127) * 128] : 0.f; }
            *(v2u*)(Wg + (size_t)r * 256 + k0) = (v2u){pk2(v[0], v[1]), pk2(v[2], v[3])}; }
    }
}
__device__ __forceinline__ void tr_item8(const float* W, int N, unsigned char* WT, int Kb, int k0, int n0, int drow0, float scale, LAS float* scr, int lane) {
#pragma unroll 8
    for (int i = 0; i < 32; ++i) { const int kk = 2 * i + (lane >> 5); scr[kk * 33 + (lane & 31)] = W[(size_t)(k0 + kk) * N + n0 + (lane & 31)]; }
    LDS_WAIT(); asm volatile("" ::: "memory");
    const int c = lane & 7;
#pragma unroll
    for (int j = 0; j < 4; ++j) { const int n = (lane >> 3) + 8 * j; const LAS float* sp = scr + (8 * c) * 33 + n; float v[8];
#pragma unroll
        for (int q = 0; q < 8; ++q) v[q] = sp[q * 33] * scale;
        *(GAS v2u*)(WT + (size_t)(drow0 + n) * Kb + k0 + 8 * c) = pack8_fp8(v); }
    LDS_WAIT(); asm volatile("" ::: "memory");
}
struct ConvItem { const float* W; unsigned char* WT; int N, Kb, k0, n0, drow0; float scale; };
__device__ __forceinline__ bool conv_e_item(ArgsRef a, int l, int it, ConvItem& c) {
    if (it >= NE * 3 * 1408) return false;
    const int e = it / (3 * 1408), r0 = it % (3 * 1408), which = r0 / 1408, r = r0 % 1408;
    if (which < 2) { const int kb = r / 44, nb = r % 44, n0 = nb * 32;
        c.W = a.in[which == 0 ? I_WG : I_WU] + (size_t)(l * NE + e) * D * DE; c.N = DE; c.WT = a.ws + WS_EGU + (size_t)e * 2816 * D; c.Kb = D; c.k0 = kb * 64; c.n0 = n0; c.drow0 = (n0 >> 7) * 256 + (n0 & 127) + which * 128; c.scale = WSC_GU; }
    else { const int kb = r / 64, nb = r % 64;
        c.W = a.in[I_WD] + (size_t)(l * NE + e) * DE * D; c.N = D; c.WT = a.ws + WS_ED + (size_t)e * D * DEP; c.Kb = DEP; c.k0 = kb * 64; c.n0 = nb * 32; c.drow0 = nb * 32; c.scale = WSC_D; }
    return true;
}
__device__ __forceinline__ void conv_e(ArgsRef a, Ctx C, int l, int w0, int nw) {
    LAS float* scr = (LAS float*)(C.lds + C.wave * 8448);
    const int lane = C.lane, total = NE * 3 * 1408 + NE * 32;
    float cur[32], nxt[32]; ConvItem ci, cn; bool hc = false, hn = false;
    int it = w0;
    if (it < total) { hn = conv_e_item(a, l, it, cn);
        if (hn) {
#pragma unroll
            for (int i = 0; i < 32; ++i) nxt[i] = cn.W[(size_t)(cn.k0 + 2 * i + (lane >> 5)) * cn.N + cn.n0 + (lane & 31)]; } }
    for (; it < total; it += nw) {
        ci = cn; hc = hn;
#pragma unroll
        for (int i = 0; i < 32; ++i) cur[i] = nxt[i];
        const int itn = it + nw; hn = false;
        if (itn < total) { hn = conv_e_item(a, l, itn, cn);
            if (hn) {
#pragma unroll
                for (int i = 0; i < 32; ++i) nxt[i] = cn.W[(size_t)(cn.k0 + 2 * i + (lane >> 5)) * cn.N + cn.n0 + (lane & 31)]; } }
        if (!hc) {
            const int z = it - NE * 3 * 1408; unsigned char* row = a.ws + WS_ED + ((size_t)z * 64 + lane) * DEP + DE;
#pragma unroll
            for (int q = 0; q < 8; ++q) *(v4u*)(row + q * 16) = (v4u){0u, 0u, 0u, 0u};
            continue; }
#pragma unroll
        for (int i = 0; i < 32; ++i) scr[(2 * i + (lane >> 5)) * 33 + (lane & 31)] = cur[i];
        LDS_WAIT(); asm volatile("" ::: "memory");
        const int c = lane & 7;
#pragma unroll
        for (int jq = 0; jq < 4; ++jq) { const int n = (lane >> 3) + 8 * jq; const LAS float* sp = scr + (8 * c) * 33 + n; float v[8];
#pragma unroll
            for (int q = 0; q < 8; ++q) v[q] = sp[q * 33] * ci.scale;
            *(GAS v2u*)(ci.WT + (size_t)(ci.drow0 + n) * ci.Kb + ci.k0 + 8 * c) = pack8_fp8(v); }
        LDS_WAIT(); asm volatile("" ::: "memory");
    }
}
__device__ __forceinline__ void ph_ln1(ArgsRef a, Ctx C, int l) {
    const float* res_lat = l == 0 ? a.in[I_X] : a.out; const float* res_ctx = l == 0 ? a.in[I_CTX] : (const float*)(a.ws + WS_XSCTX);
    const float* mod = (const float*)(a.ws + WS_MOD) + (size_t)l * 5 * NADA; bf16* h = (bf16*)(a.ws + WS_H);
    ROWLOOP { const int b = r / LT, j = r - b * LT; const bool isctx = j < LC;
        const float* src = isctx ? res_ctx + ((size_t)b * LC + j) * D : res_lat + ((size_t)b * LL + (j - LC)) * D;
        const float* sh = mod + (size_t)(isctx ? 4 : b) * NADA; const float* sc = sh + D;
        f32x4 v[8]; float s = 0.f;
#pragma unroll
        for (int jj = 0; jj < 8; ++jj) { v[jj] = ((const f32x4*)src)[C.lane + 64 * jj]; s += (v[jj].x + v[jj].y) + (v[jj].z + v[jj].w); }
        const float mean = wave_sum(s) * (1.f / D); float s2 = 0.f;
#pragma unroll
        for (int jj = 0; jj < 8; ++jj) { v[jj] = v[jj] - mean; s2 += (v[jj].x * v[jj].x + v[jj].y * v[jj].y) + (v[jj].z * v[jj].z + v[jj].w * v[jj].w); }
        const float rstd = 1.f / sqrtf(wave_sum(s2) * (1.f / D) + LN_EPS);
        unsigned long long* o8 = (unsigned long long*)(h + (size_t)r * D);
#pragma unroll
        for (int jj = 0; jj < 8; ++jj) { const int q = C.lane + 64 * jj; const f32x4 scv = ((const f32x4*)sc)[q], shv = ((const f32x4*)sh)[q];
            const f32x4 o = v[jj] * rstd * (scv + 1.f) + shv;
            o8[q] = (unsigned long long)pk2(o.x, o.y) | ((unsigned long long)pk2(o.z, o.w) << 32); }
    }
}
__device__ __forceinline__ void ph_prep(ArgsRef a, Ctx C, int l) {
    LAS float* cosT = (LAS float*)C.lds; LAS float* sinT = cosT + 1024;
    for (int e = C.tid; e < 1024; e += NTHR) { const int pos = e >> 4, fi = e & 15; const float freq = exp2f(-(float)fi * (13.287712379549449f / 16.f));
        float rev = (float)pos * freq * 0.15915494309189535f; rev -= floorf(rev); cosT[e] = __builtin_amdgcn_cosf(rev); sinT[e] = __builtin_amdgcn_sinf(rev); }
    __syncthreads();
    const bf16* p = (const bf16*)(a.ws + WS_P); bf16* xc = (bf16*)(a.ws + T_XC); bf16* xbc = (bf16*)(a.ws + T_XBC); float* dtb = (float*)(a.ws + T_DT);
    bf16* Qr = (bf16*)(a.ws + T_QR); bf16* Kr = (bf16*)(a.ws + T_KR);
    const float* lcw = a.in[I_LCW] + (size_t)l * 4 * 1024; const float* lcb = a.in[I_LCB] + (size_t)l * 1024;
    const float* scw = a.in[I_SCW] + (size_t)l * 4 * 2048; const float* scb = a.in[I_SCB] + (size_t)l * 2048; const float* dtbias = a.in[I_SDTB] + l * 32;
    for (int item = C.vcu * NWAVES + C.wave; item < M / 2; item += C.G * NWAVES) {
        const int r0 = item * 2, b = r0 / LT, j0 = r0 - b * LT; const bool isctx = j0 < LC; const int seg_lo = isctx ? 0 : LC, seg_hi = isctx ? LC : LT;
        const bf16* prow0 = p + (size_t)r0 * NP;
        const int hh = C.lane >> 3, mm = (C.lane >> 2) & 1, ax = (C.lane >> 1) & 1, ih = C.lane & 1, base = hh * 128 + mm * 64 + ax * 32 + ih * 8;
        v4u rq[2][4]; unsigned short dtraw[2];
#pragma unroll
        for (int rr = 0; rr < 2; ++rr) { const bf16* prow = prow0 + (size_t)rr * NP;
            rq[rr][0] = *(const v4u*)(prow + P_Q + base); rq[rr][1] = *(const v4u*)(prow + P_Q + base + 16); rq[rr][2] = *(const v4u*)(prow + P_K + base); rq[rr][3] = *(const v4u*)(prow + P_K + base + 16);
            dtraw[rr] = prow[P_DT + (C.lane & 31)]; }
#pragma unroll 1
        for (int hb = 0; hb < 2; ++hb) {
            v4u xr[3][5];
#pragma unroll
            for (int u = 0; u < 3; ++u) { const int it = hb * 3 + u; const bool lru = it < 2; const int c = (lru ? it : it - 2) * 512 + C.lane * 8; const int pofs = (lru ? P_LRUX : P_XBC) + c;
#pragma unroll
                for (int k = 0; k < 5; ++k) { const int jj = j0 - 2 + k; xr[u][k] = (jj >= seg_lo && jj < seg_hi) ? *(const v4u*)(prow0 + (ptrdiff_t)(k - 2) * NP + pofs) : (v4u){0u, 0u, 0u, 0u}; } }
#pragma unroll
            for (int u = 0; u < 3; ++u) { const int it = hb * 3 + u; const bool lru = it < 2; const int c = (lru ? it : it - 2) * 512 + C.lane * 8;
                const float* wq = lru ? lcw + c : scw + c; const int wstride = lru ? 1024 : 2048; const float* bq = lru ? lcb + c : scb + c;
                float xin[5][8];
#pragma unroll
                for (int k = 0; k < 5; ++k) unpack8(xr[u][k], xin[k]);
                float w[4][8], bias[8];
#pragma unroll
                for (int tap = 0; tap < 4; ++tap) { const f32x4 w0 = *(const f32x4*)(wq + tap * wstride), w1 = *(const f32x4*)(wq + tap * wstride + 4);
                    w[tap][0] = w0.x; w[tap][1] = w0.y; w[tap][2] = w0.z; w[tap][3] = w0.w; w[tap][4] = w1.x; w[tap][5] = w1.y; w[tap][6] = w1.z; w[tap][7] = w1.w; }
                { const f32x4 b0 = *(const f32x4*)bq, b1 = *(const f32x4*)(bq + 4); bias[0] = b0.x; bias[1] = b0.y; bias[2] = b0.z; bias[3] = b0.w; bias[4] = b1.x; bias[5] = b1.y; bias[6] = b1.z; bias[7] = b1.w; }
#pragma unroll
                for (int rr = 0; rr < 2; ++rr) { float acc[8];
#pragma unroll
                    for (int q = 0; q < 8; ++q) { float v = bias[q];
#pragma unroll
                        for (int tap = 0; tap < 4; ++tap) v += w[tap][q] * xin[rr + tap][q];
                        acc[q] = lru ? v : siluf_(v); }
                    if (lru) *(v4u*)(xc + (size_t)(r0 + rr) * 1024 + c) = pack8(acc); else *(v4u*)(xbc + (size_t)(r0 + rr) * 2048 + c) = pack8(acc); } }
        }
#pragma unroll
        for (int rr = 0; rr < 2; ++rr) { const int r = r0 + rr, j = j0 + rr;
            if (C.lane < 32) { const float v = __builtin_bit_cast(float, (unsigned)dtraw[rr] << 16) + dtbias[C.lane]; dtb[(size_t)r * 32 + C.lane] = softplusf_(v); }
            float cs[8], sn[8];
            if (!isctx) { const int t = j - LC, pos = ax == 0 ? (t >> 6) : (t & 63);
#pragma unroll
                for (int q = 0; q < 8; ++q) { cs[q] = cosT[pos * 16 + ih * 8 + q]; sn[q] = sinT[pos * 16 + ih * 8 + q]; } }
            else {
#pragma unroll
                for (int q = 0; q < 8; ++q) { cs[q] = 1.f; sn[q] = 0.f; } }
#pragma unroll
            for (int w = 0; w < 2; ++w) { const float scl = w == 0 ? QSCALE : 1.f; bf16* dst = (w == 0 ? Qr : Kr) + (size_t)r * 1024 + base;
                float x1[8], x2[8], o1[8], o2[8]; unpack8(rq[rr][2 * w], x1); unpack8(rq[rr][2 * w + 1], x2);
#pragma unroll
                for (int q = 0; q < 8; ++q) { o1[q] = (x1[q] * cs[q] - x2[q] * sn[q]) * scl; o2[q] = (x1[q] * sn[q] + x2[q] * cs[q]) * scl; }
                *(v4u*)dst = pack8(o1); *(v4u*)(dst + 16) = pack8(o2); } }
    }
    __syncthreads();
}
__device__ __forceinline__ void ph_lru_s1(ArgsRef a, Ctx C) {
    const bf16* la = (const bf16*)(a.ws + T_LA); const bf16* bb = (const bf16*)(a.ws + T_BB); float* aggA = (float*)(a.ws + T_AGGA); float* aggB = (float*)(a.ws + T_AGGB);
    for (int i = C.vcu * NTHR + C.tid; i < 2 * NB * NCH * 512; i += C.G * NTHR) {
        const int c2 = i & 511, qq = i >> 9, q = qq % NCH, b = (qq / NCH) & 3, d = qq / (NCH * 4); const int row0 = b * LT + q * 32;
        const unsigned* lap = (const unsigned*)(la + ((size_t)d * M + row0) * 1024) + c2; const unsigned* bbp = (const unsigned*)(bb + ((size_t)d * M + row0) * 1024) + c2;
        float A0 = 1.f, A1 = 1.f, B0 = 0.f, B1 = 0.f;
#pragma unroll 8
        for (int tt = 0; tt < 32; ++tt) { const int t = d == 0 ? tt : 31 - tt; const unsigned wl = lap[t * 512], wb = bbp[t * 512];
            const float a0 = __builtin_amdgcn_exp2f(bflo(wl)), a1 = __builtin_amdgcn_exp2f(bfhi(wl));
            A0 *= a0; A1 *= a1; B0 = a0 * B0 + bflo(wb); B1 = a1 * B1 + bfhi(wb); }
        const size_t idx = ((size_t)(d * NB + b) * NCH + q) * 1024 + 2 * c2;
        *(f32x2*)(aggA + idx) = (f32x2){A0, A1}; *(f32x2*)(aggB + idx) = (f32x2){B0, B1}; }
}
__device__ __forceinline__ void lru_s2_item(ArgsRef a, int it, int lane) {
    const float* aggA = (const float*)(a.ws + T_AGGA); const float* aggB = (const float*)(a.ws + T_AGGB); float* cin = (float*)(a.ws + T_CIN);
    const int cg = it & 15, b = (it >> 4) & 3, d = it >> 6, c = cg * 64 + lane;
    const size_t base = ((size_t)(d * NB + b) * NCH) * 1024 + c; float carry = 0.f;
#pragma unroll 8
    for (int s = 0; s < NCH; ++s) { const int q = d == 0 ? s : (s < 8 ? 7 - s : NCH + 7 - s);
        const float A = aggA[base + (size_t)q * 1024], Bv = aggB[base + (size_t)q * 1024]; cin[base + (size_t)q * 1024] = carry; carry = A * carry + Bv; }
}
__device__ __forceinline__ void ph_lru_s3(ArgsRef a, Ctx C, int l) {
    const bf16* la = (const bf16*)(a.ws + T_LA); const bf16* bb = (const bf16*)(a.ws + T_BB); const float* cin = (const float*)(a.ws + T_CIN);
    const bf16* p = (const bf16*)(a.ws + WS_P); bf16* out = (bf16*)(a.ws + WS_BR);
    LAS v2u* hfl = (LAS v2u*)C.lds + C.tid;
    const int nchq = (l == DEPTH - 1) ? 128 : NCH, nitems = NB * nchq * 256;
    for (int i = C.vcu * NTHR + C.tid; i < nitems; i += C.G * NTHR) {
        const int c4 = i & 255, qq = i >> 8, q = (l == DEPTH - 1) ? 8 + (qq & 127) : qq % NCH, b = (l == DEPTH - 1) ? (qq >> 7) : qq / NCH; const int row0 = b * LT + q * 32;
        const v2u* la0 = (const v2u*)(la + (size_t)row0 * 1024) + c4; const v2u* bb0 = (const v2u*)(bb + (size_t)row0 * 1024) + c4;
        const v2u* la1 = la0 + (size_t)M * 256; const v2u* bb1 = bb0 + (size_t)M * 256;
        const v2u* gp = (const v2u*)(p + (size_t)row0 * NP + P_LRUG) + c4; v2u* op = (v2u*)(out + (size_t)row0 * 1024) + c4;
        const f32x4 ci0 = *(const f32x4*)(cin + ((size_t)(0 * NB + b) * NCH + q) * 1024 + 4 * c4), ci1 = *(const f32x4*)(cin + ((size_t)(1 * NB + b) * NCH + q) * 1024 + 4 * c4);
        f32x4 h = ci0;
#pragma unroll
        for (int g = 0; g < 4; ++g) {
            v2u wl[8], wb[8];
#pragma unroll
            for (int u = 0; u < 8; ++u) { wl[u] = la0[(g * 8 + u) * 256]; wb[u] = bb0[(g * 8 + u) * 256]; }
#pragma unroll
            for (int u = 0; u < 8; ++u) { const int t = g * 8 + u;
                h.x = __builtin_amdgcn_exp2f(bflo(wl[u].x)) * h.x + bflo(wb[u].x); h.y = __builtin_amdgcn_exp2f(bfhi(wl[u].x)) * h.y + bfhi(wb[u].x);
                h.z = __builtin_amdgcn_exp2f(bflo(wl[u].y)) * h.z + bflo(wb[u].y); h.w = __builtin_amdgcn_exp2f(bfhi(wl[u].y)) * h.w + bfhi(wb[u].y);
                hfl[t * 512] = (v2u){pk2(h.x, h.y), pk2(h.z, h.w)}; }
            asm volatile("" ::: "memory"); }
        h = ci1;
#pragma unroll
        for (int g = 0; g < 4; ++g) {
            v2u wl[8], wb[8], gw[8];
#pragma unroll
            for (int u = 0; u < 8; ++u) { const int t = 31 - (g * 8 + u); wl[u] = la1[t * 256]; wb[u] = bb1[t * 256]; gw[u] = gp[(size_t)t * (NP / 4)]; }
#pragma unroll
            for (int u = 0; u < 8; ++u) { const int t = 31 - (g * 8 + u);
                h.x = __builtin_amdgcn_exp2f(bflo(wl[u].x)) * h.x + bflo(wb[u].x); h.y = __builtin_amdgcn_exp2f(bfhi(wl[u].x)) * h.y + bfhi(wb[u].x);
                h.z = __builtin_amdgcn_exp2f(bflo(wl[u].y)) * h.z + bflo(wb[u].y); h.w = __builtin_amdgcn_exp2f(bfhi(wl[u].y)) * h.w + bfhi(wb[u].y);
                const v2u hf = hfl[t * 512];
                op[t * 256] = (v2u){pk2((bflo(hf.x) + h.x) * gelu_tanh(bflo(gw[u].x)), (bfhi(hf.x) + h.y) * gelu_tanh(bfhi(gw[u].x))), pk2((bflo(hf.y) + h.z) * gelu_tanh(bflo(gw[u].y)), (bfhi(hf.y) + h.w) * gelu_tanh(bfhi(gw[u].y)))}; }
            asm volatile("" ::: "memory"); }
    }
    __syncthreads();
}
__device__ __forceinline__ void ph_ssd_scan(ArgsRef a, Ctx C, int l) {
    LAS float* Xs = (LAS float*)C.lds; LAS float* Bs = Xs + 64 * 64; LAS float* Cs = Bs + 64 * 128; LAS float* Ys = Cs + 64 * 128; LAS float* dts = Ys + 64 * 64;
    const bf16* xbc = (const bf16*)(a.ws + T_XBC); const float* dtb = (const float*)(a.ws + T_DT); bf16* ssdy = (bf16*)(a.ws + T_SSDY);
    const int p_ = C.tid >> 3, ng = C.tid & 7, n0 = ng * 16;
    for (int it = C.vcu; it < 128; it += C.G) { const int h = it & 15, d = (it >> 4) & 1, b = it >> 5, g = h >> 2;
        const float Aneg = -__expf(a.in[I_SALOG][(l * 2 + d) * 16 + h]);
        float S[16];
#pragma unroll
        for (int n = 0; n < 16; ++n) S[n] = 0.f;
        for (int ci = 0; ci < 68; ++ci) { const int q = d == 0 ? ci : (ci < 4 ? 3 - ci : 71 - ci); const int row0 = b * LT + q * 64;
            { const int rr = C.tid >> 3, cc = (C.tid & 7) * 8; float x8[8]; unpack8(*(const v4u*)(xbc + (size_t)(row0 + rr) * 2048 + h * 64 + cc), x8);
              *(LAS f32x4*)(Xs + rr * 64 + cc) = (f32x4){x8[0], x8[1], x8[2], x8[3]}; *(LAS f32x4*)(Xs + rr * 64 + cc + 4) = (f32x4){x8[4], x8[5], x8[6], x8[7]}; }
#pragma unroll
            for (int rep = 0; rep < 2; ++rep) { const int idx = C.tid + rep * 512, rr = idx >> 4, cc = (idx & 15) * 8; float b8[8], c8[8];
                unpack8(*(const v4u*)(xbc + (size_t)(row0 + rr) * 2048 + 1024 + g * 128 + cc), b8); unpack8(*(const v4u*)(xbc + (size_t)(row0 + rr) * 2048 + 1536 + g * 128 + cc), c8);
                *(LAS f32x4*)(Bs + rr * 128 + cc) = (f32x4){b8[0], b8[1], b8[2], b8[3]}; *(LAS f32x4*)(Bs + rr * 128 + cc + 4) = (f32x4){b8[4], b8[5], b8[6], b8[7]};
                *(LAS f32x4*)(Cs + rr * 128 + cc) = (f32x4){c8[0], c8[1], c8[2], c8[3]}; *(LAS f32x4*)(Cs + rr * 128 + cc + 4) = (f32x4){c8[4], c8[5], c8[6], c8[7]}; }
            if (C.tid < 64) { const float dtv = dtb[(size_t)(row0 + C.tid) * 32 + d * 16 + h]; dts[C.tid] = dtv; dts[64 + C.tid] = __expf(dtv * Aneg); }
            __syncthreads();
            for (int tt = 0; tt < 64; ++tt) { const int t = d == 0 ? tt : 63 - tt; const float dt = dts[t], dec = dts[64 + t], xv = Xs[t * 64 + p_] * dt;
                f32x4 Bv[4], Cv[4];
#pragma unroll
                for (int q4 = 0; q4 < 4; ++q4) { Bv[q4] = *(const LAS f32x4*)(Bs + t * 128 + n0 + 4 * q4); Cv[q4] = *(const LAS f32x4*)(Cs + t * 128 + n0 + 4 * q4); }
                float y = 0.f;
#pragma unroll
                for (int n = 0; n < 16; ++n) { S[n] = dec * S[n] + xv * Bv[n >> 2][n & 3]; y += S[n] * Cv[n >> 2][n & 3]; }
                y += __shfl_xor(y, 1); y += __shfl_xor(y, 2); y += __shfl_xor(y, 4);
                if (ng == 0) Ys[t * 64 + p_] = y; }
            __syncthreads();
            { const int rr = C.tid >> 3, cc = (C.tid & 7) * 8; float y8[8]; const f32x4 y0 = *(const LAS f32x4*)(Ys + rr * 64 + cc), y1 = *(const LAS f32x4*)(Ys + rr * 64 + cc + 4);
              y8[0] = y0.x; y8[1] = y0.y; y8[2] = y0.z; y8[3] = y0.w; y8[4] = y1.x; y8[5] = y1.y; y8[6] = y1.z; y8[7] = y1.w;
              *(v4u*)(ssdy + ((size_t)d * M + row0 + rr) * 1024 + h * 64 + cc) = pack8(y8); }
        }
        __syncthreads();
    }
}
__device__ __forceinline__ void ph_attn_naive(ArgsRef a, Ctx C) {
    LAS float* Ks = (LAS float*)C.lds; LAS float* Vs = Ks + 64 * 64;
    const bf16* Qr = (const bf16*)(a.ws + T_QR); const bf16* Kr = (const bf16*)(a.ws + T_KR); const bf16* p = (const bf16*)(a.ws + WS_P); bf16* otmp = (bf16*)(a.ws + T_OTMP);
    const int qi = C.tid >> 2, part = C.tid & 3;
    for (int u = C.vcu; u < 2048 + 128; u += C.G) {
        int qb, hm, b; bool isctx;
        if (u < 2048) { qb = u & 31; hm = (u >> 5) & 15; b = u >> 9; isctx = false; } else { const int u2 = u - 2048; qb = u2 & 1; hm = (u2 >> 1) & 15; b = u2 >> 5; isctx = true; }
        const int qrow = b * LT + (isctx ? 0 : LC) + qb * 128 + qi, kv0 = b * LT, nkt = isctx ? 4 : 68, hh = hm >> 1, qcol = hh * 128 + (hm & 1) * 64;
        float q[16];
        { float t8[8]; unpack8(*(const v4u*)(Qr + (size_t)qrow * 1024 + qcol + part * 16), t8);
#pragma unroll
          for (int j = 0; j < 8; ++j) q[j] = t8[j];
          unpack8(*(const v4u*)(Qr + (size_t)qrow * 1024 + qcol + part * 16 + 8), t8);
#pragma unroll
          for (int j = 0; j < 8; ++j) q[8 + j] = t8[j]; }
        float o[32], mrun = -1e30f, lsum = 0.f;
#pragma unroll
        for (int j = 0; j < 32; ++j) o[j] = 0.f;
        for (int kt = 0; kt < nkt; ++kt) {
            __syncthreads();
            { const int rr = C.tid >> 3, cc = (C.tid & 7) * 8; float k8[8]; unpack8(*(const v4u*)(Kr + (size_t)(kv0 + kt * 64 + rr) * 1024 + qcol + cc), k8);
              *(LAS f32x4*)(Ks + rr * 64 + cc) = (f32x4){k8[0], k8[1], k8[2], k8[3]}; *(LAS f32x4*)(Ks + rr * 64 + cc + 4) = (f32x4){k8[4], k8[5], k8[6], k8[7]}; }
#pragma unroll
            for (int rep = 0; rep < 2; ++rep) { const int idx = C.tid + rep * 512, rr = idx >> 4, cc = (idx & 15) * 8; float v8[8];
                unpack8(*(const v4u*)(p + (size_t)(kv0 + kt * 64 + rr) * NP + P_V + hh * 128 + cc), v8);
                *(LAS f32x4*)(Vs + rr * 128 + cc) = (f32x4){v8[0], v8[1], v8[2], v8[3]}; *(LAS f32x4*)(Vs + rr * 128 + cc + 4) = (f32x4){v8[4], v8[5], v8[6], v8[7]}; }
            __syncthreads();
#pragma unroll 1
            for (int g8 = 0; g8 < 8; ++g8) {
                float s[8];
#pragma unroll
                for (int j = 0; j < 8; ++j) { const LAS float* kp = Ks + (g8 * 8 + j) * 64 + part * 16; float acc = 0.f;
#pragma unroll
                    for (int q4 = 0; q4 < 4; ++q4) { const f32x4 kv = *(const LAS f32x4*)(kp + 4 * q4); acc += q[4 * q4] * kv.x + q[4 * q4 + 1] * kv.y + q[4 * q4 + 2] * kv.z + q[4 * q4 + 3] * kv.w; }
                    acc += __shfl_xor(acc, 1); acc += __shfl_xor(acc, 2); s[j] = acc; }
                float mx = s[0];
#pragma unroll
                for (int j = 1; j < 8; ++j) mx = fmaxf(mx, s[j]);
                const float mnew = fmaxf(mrun, mx), alpha = __builtin_amdgcn_exp2f(mrun - mnew); mrun = mnew; lsum *= alpha;
#pragma unroll
                for (int j = 0; j < 32; ++j) o[j] *= alpha;
#pragma unroll
                for (int j = 0; j < 8; ++j) { const float pj = __builtin_amdgcn_exp2f(s[j] - mnew); lsum += pj; const LAS float* vp = Vs + (g8 * 8 + j) * 128 + part * 32;
#pragma unroll
                    for (int q4 = 0; q4 < 8; ++q4) { const f32x4 vv = *(const LAS f32x4*)(vp + 4 * q4); o[4 * q4] += pj * vv.x; o[4 * q4 + 1] += pj * vv.y; o[4 * q4 + 2] += pj * vv.z; o[4 * q4 + 3] += pj * vv.w; } }
            }
        }
        const float inv = 1.f / lsum; bf16* op = otmp + (size_t)qrow * 2048 + hm * 128 + part * 32;
#pragma unroll
        for (int q8 = 0; q8 < 4; ++q8) { float t8[8];
#pragma unroll
            for (int j = 0; j < 8; ++j) t8[j] = o[q8 * 8 + j] * inv;
            *(v4u*)(op + q8 * 8) = pack8(t8); }
    }
    __syncthreads();
}
namespace att {
using f32x16 = __attribute__((ext_vector_type(16))) float;
using s16x4 = __attribute__((ext_vector_type(4))) short;
constexpr int SHM_V = 64 * 128 * 2, SHM_K = 64 * 64 * 2;
constexpr float THR2 = 11.5f;
#define KSWZ64(row, colB) ((row) * 128 + ((colB) ^ ((((row) >> 1) & 7) << 4)))
#define SBAR() __builtin_amdgcn_sched_barrier(0)
__device__ __forceinline__ int crow(int r, int hi) { return (r & 3) + 8 * (r >> 2) + 4 * hi; }
__device__ __forceinline__ unsigned cvtpk(float lo, float hi) { unsigned r; asm volatile("v_cvt_pk_bf16_f32 %0, %1, %2" : "=v"(r) : "v"(lo), "v"(hi)); return r; }
__device__ __forceinline__ void partialSM(f32x16& p0, f32x16& p1, float& m_reg, float& mn, float& alpha) {
    float pmax = p0[0];
#pragma unroll
    for (int r = 1; r < 16; ++r) pmax = fmaxf(pmax, p0[r]);
#pragma unroll
    for (int r = 0; r < 16; ++r) pmax = fmaxf(pmax, p1[r]);
    { auto rr = __builtin_amdgcn_permlane32_swap(__float_as_uint(pmax), __float_as_uint(pmax), false, false); pmax = fmaxf(__uint_as_float(rr[0]), __uint_as_float(rr[1])); }
    if (__builtin_expect(__all(pmax - m_reg <= THR2), 1)) { mn = m_reg; alpha = 1.f; }
    else { mn = fmaxf(m_reg, pmax); alpha = __builtin_amdgcn_exp2f(m_reg - mn); m_reg = mn; }
#pragma unroll
    for (int r = 0; r < 16; ++r) { p0[r] = p0[r] - mn; p1[r] = p1[r] - mn; }
#pragma unroll
    for (int r = 0; r < 16; ++r) p0[r] = __builtin_amdgcn_exp2f(p0[r]);
}
__device__ __forceinline__ void finishSM(f32x16& p0, f32x16& p1, float alpha, float& l_reg, bf16x8& pa0, bf16x8& pa1, bf16x8& pa2, bf16x8& pa3) {
#pragma unroll
    for (int r = 0; r < 16; ++r) p1[r] = __builtin_amdgcn_exp2f(p1[r]);
    float ps = 0.f;
#pragma unroll
    for (int r = 0; r < 16; ++r) ps += p0[r];
#pragma unroll
    for (int r = 0; r < 16; ++r) ps += p1[r];
    { auto rr = __builtin_amdgcn_permlane32_swap(__float_as_uint(ps), __float_as_uint(ps), false, false); ps = __uint_as_float(rr[0]) + __uint_as_float(rr[1]); }
    l_reg = l_reg * alpha + ps;
#define PK4(P, BASE, OUT) do { unsigned a0 = cvtpk(P[BASE + 0], P[BASE + 1]), a1 = cvtpk(P[BASE + 2], P[BASE + 3]); \
    unsigned b0 = cvtpk(P[BASE + 4], P[BASE + 5]), b1 = cvtpk(P[BASE + 6], P[BASE + 7]); \
    auto r0 = __builtin_amdgcn_permlane32_swap(a0, b0, false, false); auto r1 = __builtin_amdgcn_permlane32_swap(a1, b1, false, false); \
    v4u w = {r0[0], r1[0], r0[1], r1[1]}; OUT = __builtin_bit_cast(bf16x8, w); } while (0)
    PK4(p0, 0, pa0); PK4(p0, 8, pa1); PK4(p1, 0, pa2); PK4(p1, 8, pa3);
#undef PK4
}
__device__ __forceinline__ void qkt(f32x16& p0, f32x16& p1, const LAS char* Ks, const bf16x8* qr, int r32, int hi) {
    p0 = f32x16{}; p1 = f32x16{};
#pragma unroll
    for (int d0 = 0; d0 < 4; ++d0) { const int cb = (d0 * 16 + hi * 8) * 2;
        const bf16x8 b0 = *(const LAS bf16x8*)(Ks + KSWZ64(r32, cb));
        const bf16x8 b1 = *(const LAS bf16x8*)(Ks + KSWZ64(32 + r32, cb));
        p0 = __builtin_amdgcn_mfma_f32_32x32x16_bf16(b0, qr[d0], p0, 0, 0, 0);
        p1 = __builtin_amdgcn_mfma_f32_32x32x16_bf16(b1, qr[d0], p1, 0, 0, 0); }
}
__device__ __forceinline__ int v_st(int k, int c) { const int kk = (k & ~0xC) | ((k & 4) << 1) | ((k & 8) >> 1); return ((kk >> 3) * 4 + (c >> 5)) * 512 + ((kk & 7) * 32 + (c & 31)) * 2; }
__device__ __forceinline__ int v_rd_base(int lane) { return ((lane & 3) << 3) | (((lane >> 2) & 3) << 6) | (((lane >> 4) & 1) << 5) | (((lane >> 5) & 1) << 8); }
constexpr int v_rd_off(int d0, int ks, int half) { return d0 * 512 + ks * 4096 + half * 2048; }
template <int OFF> __device__ __forceinline__ s16x4 tr_read(int vb) { s16x4 r; asm volatile("ds_read_b64_tr_b16 %0, %1 offset:%2" : "=&v"(r) : "v"(vb), "i"(OFF) : "memory"); return r; }
template <int D0> __device__ __forceinline__ void pv_one(f32x16& od, int vb, bf16x8 pa0, bf16x8 pa1, bf16x8 pa2, bf16x8 pa3) {
    const s16x4 l0 = tr_read<v_rd_off(D0, 0, 0)>(vb), h0 = tr_read<v_rd_off(D0, 0, 1)>(vb), l1 = tr_read<v_rd_off(D0, 1, 0)>(vb), h1 = tr_read<v_rd_off(D0, 1, 1)>(vb);
    const s16x4 l2 = tr_read<v_rd_off(D0, 2, 0)>(vb), h2 = tr_read<v_rd_off(D0, 2, 1)>(vb), l3 = tr_read<v_rd_off(D0, 3, 0)>(vb), h3 = tr_read<v_rd_off(D0, 3, 1)>(vb);
    asm volatile("s_waitcnt lgkmcnt(0)" ::: "memory"); SBAR();
#define PK(L, H) (bf16x8){L[0], L[1], L[2], L[3], H[0], H[1], H[2], H[3]}
    od = __builtin_amdgcn_mfma_f32_32x32x16_bf16(pa0, PK(l0, h0), od, 0, 0, 0);
    od = __builtin_amdgcn_mfma_f32_32x32x16_bf16(pa1, PK(l1, h1), od, 0, 0, 0);
    od = __builtin_amdgcn_mfma_f32_32x32x16_bf16(pa2, PK(l2, h2), od, 0, 0, 0);
    od = __builtin_amdgcn_mfma_f32_32x32x16_bf16(pa3, PK(l3, h3), od, 0, 0, 0);
#undef PK
}
__device__ __forceinline__ void pv_d0(f32x16* o, int vb, bf16x8 pa0, bf16x8 pa1, bf16x8 pa2, bf16x8 pa3) {
    pv_one<0>(o[0], vb, pa0, pa1, pa2, pa3); pv_one<1>(o[1], vb, pa0, pa1, pa2, pa3); pv_one<2>(o[2], vb, pa0, pa1, pa2, pa3); pv_one<3>(o[3], vb, pa0, pa1, pa2, pa3);
}
__device__ __forceinline__ void attn_unit(const bf16* __restrict__ Qb, const bf16* __restrict__ Kh, const bf16* __restrict__ Vh, bf16* __restrict__ Ob, int seq, LAS char* lds, int tid) {
    const int wid = __builtin_amdgcn_readfirstlane(tid >> 6), lane = tid & 63, r32 = lane & 31, hi = lane >> 5;
    LAS char* V_lds = lds; LAS char* K_lds = lds + 2 * SHM_V;
    LAS float* wsf = (LAS float*)(lds + 2 * SHM_V + 2 * SHM_K) + wid * 64; LAS float* li_l = wsf; LAS float* al_l = wsf + 32;
    float m_reg = -1e30f, l_reg = 0.f; f32x16 o[4] = {}; bf16x8 qr[4];
    const bf16* Qw = Qb + (size_t)(wid * 32 + r32) * 1024 + hi * 8;
#pragma unroll
    for (int d0 = 0; d0 < 4; ++d0) qr[d0] = *(const bf16x8*)(Qw + d0 * 16);
    const int sr = tid >> 4, sc = (tid & 15) * 8, vst0 = v_st(sr, sc), vst1 = v_st(32 + sr, sc);
    const int kr = tid >> 3, kc = (tid & 7) * 8, kst = KSWZ64(kr, kc * 2);
    const int vb0 = (int)(unsigned)(size_t)V_lds + v_rd_base(lane);
    struct { bf16x8 vs0, vs1, ks0; } sr_[2];
#define SLOAD(i, k0) do { sr_[i].vs0 = *(const bf16x8*)(Vh + (size_t)((k0) + sr) * NP + sc); sr_[i].vs1 = *(const bf16x8*)(Vh + (size_t)((k0) + 32 + sr) * NP + sc); \
    sr_[i].ks0 = *(const bf16x8*)(Kh + (size_t)((k0) + kr) * 1024 + kc); } while (0)
#define SWRITE(b, i) do { *(LAS bf16x8*)(V_lds + (b) * SHM_V + vst0) = sr_[i].vs0; *(LAS bf16x8*)(V_lds + (b) * SHM_V + vst1) = sr_[i].vs1; \
    *(LAS bf16x8*)(K_lds + (b) * SHM_K + kst) = sr_[i].ks0; } while (0)
#define SWAIT() asm volatile("s_waitcnt vmcnt(3)" ::: "memory")
#define RESC(a) do { if (__any((a) < 1.f)) { if (hi == 0) al_l[r32] = (a); asm volatile("s_waitcnt lgkmcnt(0)" ::: "memory"); \
    _Pragma("unroll") for (int d = 0; d < 4; ++d) _Pragma("unroll") for (int r = 0; r < 16; ++r) o[d][r] *= al_l[crow(r, hi)]; } } while (0)
    f32x16 pA0, pA1, pB0, pB1; float mnA, mnB, alA, alB; bf16x8 pa0, pa1, pa2, pa3; const int NT = seq / 64;
    constexpr int SE = 0, SO = 1;
    SLOAD(SE, 0); asm volatile("s_waitcnt vmcnt(0)" ::: "memory"); SWRITE(0, SE); __syncthreads();
    qkt(pA0, pA1, K_lds, qr, r32, hi); partialSM(pA0, pA1, m_reg, mnA, alA);
    SLOAD(SO, 64); if (2 < NT) SLOAD(SE, 2 * 64);
    SWAIT(); SWRITE(1, SO); __syncthreads();
    for (int j = 1; j + 1 < NT; j += 2) {
        SBAR(); qkt(pB0, pB1, K_lds + SHM_K, qr, r32, hi);
        finishSM(pA0, pA1, alA, l_reg, pa0, pa1, pa2, pa3); SBAR();
        SLOAD(SO, (j + 2) * 64); SBAR();
        pv_d0(o, vb0, pa0, pa1, pa2, pa3); partialSM(pB0, pB1, m_reg, mnB, alB);
        __syncthreads(); SWAIT(); SWRITE(0, SE);
        RESC(alB); __syncthreads();
        SBAR(); qkt(pA0, pA1, K_lds, qr, r32, hi);
        finishSM(pB0, pB1, alB, l_reg, pa0, pa1, pa2, pa3); SBAR();
        if (j + 3 < NT) SLOAD(SE, (j + 3) * 64); SBAR();
        pv_d0(o, vb0 + SHM_V, pa0, pa1, pa2, pa3); partialSM(pA0, pA1, m_reg, mnA, alA);
        __syncthreads(); SWAIT(); SWRITE(1, SO);
        RESC(alA); __syncthreads();
    }
    SBAR(); qkt(pB0, pB1, K_lds + SHM_K, qr, r32, hi);
    finishSM(pA0, pA1, alA, l_reg, pa0, pa1, pa2, pa3); SBAR();
    pv_d0(o, vb0, pa0, pa1, pa2, pa3); partialSM(pB0, pB1, m_reg, mnB, alB);
    __syncthreads(); RESC(alB);
    finishSM(pB0, pB1, alB, l_reg, pa0, pa1, pa2, pa3); SBAR();
    pv_d0(o, vb0 + SHM_V, pa0, pa1, pa2, pa3);
    if (hi == 0) li_l[r32] = l_reg; asm volatile("s_waitcnt lgkmcnt(0)" ::: "memory");
    float rli[16];
#pragma unroll
    for (int r = 0; r < 16; ++r) rli[r] = __builtin_amdgcn_rcpf(li_l[crow(r, hi)]);
    bf16* Ow = Ob + (size_t)(wid * 32) * 2048;
#pragma unroll
    for (int r = 0; r < 16; ++r) { const int orow = crow(r, hi);
#pragma unroll
        for (int d0 = 0; d0 < 4; ++d0) Ow[(size_t)orow * 2048 + d0 * 32 + r32] = (bf16)f2bf(o[d0][r] * rli[r]); }
    __syncthreads();
#undef SLOAD
#undef SWRITE
#undef SWAIT
#undef RESC
}
}
namespace ssd {
using att::f32x16; using att::s16x4;
constexpr int IMG = 16384;
#define KSWZ128(row, colB) ((row) * 256 + ((colB) ^ (((row) & 7) << 4)))
template <int OFF> __device__ __forceinline__ s16x4 trr(int vb) { s16x4 r; asm volatile("ds_read_b64_tr_b16 %0, %1 offset:%2" : "=&v"(r) : "v"(vb), "i"(OFF) : "memory"); return r; }
#define SSD_PK(L, H) (bf16x8){L[0], L[1], L[2], L[3], H[0], H[1], H[2], H[3]}
__device__ __forceinline__ void ssd_item(const bf16* __restrict__ xbc, const float* __restrict__ dtb, bf16* __restrict__ ssdy, float Aneg2, int b, int d, int h, LAS char* lds, int tid) {
    const int wid = __builtin_amdgcn_readfirstlane(tid >> 6), lane = tid & 63, r32 = lane & 31, hi = lane >> 5, g = h >> 2;
    const bool ywave = wid < 4; const int tb = wid & 1, pb = (wid >> 1) & 1, pb2 = wid & 1, nb = wid >> 1;
    LAS char* Ss = lds + 8 * IMG; LAS float* cumw = (LAS float*)(lds + 9 * IMG) + wid * 128;
    const int ldsb = (int)(unsigned)(size_t)lds;
    const int sa = tid >> 4, cB = (tid & 15) * 8, sx = tid >> 3, cX = (tid & 7) * 8;
    const int kst_a = KSWZ128(sa, cB * 2), kst_b = KSWZ128(32 + sa, cB * 2), vst_a = att::v_st(sa, cB), vst_b = att::v_st(32 + sa, cB), xst_d = att::v_st(sx, cX), xst_s = att::v_st(sx, 64 + cX);
    const int rdb = att::v_rd_base(lane);
    f32x16 sacc = {};
    { LAS v4u* z = (LAS v4u*)(Ss + tid * 32); z[0] = (v4u){0u, 0u, 0u, 0u}; z[1] = (v4u){0u, 0u, 0u, 0u}; }
    bf16x8 nb0, nb1, nc0, nc1, nx; float ndt; float cum2 = 0.f;
#define SSD_ROW0(ci) (b * LT + ((d == 0) ? (ci) : ((ci) < 4 ? 3 - (ci) : 71 - (ci))) * 64)
#define SSD_ROW(r0, s) ((r0) + ((d == 0) ? (s) : 63 - (s)))
#define SSD_LOAD(ci) do { const int r0_ = SSD_ROW0(ci); \
        nb0 = *(const bf16x8*)(xbc + (size_t)SSD_ROW(r0_, sa) * 2048 + 1024 + g * 128 + cB); nb1 = *(const bf16x8*)(xbc + (size_t)SSD_ROW(r0_, 32 + sa) * 2048 + 1024 + g * 128 + cB); \
        nc0 = *(const bf16x8*)(xbc + (size_t)SSD_ROW(r0_, sa) * 2048 + 1536 + g * 128 + cB); nc1 = *(const bf16x8*)(xbc + (size_t)SSD_ROW(r0_, 32 + sa) * 2048 + 1536 + g * 128 + cB); \
        nx = *(const bf16x8*)(xbc + (size_t)SSD_ROW(r0_, sx) * 2048 + h * 64 + cX); ndt = dtb[(size_t)SSD_ROW(r0_, lane) * 32 + d * 16 + h]; } while (0)
#define SSD_DPPADD(v, ctrl, rmask) v += __int_as_float(__builtin_amdgcn_update_dpp(0, __float_as_int(v), ctrl, rmask, 0xF, false))
#define SSD_STAGE(buf, cum2n) do { float a2_ = ndt * Aneg2; \
        SSD_DPPADD(a2_, 0x111, 0xF); SSD_DPPADD(a2_, 0x112, 0xF); SSD_DPPADD(a2_, 0x114, 0xF); SSD_DPPADD(a2_, 0x118, 0xF); SSD_DPPADD(a2_, 0x142, 0xA); SSD_DPPADD(a2_, 0x143, 0xC); \
        cum2n = a2_; cumw[(buf) * 64 + lane] = a2_; const float cT_ = __int_as_float(__builtin_amdgcn_readlane(__float_as_int(a2_), 63)), cs_ = __shfl(a2_, sx & 63), dts_ = __shfl(ndt, sx & 63); \
        const float w2_ = dts_ * __builtin_amdgcn_exp2f(cT_ - cs_); float x8_[8], xd_[8], xs_[8]; unpack8(__builtin_bit_cast(v4u, nx), x8_); \
        _Pragma("unroll") for (int j_ = 0; j_ < 8; ++j_) { xd_[j_] = x8_[j_] * dts_; xs_[j_] = x8_[j_] * w2_; } \
        LAS char* Bk_ = lds + (buf) * IMG; LAS char* Bv_ = lds + (2 + (buf)) * IMG; LAS char* Xv_ = lds + (4 + (buf)) * IMG; LAS char* Ck_ = lds + (6 + (buf)) * IMG; \
        *(LAS bf16x8*)(Bk_ + kst_a) = nb0; *(LAS bf16x8*)(Bk_ + kst_b) = nb1; *(LAS bf16x8*)(Bv_ + vst_a) = nb0; *(LAS bf16x8*)(Bv_ + vst_b) = nb1; \
        *(LAS bf16x8*)(Ck_ + kst_a) = nc0; *(LAS bf16x8*)(Ck_ + kst_b) = nc1; \
        *(LAS v4u*)(Xv_ + xst_d) = pack8(xd_); *(LAS v4u*)(Xv_ + xst_s) = pack8(xs_); } while (0)
    SSD_LOAD(0); SSD_STAGE(0, cum2);
    __syncthreads();
    for (int ci = 0; ci < 68; ++ci) {
        const int cur = ci & 1; const int row0 = SSD_ROW0(ci);
        if (ci + 1 < 68) SSD_LOAD(ci + 1);
        f32x16 o = {}; bf16x8 Cc[8];
        if (ywave) { bf16x8 sf[8]; const LAS char* Ck = lds + (6 + cur) * IMG;
#pragma unroll
            for (int d0 = 0; d0 < 8; ++d0) { sf[d0] = *(const LAS bf16x8*)(Ss + KSWZ128(pb * 32 + r32, (d0 * 16 + hi * 8) * 2)); Cc[d0] = *(const LAS bf16x8*)(Ck + KSWZ128(tb * 32 + r32, (d0 * 16 + hi * 8) * 2)); }
            asm volatile("s_waitcnt lgkmcnt(0)" ::: "memory"); SBAR();
            f32x16 o2 = {};
#pragma unroll
            for (int d0 = 0; d0 < 8; d0 += 2) { o = __builtin_amdgcn_mfma_f32_32x32x16_bf16(Cc[d0], sf[d0], o, 0, 0, 0); o2 = __builtin_amdgcn_mfma_f32_32x32x16_bf16(Cc[d0 + 1], sf[d0 + 1], o2, 0, 0, 0); }
#pragma unroll
            for (int r = 0; r < 16; ++r) o[r] += o2[r]; }
        __syncthreads();
        {
            const float decT = __builtin_amdgcn_exp2f(__int_as_float(__builtin_amdgcn_readlane(__float_as_int(cum2), 63)));
#pragma unroll
            for (int r = 0; r < 16; ++r) sacc[r] *= decT;
            const int vbx = ldsb + (4 + cur) * IMG + rdb + (2 + pb2) * 512, vbb = ldsb + (2 + cur) * IMG + rdb + nb * 512;
            const s16x4 xl0 = trr<0>(vbx), xh0 = trr<2048>(vbx), xl1 = trr<4096>(vbx), xh1 = trr<6144>(vbx), xl2 = trr<8192>(vbx), xh2 = trr<10240>(vbx), xl3 = trr<12288>(vbx), xh3 = trr<14336>(vbx);
            const s16x4 bl0 = trr<0>(vbb), bh0 = trr<2048>(vbb), bl1 = trr<4096>(vbb), bh1 = trr<6144>(vbb), bl2 = trr<8192>(vbb), bh2 = trr<10240>(vbb), bl3 = trr<12288>(vbb), bh3 = trr<14336>(vbb);
            asm volatile("s_waitcnt lgkmcnt(0)" ::: "memory"); SBAR();
            sacc = __builtin_amdgcn_mfma_f32_32x32x16_bf16(SSD_PK(xl0, xh0), SSD_PK(bl0, bh0), sacc, 0, 0, 0);
            sacc = __builtin_amdgcn_mfma_f32_32x32x16_bf16(SSD_PK(xl1, xh1), SSD_PK(bl1, bh1), sacc, 0, 0, 0);
            sacc = __builtin_amdgcn_mfma_f32_32x32x16_bf16(SSD_PK(xl2, xh2), SSD_PK(bl2, bh2), sacc, 0, 0, 0);
            sacc = __builtin_amdgcn_mfma_f32_32x32x16_bf16(SSD_PK(xl3, xh3), SSD_PK(bl3, bh3), sacc, 0, 0, 0);
#pragma unroll
            for (int r = 0; r < 16; ++r) *(LAS bf16*)(Ss + KSWZ128(pb2 * 32 + att::crow(r, hi), (nb * 32 + r32) * 2)) = (bf16)f2bf(sacc[r]);
        }
        if (ywave) {
            const LAS float* cw = cumw + cur * 64; const LAS char* Bk = lds + cur * IMG; const int vby = ldsb + (4 + cur) * IMG + rdb + pb * 512;
#pragma unroll
            for (int r = 0; r < 16; ++r) o[r] *= __builtin_amdgcn_exp2f(cw[tb * 32 + att::crow(r, hi)]);
            const float ct = __shfl(cum2, tb * 32 + r32);
#pragma unroll
            for (int sb = 0; sb < 2; ++sb) {
                if (sb <= tb) {
                    f32x16 p = {};
#pragma unroll
                    for (int d0 = 0; d0 < 8; ++d0) { const bf16x8 kf = *(const LAS bf16x8*)(Bk + KSWZ128(sb * 32 + r32, (d0 * 16 + hi * 8) * 2)); p = __builtin_amdgcn_mfma_f32_32x32x16_bf16(kf, Cc[d0], p, 0, 0, 0); }
#pragma unroll
                    for (int r = 0; r < 16; ++r) { const int sl = att::crow(r, hi); const float w = __builtin_amdgcn_exp2f(ct - cw[sb * 32 + sl]); const float v = p[r] * w; p[r] = (sb == tb && sl > r32) ? 0.f : v; }
                    bf16x8 paA, paB;
#define PK4(P, BASE, OUT) do { unsigned a0 = att::cvtpk(P[BASE + 0], P[BASE + 1]), a1 = att::cvtpk(P[BASE + 2], P[BASE + 3]); \
    unsigned b0 = att::cvtpk(P[BASE + 4], P[BASE + 5]), b1 = att::cvtpk(P[BASE + 6], P[BASE + 7]); \
    auto r0 = __builtin_amdgcn_permlane32_swap(a0, b0, false, false); auto r1 = __builtin_amdgcn_permlane32_swap(a1, b1, false, false); \
    v4u w = {r0[0], r1[0], r0[1], r1[1]}; OUT = __builtin_bit_cast(bf16x8, w); } while (0)
                    PK4(p, 0, paA); PK4(p, 8, paB);
#undef PK4
                    s16x4 l0, h0, l1, h1;
                    if (sb == 0) { l0 = trr<0>(vby); h0 = trr<2048>(vby); l1 = trr<4096>(vby); h1 = trr<6144>(vby); }
                    else { l0 = trr<8192>(vby); h0 = trr<10240>(vby); l1 = trr<12288>(vby); h1 = trr<14336>(vby); }
                    asm volatile("s_waitcnt lgkmcnt(0)" ::: "memory"); SBAR();
                    o = __builtin_amdgcn_mfma_f32_32x32x16_bf16(paA, SSD_PK(l0, h0), o, 0, 0, 0);
                    o = __builtin_amdgcn_mfma_f32_32x32x16_bf16(paB, SSD_PK(l1, h1), o, 0, 0, 0);
                }
            }
            bf16* yp = ssdy + ((size_t)d * M) * 1024 + h * 64 + pb * 32 + r32;
#pragma unroll
            for (int r = 0; r < 16; ++r) { const int t = tb * 32 + att::crow(r, hi); yp[(size_t)SSD_ROW(row0, t) * 1024] = (bf16)f2bf(o[r]); }
        }
        if (ci + 1 < 68) { float c2n; SSD_STAGE(cur ^ 1, c2n); cum2 = c2n; }
        __syncthreads();
    }
#undef SSD_ROW0
#undef SSD_ROW
#undef SSD_LOAD
#undef SSD_STAGE
#undef SSD_DPPADD
}
}
__device__ __forceinline__ void ph_ssd_mfma(ArgsRef a, Ctx C, int l) {
    const bf16* xbc = (const bf16*)(a.ws + T_XBC); const float* dtb = (const float*)(a.ws + T_DT); bf16* ssdy = (bf16*)(a.ws + T_SSDY);
    const bool split = C.G >= 256;
    if (!split || C.vcu < 128)
    for (int it = C.vcu; it < 128; it += C.G) { const int h = it & 15, d = (it >> 4) & 1, b = it >> 5;
        const float Aneg2 = -__expf(a.in[I_SALOG][(l * 2 + d) * 16 + h]) * 1.4426950408889634f;
        ssd::ssd_item(xbc, dtb, ssdy, Aneg2, b, d, h, (LAS char*)C.lds, C.tid);
        __syncthreads(); }
    if (split) { if (C.vcu >= 128) { if (C.wave == 0) for (int it = C.vcu - 128; it < 128; it += C.G - 128) lru_s2_item(a, it, C.lane);
                                     conv_e(a, C, l, (C.vcu - 128) * NWAVES + C.wave, (C.G - 128) * NWAVES); } }
    else { for (int it = C.wave * C.G + C.vcu; it < 128; it += NWAVES * C.G) lru_s2_item(a, it, C.lane); conv_e(a, C, l, C.vcu * NWAVES + C.wave, C.G * NWAVES); }
}
__device__ __forceinline__ void ph_attn(ArgsRef a, Ctx C, int l) {
    const bf16* Qr = (const bf16*)(a.ws + T_QR); const bf16* Kr = (const bf16*)(a.ws + T_KR); const bf16* p = (const bf16*)(a.ws + WS_P); bf16* otmp = (bf16*)(a.ws + T_OTMP);
    unsigned* qhead = (unsigned*)(a.ws + WS_CTL) + CW_ATTQ + 64 * l; LAS unsigned* slot = (LAS unsigned*)(C.lds + RING_BYTES + 2048);
    const int nunits = 1024 + (l == DEPTH - 1 ? 0 : 64);
    for (;;) {
        if (C.tid == 0) *slot = __hip_atomic_fetch_add(qhead, 1u, RLX_AGENT);
        __syncthreads();
        const int u = (int)__builtin_amdgcn_readfirstlane(*slot);
        __syncthreads();
        if (u >= nunits) break;
        int qb, hm, b; bool isctx;
        if (u < 1024) { qb = u & 15; hm = (u >> 4) & 15; b = u >> 8; isctx = false; } else { const int u2 = u - 1024; qb = 0; hm = u2 & 15; b = u2 >> 4; isctx = true; }
        const int qrow0 = b * LT + (isctx ? 0 : LC) + qb * 256, kv0 = b * LT, seq = isctx ? LC : LT, hh = hm >> 1, qcol = hh * 128 + (hm & 1) * 64;
        att::attn_unit(Qr + (size_t)qrow0 * 1024 + qcol, Kr + (size_t)kv0 * 1024 + qcol, p + (size_t)kv0 * NP + P_V + hh * 128, otmp + (size_t)qrow0 * 2048 + hm * 128, seq, (LAS char*)C.lds, C.tid);
    }
}
__device__ __forceinline__ void ph_mixfin(ArgsRef a, Ctx C, int l) {
    const bf16* p = (const bf16*)(a.ws + WS_P); const bf16* xbc = (const bf16*)(a.ws + T_XBC); const bf16* ssdy = (const bf16*)(a.ws + T_SSDY); const bf16* otmp = (const bf16*)(a.ws + T_OTMP);
    bf16* br1 = (bf16*)(a.ws + WS_BR) + (size_t)M * 1024; bf16* br2 = br1 + (size_t)M * 1024;
    const float* sd = a.in[I_SD] + l * 16; const float* snw = a.in[I_SNW] + l * 1024; const float* anw = a.in[I_ANW] + l * 128; const float* lv = a.in[I_ALAM] + l * 256;
    const float lam_init = 0.8f - 0.6f * __expf(-0.3f * (float)l);
    const float lam = __expf(wave_sum(lv[C.lane] * lv[64 + C.lane])) - __expf(wave_sum(lv[128 + C.lane] * lv[192 + C.lane])) + lam_init;
    ROWLOOP {
        if (l == DEPTH - 1 && (r % LT) < LC) continue;
        float v[2][8]; float ss = 0.f;
#pragma unroll
        for (int it = 0; it < 2; ++it) { const int c = it * 512 + C.lane * 8; float x8[8], yf[8], yb[8], z8[8];
            unpack8(*(const v4u*)(xbc + (size_t)r * 2048 + c), x8); unpack8(*(const v4u*)(ssdy + (size_t)r * 1024 + c), yf); unpack8(*(const v4u*)(ssdy + ((size_t)M + r) * 1024 + c), yb);
            unpack8(*(const v4u*)(p + (size_t)r * NP + P_Z + c), z8); const float Dh = sd[c >> 6];
#pragma unroll
            for (int j = 0; j < 8; ++j) { const float y = Dh * x8[j] + yf[j] + yb[j]; const float vv = y * siluf_(z8[j]); v[it][j] = vv; ss += vv * vv; } }
        ss = wave_sum(ss); const float sc = 1.f / sqrtf(ss * (1.f / 1024.f) + LN_EPS);
#pragma unroll
        for (int it = 0; it < 2; ++it) { const int c = it * 512 + C.lane * 8; float o8[8];
#pragma unroll
            for (int j = 0; j < 8; ++j) o8[j] = v[it][j] * sc * snw[c + j];
            *(v4u*)(br1 + (size_t)r * 1024 + c) = pack8(o8); }
        const int hh = C.lane >> 3, d0 = (C.lane & 7) * 16; float od[16]; float s2 = 0.f;
#pragma unroll
        for (int hf = 0; hf < 2; ++hf) { float o0[8], o1[8]; unpack8(*(const v4u*)(otmp + (size_t)r * 2048 + (2 * hh) * 128 + d0 + hf * 8), o0); unpack8(*(const v4u*)(otmp + (size_t)r * 2048 + (2 * hh + 1) * 128 + d0 + hf * 8), o1);
#pragma unroll
            for (int j = 0; j < 8; ++j) { const float o = o0[j] - lam * o1[j]; od[hf * 8 + j] = o; s2 += o * o; } }
        s2 = sum8(s2);
        const float sc2 = (1.f - lam_init) / sqrtf(s2 * (1.f / 128.f) + LN_EPS);
#pragma unroll
        for (int hf = 0; hf < 2; ++hf) { float o8[8];
#pragma unroll
            for (int j = 0; j < 8; ++j) o8[j] = od[hf * 8 + j] * sc2 * anw[d0 + hf * 8 + j];
            *(v4u*)(br2 + (size_t)r * 1024 + hh * 128 + d0 + hf * 8) = pack8(o8); }
    }
}
struct RouteOut { int e0, e1; float w0, w1; };
__device__ __forceinline__ void lnmid_norms(f32x4 (&v)[8], float* xdst, bf16* hrow, const float* lng, const float* lnb, const float* sh, const float* sc, int lane) {
    float s = 0.f, q = 0.f;
#pragma unroll
    for (int jj = 0; jj < 8; ++jj) { s += (v[jj].x + v[jj].y) + (v[jj].z + v[jj].w); q += (v[jj].x * v[jj].x + v[jj].y * v[jj].y) + (v[jj].z * v[jj].z + v[jj].w * v[jj].w); }
    s = wave_sum(s); q = wave_sum(q);
    float mean = s * (1.f / D), rstd = 1.f / sqrtf(fmaxf(q * (1.f / D) - mean * mean, 0.f) + LN_EPS); s = 0.f; q = 0.f;
#pragma unroll
    for (int jj = 0; jj < 8; ++jj) { const int c = lane + 64 * jj; v[jj] = (v[jj] - mean) * rstd * ((const f32x4*)lng)[c] + ((const f32x4*)lnb)[c]; ((f32x4*)xdst)[c] = v[jj];
        s += (v[jj].x + v[jj].y) + (v[jj].z + v[jj].w); q += (v[jj].x * v[jj].x + v[jj].y * v[jj].y) + (v[jj].z * v[jj].z + v[jj].w * v[jj].w); }
    s = wave_sum(s); q = wave_sum(q);
    mean = s * (1.f / D); rstd = 1.f / sqrtf(fmaxf(q * (1.f / D) - mean * mean, 0.f) + LN_EPS);
    unsigned long long* o8 = (unsigned long long*)hrow;
#pragma unroll
    for (int jj = 0; jj < 8; ++jj) { const int c = lane + 64 * jj; v[jj] = (v[jj] - mean) * rstd * (((const f32x4*)sc)[c] + 1.f) + ((const f32x4*)sh)[c];
        o8[c] = (unsigned long long)pk2(v[jj].x, v[jj].y) | ((unsigned long long)pk2(v[jj].z, v[jj].w) << 32); }
}
__device__ __forceinline__ RouteOut route_pick(const float (&lg)[16], const float* rb) {
    float mx = lg[0];
#pragma unroll
    for (int e = 1; e < 16; ++e) mx = fmaxf(mx, lg[e]);
    float sm = 0.f, scs[16], sel[16];
#pragma unroll
    for (int e = 0; e < 16; ++e) { scs[e] = __expf(lg[e] - mx); sm += scs[e]; }
    const float ism = 1.f / sm;
#pragma unroll
    for (int e = 0; e < 16; ++e) { scs[e] *= ism; sel[e] = scs[e] + rb[e]; }
    int gbest = 0, i0b = 0, i1b = 0; float gsb = -1e30f;
#pragma unroll
    for (int g = 0; g < 4; ++g) { float best = sel[4 * g]; int bi = 0;
#pragma unroll
        for (int i = 1; i < 4; ++i) if (sel[4 * g + i] > best) { best = sel[4 * g + i]; bi = i; }
        float sb = -1e30f; int si = 0;
#pragma unroll
        for (int i = 0; i < 4; ++i) if (i != bi && sel[4 * g + i] > sb) { sb = sel[4 * g + i]; si = i; }
        const float gs = best + sb;
        if (gs > gsb) { gsb = gs; gbest = g; i0b = bi; i1b = si; } }
    RouteOut o; o.e0 = gbest * 4 + i0b; o.e1 = gbest * 4 + i1b; float w0 = 0.f, w1 = 0.f;
#pragma unroll
    for (int e = 0; e < 16; ++e) { w0 = (e == o.e0) ? scs[e] : w0; w1 = (e == o.e1) ? scs[e] : w1; }
    const float iw = 1.f / (w0 + w1); o.w0 = w0 * iw; o.w1 = w1 * iw;
    return o;
}
__device__ __forceinline__ void ph_lnmid(ArgsRef a, Ctx C, int l) {
    LAS float* wt = (LAS float*)C.lds;
    LAS unsigned* cnt = (LAS unsigned*)(C.lds + RING_BYTES + 1024); LAS unsigned* base = cnt + 16; LAS unsigned* park = cnt + 64;
    const float* wr = a.in[I_WR];
    for (int i = C.tid; i < D * NE; i += NTHR) wt[(i & 15) * D + (i >> 4)] = wr[i];
    if (C.tid < 16) cnt[C.tid] = 0u;
    __syncthreads();
    const float* y = (const float*)(a.ws + T_MACC); float* xs_ctx = (float*)(a.ws + WS_XSCTX); bf16* h = (bf16*)(a.ws + WS_H);
    const float* mod = (const float*)(a.ws + WS_MOD) + (size_t)l * 5 * NADA; const float* lng = a.in[I_LNG] + (size_t)(l * 2) * D; const float* lnb = a.in[I_LNB] + (size_t)(l * 2) * D;
    const float* rb = a.in[I_RB];
    int* tok_e = (int*)(a.ws + WS_ROUTE); float* tok_w = (float*)(tok_e + 2 * M); int* tok_idx = (int*)(tok_w + 2 * M);
    const int nrows = (l == DEPTH - 1) ? NB * LL : M, rstep = C.G * NWAVES;
#define LNM_ROW(i) ((l == DEPTH - 1) ? ((i) >> 12) * LT + LC + ((i) & 4095) : (i))
#define LNM_COMMIT(r_, o_) do { const unsigned x0 = __hip_atomic_fetch_add(&cnt[(o_).e0], 1u, __ATOMIC_RELAXED, __HIP_MEMORY_SCOPE_WORKGROUP), x1 = __hip_atomic_fetch_add(&cnt[(o_).e1], 1u, __ATOMIC_RELAXED, __HIP_MEMORY_SCOPE_WORKGROUP); \
        tok_e[2 * (r_)] = (o_).e0; tok_e[2 * (r_) + 1] = (o_).e1; tok_w[2 * (r_)] = (o_).w0; tok_w[2 * (r_) + 1] = (o_).w1; \
        LAS unsigned* pk = park + (C.wave * 16 + nrow) * 4; pk[0] = (unsigned)(o_).e0; pk[1] = (unsigned)(o_).e1; pk[2] = x0; pk[3] = x1; ++nrow; } while (0)
    int nrow = 0;
    for (int ri = C.vcu * NWAVES + C.wave; ri < nrows; ri += 2 * rstep) {
        const bool has2 = ri + rstep < nrows; const int r1 = LNM_ROW(ri), r2 = has2 ? LNM_ROW(ri + rstep) : r1;
        const int b1 = r1 / LT, j1 = r1 - b1 * LT, b2 = r2 / LT, j2 = r2 - b2 * LT; const bool c1 = j1 < LC, c2 = j2 < LC;
        f32x4 v1[8], v2[8];
#pragma unroll
        for (int jj = 0; jj < 8; ++jj) { v1[jj] = ((const f32x4*)(y + (size_t)r1 * D))[C.lane + 64 * jj]; v2[jj] = ((const f32x4*)(y + (size_t)r2 * D))[C.lane + 64 * jj]; }
        const float* sh1 = mod + (size_t)(c1 ? 4 : b1) * NADA + 3 * D; const float* sh2 = mod + (size_t)(c2 ? 4 : b2) * NADA + 3 * D;
        lnmid_norms(v1, c1 ? xs_ctx + ((size_t)b1 * LC + j1) * D : a.out + ((size_t)b1 * LL + (j1 - LC)) * D, h + (size_t)r1 * D, lng, lnb, sh1, sh1 + D, C.lane);
        lnmid_norms(v2, c2 ? xs_ctx + ((size_t)b2 * LC + j2) * D : a.out + ((size_t)b2 * LL + (j2 - LC)) * D, h + (size_t)r2 * D, lng, lnb, sh2, sh2 + D, C.lane);
        float lg1[16], lg2[16];
#pragma unroll
        for (int e = 0; e < 16; ++e) { float a1 = 0.f, a2 = 0.f;
#pragma unroll
            for (int jj = 0; jj < 8; ++jj) { const f32x4 w = *(const LAS f32x4*)(wt + e * D + (C.lane + 64 * jj) * 4);
                a1 += (v1[jj].x * w.x + v1[jj].y * w.y) + (v1[jj].z * w.z + v1[jj].w * w.w); a2 += (v2[jj].x * w.x + v2[jj].y * w.y) + (v2[jj].z * w.z + v2[jj].w * w.w); }
            lg1[e] = wave_sum(a1); lg2[e] = wave_sum(a2);
            if (e & 1) asm volatile("" ::: "memory"); }
        const RouteOut o1 = route_pick(lg1, rb), o2 = route_pick(lg2, rb);
        if (C.lane == 0) { LNM_COMMIT(r1, o1); if (has2) LNM_COMMIT(r2, o2); }
    }
    __syncthreads();
    if (C.tid < 16) base[C.tid] = __hip_atomic_fetch_add((unsigned*)(a.ws + WS_CTL) + CW_GCNT + l * 16 + C.tid, cnt[C.tid], RLX_AGENT);
    __syncthreads();
    { int n2 = 0;
      for (int ri = C.vcu * NWAVES + C.wave; ri < nrows; ri += rstep) { const int r = LNM_ROW(ri);
          if (C.lane == 0) { const LAS unsigned* pk = park + (C.wave * 16 + n2) * 4; tok_idx[2 * r] = (int)(pk[2] + base[pk[0] & 15u]); tok_idx[2 * r + 1] = (int)(pk[3] + base[pk[1] & 15u]); }
          ++n2; } }
#undef LNM_ROW
#undef LNM_COMMIT
}
__device__ __forceinline__ void ph_gather(ArgsRef a, Ctx C, int l) {
    LAS int* offs = (LAS int*)(C.lds + RING_BYTES + 1024);
    unsigned* ctl = (unsigned*)(a.ws + WS_CTL);
    LAS int* cnts = offs + 32;
    if (C.tid < 16) cnts[C.tid] = (int)__hip_atomic_load(ctl + CW_GCNT + l * 16 + C.tid, RLX_AGENT);
    __syncthreads();
    if (C.tid == 0) { int o = 0;
        for (int e = 0; e < 16; ++e) { offs[e] = o; o += ((cnts[e] + 127) >> 7) * 128; }
        offs[16] = o; if (blockIdx.x == 0) ctl[CW_NMT + l] = (unsigned)(o >> 7); }
    __syncthreads();
    if (blockIdx.x == 0) { const int nt = offs[16] >> 7;
        for (int t = C.tid; t < nt; t += NTHR) { int e = 0;
#pragma unroll
            for (int k = 1; k < 16; ++k) e += (t * 128 >= offs[k]) ? 1 : 0;
            ctl[CW_TILEE + l * 512 + t] = (unsigned)e; } }
    const int* tok_e = (const int*)(a.ws + WS_ROUTE); const int* tok_idx = tok_e + 4 * M; int* tok_pos = (int*)tok_e + 6 * M;
    const bf16* h = (const bf16*)(a.ws + WS_H); unsigned char* Xg = a.ws + WS_XG;
    const int gw = C.vcu * NWAVES + C.wave, NGW = C.G * NWAVES;
    int mypos = -1;
    { const int r = gw + (C.lane >> 1) * NGW, k = C.lane & 1;
      if (C.lane < 18 && r < M && !(l == DEPTH - 1 && (r % LT) < LC)) { const int e = tok_e[2 * r + k] & 15, idx = tok_idx[2 * r + k]; int pos = offs[e] + idx; pos = pos < 0 ? 0 : (pos >= MOE_ROWS ? MOE_ROWS - 1 : pos);
          tok_pos[2 * r + k] = pos; mypos = pos; } }
    v4u cur[4], nxt[4];
    { const int r0 = gw; if (r0 < M) {
#pragma unroll
        for (int q = 0; q < 4; ++q) nxt[q] = ((const v4u*)(h + (size_t)r0 * D))[C.lane + 64 * q]; } }
#pragma unroll 1
    for (int j = 0; j < 9; ++j) { const int r = gw + j * NGW; if (r >= M) break;
#pragma unroll
        for (int q = 0; q < 4; ++q) cur[q] = nxt[q];
        if (r + NGW < M) {
#pragma unroll
            for (int q = 0; q < 4; ++q) nxt[q] = ((const v4u*)(h + (size_t)(r + NGW) * D))[C.lane + 64 * q]; }
        const int p0 = __shfl(mypos, 2 * j), p1 = __shfl(mypos, 2 * j + 1);
        if (p0 < 0) continue;
        v2u* d0 = (v2u*)(Xg + (size_t)p0 * D); v2u* d1 = (v2u*)(Xg + (size_t)p1 * D);
#pragma unroll
        for (int q = 0; q < 4; ++q) { float x8[8]; unpack8(cur[q], x8); const v2u w = pack8_fp8(x8); d0[C.lane + 64 * q] = w; d1[C.lane + 64 * q] = w; }
    }
    __syncthreads();
}
__device__ __forceinline__ void ph_final(ArgsRef a, Ctx C, int l) {
    const int* tok_pos = (const int*)(a.ws + WS_ROUTE) + 6 * M; const float* tok_w = (const float*)(a.ws + WS_ROUTE) + 2 * M;
    const bf16* fs = (const bf16*)(a.ws + WS_FS); float* xs_ctx = (float*)(a.ws + WS_XSCTX);
    const float* mod = (const float*)(a.ws + WS_MOD) + (size_t)l * 5 * NADA; const float* lng = a.in[I_LNG] + (size_t)(l * 2 + 1) * D; const float* lnb = a.in[I_LNB] + (size_t)(l * 2 + 1) * D;
    const int nrows = (l == DEPTH - 1) ? NB * LL : M, rstep = C.G * NWAVES;
#define FIN_ROW(i) ((l == DEPTH - 1) ? ((i) >> 12) * LT + LC + ((i) & 4095) : (i))
#define FIN_XROW(r_) (((r_) % LT) < LC ? xs_ctx + ((size_t)((r_) / LT) * LC + ((r_) % LT)) * D : a.out + ((size_t)((r_) / LT) * LL + (((r_) % LT) - LC)) * D)
    f32x4 xn[8]; v2u f0n[8], f1n[8]; float w0n = 0.f, w1n = 0.f; int ri = C.vcu * NWAVES + C.wave;
#define FIN_LOAD(i) do { const int r_ = FIN_ROW(i); const float* xr_ = FIN_XROW(r_); const v2u* p0_ = (const v2u*)(fs + (size_t)tok_pos[2 * r_] * D); const v2u* p1_ = (const v2u*)(fs + (size_t)tok_pos[2 * r_ + 1] * D); \
        w0n = tok_w[2 * r_]; w1n = tok_w[2 * r_ + 1]; \
        _Pragma("unroll") for (int jj = 0; jj < 8; ++jj) { const int q = C.lane + 64 * jj; xn[jj] = ((const f32x4*)xr_)[q]; f0n[jj] = p0_[q]; f1n[jj] = p1_[q]; } } while (0)
    if (ri < nrows) FIN_LOAD(ri);
    for (; ri < nrows; ri += rstep) { const int r = FIN_ROW(ri); const int b = r / LT, j = r - b * LT; const bool isctx = j < LC;
        float* xrow = isctx ? xs_ctx + ((size_t)b * LC + j) * D : a.out + ((size_t)b * LL + (j - LC)) * D;
        const float* g2 = mod + (size_t)(isctx ? 4 : b) * NADA + 5 * D;
        f32x4 v[8]; float s = 0.f, s2 = 0.f; const float w0 = w0n, w1 = w1n;
#pragma unroll
        for (int jj = 0; jj < 8; ++jj) { const int q = C.lane + 64 * jj; const v2u a0 = f0n[jj], a1 = f1n[jj];
            const f32x4 f = (f32x4){bflo(a0.x), bfhi(a0.x), bflo(a0.y), bfhi(a0.y)} * w0 + (f32x4){bflo(a1.x), bfhi(a1.x), bflo(a1.y), bfhi(a1.y)} * w1;
            v[jj] = xn[jj] * DN_ALPHA + ((const f32x4*)g2)[q] * f; s += (v[jj].x + v[jj].y) + (v[jj].z + v[jj].w); s2 += (v[jj].x * v[jj].x + v[jj].y * v[jj].y) + (v[jj].z * v[jj].z + v[jj].w * v[jj].w); }
        if (ri + rstep < nrows) FIN_LOAD(ri + rstep);
        const float mean = wave_sum(s) * (1.f / D), rstd = 1.f / sqrtf(fmaxf(wave_sum(s2) * (1.f / D) - mean * mean, 0.f) + LN_EPS);
        float s3 = 0.f, s4 = 0.f;
#pragma unroll
        for (int jj = 0; jj < 8; ++jj) { const int q = C.lane + 64 * jj; v[jj] = (v[jj] - mean) * rstd * ((const f32x4*)lng)[q] + ((const f32x4*)lnb)[q]; ((f32x4*)xrow)[q] = v[jj];
            s3 += (v[jj].x + v[jj].y) + (v[jj].z + v[jj].w); s4 += (v[jj].x * v[jj].x + v[jj].y * v[jj].y) + (v[jj].z * v[jj].z + v[jj].w * v[jj].w); }
        if (l < DEPTH - 1) {
            const float* sh = mod + (size_t)5 * NADA + (size_t)(isctx ? 4 : b) * NADA; const float* sc = sh + D;
            const float mean2 = wave_sum(s3) * (1.f / D), rstd2 = 1.f / sqrtf(fmaxf(wave_sum(s4) * (1.f / D) - mean2 * mean2, 0.f) + LN_EPS);
            unsigned long long* o8 = (unsigned long long*)((bf16*)(a.ws + WS_H) + (size_t)r * D);
#pragma unroll
            for (int jj = 0; jj < 8; ++jj) { const int q = C.lane + 64 * jj; const f32x4 o = (v[jj] - mean2) * rstd2 * (((const f32x4*)sc)[q] + 1.f) + ((const f32x4*)sh)[q];
                o8[q] = (unsigned long long)pk2(o.x, o.y) | ((unsigned long long)pk2(o.z, o.w) << 32); } }
    }
#undef FIN_LOAD
#undef FIN_ROW
#undef FIN_XROW
}

constexpr int NPL = 15, NPH = 2 + DEPTH * NPL;
__global__ void __launch_bounds__(NTHR, 2) fwd(Args args) {
    extern __shared__ __attribute__((aligned(16))) unsigned char lds_raw[];
    Ctx C; C.lds = (LAS unsigned char*)lds_raw; C.tid = threadIdx.x; C.lane = C.tid & 63; C.wave = __builtin_amdgcn_readfirstlane(C.tid >> 6);
    C.G = gridDim.x; { const int bx = blockIdx.x; C.vcu = (C.G % 8 == 0) ? (bx % 8) * (C.G / 8) + bx / 8 : bx; }
    for (int u = C.tid; u < (LDS_BYTES - RING_BYTES) / 4; u += NTHR) ((LAS unsigned*)(C.lds + RING_BYTES))[u] = 0u;
    __syncthreads();
    const __attribute__((address_space(4))) Args* kargs = (const __attribute__((address_space(4))) Args*)__builtin_amdgcn_kernarg_segment_ptr();
    unsigned* ctl0 = (unsigned*)(kargs->ws + WS_CTL);
    XcdBarrier bar; bar.bar = ctl0 + CW_BAR; bar.x = 0; bar.st = nullptr;
    if (MK_N_LAUNCHES == 1) bar = xcd_barrier_post(ctl0 + CW_BAR, (volatile LAS unsigned*)(C.lds + MISC_OFF) + 8);
    const int lo = kargs->ph_lo, hi = kargs->ph_hi;
#ifndef PHMASK
#define PHMASK 0xFFFFFFFFu
#endif
#define EN(k) ((PHMASK >> (k)) & 1u)
#define IN(k) (lo <= (k) && (k) < hi)
#define SEAM(k) do { if (MK_N_LAUNCHES == 1 && IN(k) && IN((k) + 1)) xcd_barrier(bar); } while (0)
    const int cblk = (int)blockIdx.x;
#define PH_CTX Ctx Cq = C; { int t_ = C.tid; asm volatile("" : "+v"(t_)); Cq.tid = t_; Cq.lane = t_ & 63; Cq.wave = __builtin_amdgcn_readfirstlane(t_ >> 6); } \
    const __attribute__((address_space(4))) Args* ap_ = kargs; asm volatile("" : "+s"(ap_)); ArgsRef A = *ap_; unsigned char* ws = A.ws; unsigned* ctl = (unsigned*)(ws + WS_CTL); (void)ctl

    if (EN(0) && IN(0)) { PH_CTX; ph_modp(A, Cq); ph_conva(A, Cq, 0); }
    SEAM(0);
    if (EN(1) && IN(1)) { PH_CTX; ph_modr(A, Cq); }
    SEAM(1);
    { constexpr int l = 0; constexpr int pb = 2 + l * NPL;
        if (l == 0) { if (EN(2) && IN(pb + 0)) { PH_CTX; ph_ln1(A, Cq, l); } SEAM(pb + 0); }
        if (EN(3) && IN(pb + 1)) {
            PH_CTX;
            const pg8::Gemm g{D, D, D}; const SchedIn S{Cq.G, cblk, l == DEPTH - 1, (const char*)(ws + WS_H), (const char*)(ws + WS_WIN)};
            const EpiP E{(bf16*)(ws + WS_P)};
            pg8::gemm_phase<EpiP, SchedIn, true, true>(Cq.lds, Cq.tid, g, S, E); }
        SEAM(pb + 1);
        if (EN(4) && IN(pb + 2)) { PH_CTX; ph_prep(A, Cq, l); }
        SEAM(pb + 2);
        if (EN(5) && IN(pb + 3)) {
            PH_CTX;
            const pg8::Gemm g{256, 1024, 256}; const SchedLru S{Cq.G, cblk, (const char*)(ws + T_XC), (const char*)(ws + WS_WG)};
            const EpiLru E{(const bf16*)(ws + T_XC), A.in[I_LGB] + (size_t)l * 4096, A.in[I_LLAM] + (size_t)l * 2048, (bf16*)(ws + T_LA), (bf16*)(ws + T_BB)};
            pg8::gemm_phase<EpiLru, SchedLru, true, true>(Cq.lds, Cq.tid, g, S, E); }
        SEAM(pb + 3);
        if (EN(6) && IN(pb + 4)) { PH_CTX; ph_lru_s1(A, Cq); }
        SEAM(pb + 4);
        if (EN(7) && IN(pb + 5)) { PH_CTX; ph_ssd_mfma(A, Cq, l); }
        if (EN(8) && IN(pb + 5)) { PH_CTX; __syncthreads(); ph_attn(A, Cq, l); }
        SEAM(pb + 5);
        if (EN(9) && IN(pb + 7)) { PH_CTX; ph_lru_s3(A, Cq, l); ph_mixfin(A, Cq, l); }
        SEAM(pb + 7);
        if (EN(10) && IN(pb + 8)) {
            PH_CTX;
            const pg8::Gemm g{1024, 1024, 1024}; const SchedMerge S{Cq.G, cblk, (const char*)(ws + WS_BR), (const char*)(ws + WS_WBR), l == DEPTH - 1};
            const EpiMerge E{(const bf16*)(ws + WS_P), (bf16*)(ws + T_MB)};
            pg8::gemm_phase<EpiMerge, SchedMerge, true, true>(Cq.lds, Cq.tid, g, S, E); }
        SEAM(pb + 8);
        if (EN(11) && IN(pb + 9)) {
            PH_CTX;
            const pg8::Gemm g{D, D, D}; const SchedPlain S{l == DEPTH - 1 ? 64 : M / 256, D / 256, Cq.G, cblk, (const char*)(ws + T_MB), (const char*)(ws + WS_WOUT), (size_t)256 * D * 2, (size_t)256 * D * 2, l == DEPTH - 1};
            const EpiWout E{l == 0 ? A.in[I_X] : A.out, l == 0 ? A.in[I_CTX] : (const float*)(ws + WS_XSCTX), (const float*)(ws + WS_MOD) + (size_t)l * 5 * NADA + 2 * D, (float*)(ws + T_MACC)};
            pg8::gemm_phase<EpiWout, SchedPlain, true, true>(Cq.lds, Cq.tid, g, S, E); }
        SEAM(pb + 9);
        if (EN(12) && IN(pb + 10)) { PH_CTX; ph_lnmid(A, Cq, l); }
        SEAM(pb + 10);
        if (EN(13) && IN(pb + 11)) { PH_CTX; ph_gather(A, Cq, l); }
        SEAM(pb + 11);
        if (EN(14) && IN(pb + 12)) {
            PH_CTX;
            int nmt = (int)__builtin_amdgcn_readfirstlane(__hip_atomic_load(ctl + CW_NMT + l, RLX_AGENT)); nmt = nmt > MOE_TILES ? MOE_TILES : nmt;
            const pg8::Gemm g{D / 2, D / 2, D / 2}; const SchedMoe S{nmt, 11, Cq.G, cblk, (const char*)(ws + WS_XG), (const char*)(ws + WS_EGU), (size_t)128 * D, (size_t)2816 * D, (size_t)256 * D, ctl + CW_TILEE + l * 512};
            const EpiMoe1 E{ws + WS_ACT};
            pg8::gemm_phase<EpiMoe1, SchedMoe, true, true, true, true>(Cq.lds, Cq.tid, g, S, E); }
        SEAM(pb + 12);
        if (EN(15) && IN(pb + 13)) {
            PH_CTX;
            int nmt = (int)__builtin_amdgcn_readfirstlane(__hip_atomic_load(ctl + CW_NMT + l, RLX_AGENT)); nmt = nmt > MOE_TILES ? MOE_TILES : nmt;
            const pg8::Gemm g{DEP / 2, DEP / 2, DEP / 2}; const SchedMoe S{nmt, 8, Cq.G, cblk, (const char*)(ws + WS_ACT), (const char*)(ws + WS_ED), (size_t)128 * DEP, (size_t)D * DEP, (size_t)256 * DEP, ctl + CW_TILEE + l * 512};
            const EpiMoe2 E{(bf16*)(ws + WS_FS)};
            pg8::gemm_phase<EpiMoe2, SchedMoe, true, true, true, true>(Cq.lds, Cq.tid, g, S, E); }
        SEAM(pb + 13);
        if (EN(16) && IN(pb + 14)) { PH_CTX; ph_final(A, Cq, l); if (l < DEPTH - 1) ph_conva(A, Cq, l + 1); }
        if (l < DEPTH - 1) SEAM(pb + 14);
    }
    { constexpr int l = 1; constexpr int pb = 2 + l * NPL;
        if (l == 0) { if (EN(2) && IN(pb + 0)) { PH_CTX; ph_ln1(A, Cq, l); } SEAM(pb + 0); }
        if (EN(3) && IN(pb + 1)) {
            PH_CTX;
            const pg8::Gemm g{D, D, D}; const SchedIn S{Cq.G, cblk, l == DEPTH - 1, (const char*)(ws + WS_H), (const char*)(ws + WS_WIN)};
            const EpiP E{(bf16*)(ws + WS_P)};
            pg8::gemm_phase<EpiP, SchedIn, true, true>(Cq.lds, Cq.tid, g, S, E); }
        SEAM(pb + 1);
        if (EN(4) && IN(pb + 2)) { PH_CTX; ph_prep(A, Cq, l); }
        SEAM(pb + 2);
        if (EN(5) && IN(pb + 3)) {
            PH_CTX;
            const pg8::Gemm g{256, 1024, 256}; const SchedLru S{Cq.G, cblk, (const char*)(ws + T_XC), (const char*)(ws + WS_WG)};
            const EpiLru E{(const bf16*)(ws + T_XC), A.in[I_LGB] + (size_t)l * 4096, A.in[I_LLAM] + (size_t)l * 2048, (bf16*)(ws + T_LA), (bf16*)(ws + T_BB)};
            pg8::gemm_phase<EpiLru, SchedLru, true, true>(Cq.lds, Cq.tid, g, S, E); }
        SEAM(pb + 3);
        if (EN(6) && IN(pb + 4)) { PH_CTX; ph_lru_s1(A, Cq); }
        SEAM(pb + 4);
        if (EN(7) && IN(pb + 5)) { PH_CTX; ph_ssd_mfma(A, Cq, l); }
        if (EN(8) && IN(pb + 5)) { PH_CTX; __syncthreads(); ph_attn(A, Cq, l); }
        SEAM(pb + 5);
        if (EN(9) && IN(pb + 7)) { PH_CTX; ph_lru_s3(A, Cq, l); ph_mixfin(A, Cq, l); }
        SEAM(pb + 7);
        if (EN(10) && IN(pb + 8)) {
            PH_CTX;
            const pg8::Gemm g{1024, 1024, 1024}; const SchedMerge S{Cq.G, cblk, (const char*)(ws + WS_BR), (const char*)(ws + WS_WBR), l == DEPTH - 1};
            const EpiMerge E{(const bf16*)(ws + WS_P), (bf16*)(ws + T_MB)};
            pg8::gemm_phase<EpiMerge, SchedMerge, true, true>(Cq.lds, Cq.tid, g, S, E); }
        SEAM(pb + 8);
        if (EN(11) && IN(pb + 9)) {
            PH_CTX;
            const pg8::Gemm g{D, D, D}; const SchedPlain S{l == DEPTH - 1 ? 64 : M / 256, D / 256, Cq.G, cblk, (const char*)(ws + T_MB), (const char*)(ws + WS_WOUT), (size_t)256 * D * 2, (size_t)256 * D * 2, l == DEPTH - 1};
            const EpiWout E{l == 0 ? A.in[I_X] : A.out, l == 0 ? A.in[I_CTX] : (const float*)(ws + WS_XSCTX), (const float*)(ws + WS_MOD) + (size_t)l * 5 * NADA + 2 * D, (float*)(ws + T_MACC)};
            pg8::gemm_phase<EpiWout, SchedPlain, true, true>(Cq.lds, Cq.tid, g, S, E); }
        SEAM(pb + 9);
        if (EN(12) && IN(pb + 10)) { PH_CTX; ph_lnmid(A, Cq, l); }
        SEAM(pb + 10);
        if (EN(13) && IN(pb + 11)) { PH_CTX; ph_gather(A, Cq, l); }
        SEAM(pb + 11);
        if (EN(14) && IN(pb + 12)) {
            PH_CTX;
            int nmt = (int)__builtin_amdgcn_readfirstlane(__hip_atomic_load(ctl + CW_NMT + l, RLX_AGENT)); nmt = nmt > MOE_TILES ? MOE_TILES : nmt;
            const pg8::Gemm g{D / 2, D / 2, D / 2}; const SchedMoe S{nmt, 11, Cq.G, cblk, (const char*)(ws + WS_XG), (const char*)(ws + WS_EGU), (size_t)128 * D, (size_t)2816 * D, (size_t)256 * D, ctl + CW_TILEE + l * 512};
            const EpiMoe1 E{ws + WS_ACT};
            pg8::gemm_phase<EpiMoe1, SchedMoe, true, true, true, true>(Cq.lds, Cq.tid, g, S, E); }
        SEAM(pb + 12);
        if (EN(15) && IN(pb + 13)) {
            PH_CTX;
            int nmt = (int)__builtin_amdgcn_readfirstlane(__hip_atomic_load(ctl + CW_NMT + l, RLX_AGENT)); nmt = nmt > MOE_TILES ? MOE_TILES : nmt;
            const pg8::Gemm g{DEP / 2, DEP / 2, DEP / 2}; const SchedMoe S{nmt, 8, Cq.G, cblk, (const char*)(ws + WS_ACT), (const char*)(ws + WS_ED), (size_t)128 * DEP, (size_t)D * DEP, (size_t)256 * DEP, ctl + CW_TILEE + l * 512};
            const EpiMoe2 E{(bf16*)(ws + WS_FS)};
            pg8::gemm_phase<EpiMoe2, SchedMoe, true, true, true, true>(Cq.lds, Cq.tid, g, S, E); }
        SEAM(pb + 13);
        if (EN(16) && IN(pb + 14)) { PH_CTX; ph_final(A, Cq, l); if (l < DEPTH - 1) ph_conva(A, Cq, l + 1); }
        if (l < DEPTH - 1) SEAM(pb + 14);
    }
#undef IN
#undef SEAM
}

extern "C" void kernel_launch(void* const* d_in, const int* in_sizes, int n_in, void* d_out, int out_size, void* d_ws, size_t ws_size, hipStream_t stream) {
    static int grid = 0;
    if (grid == 0) {
        if (n_in != 29 || out_size != NB * LL * D || ws_size < WS_END) { fprintf(stderr, "kernel_launch: unexpected shapes: n_in %d out %d ws %zu (need %zu)\n", n_in, out_size, ws_size, (size_t)WS_END); grid = -1; return; }
        int dev = 0, cus = 0, per_cu = 0;
        if (hipGetDevice(&dev) != hipSuccess || hipDeviceGetAttribute(&cus, hipDeviceAttributeMultiprocessorCount, dev) != hipSuccess) { grid = -1; return; }
        if (hipFuncSetAttribute((const void*)fwd, hipFuncAttributeMaxDynamicSharedMemorySize, LDS_BYTES) != hipSuccess) { fprintf(stderr, "kernel_launch: hipFuncSetAttribute failed\n"); grid = -1; return; }
        if (hipOccupancyMaxActiveBlocksPerMultiprocessor(&per_cu, (const void*)fwd, NTHR, LDS_BYTES) != hipSuccess || per_cu < 1) fprintf(stderr, "kernel_launch: occupancy query says %d\n", per_cu);
        (void)hipGetLastError();
        grid = cus;
    }
    if (grid < 0) return;
    if (hipMemsetAsync((char*)d_ws + WS_CTL, 0, CTL_ZERO_BYTES, stream) != hipSuccess) return;
    Args a{};
    for (int i = 0; i < 29; ++i) a.in[i] = (const float*)d_in[i];
    a.out = (float*)d_out; a.ws = (unsigned char*)d_ws; a.li = 0; a.pad = 0;
    if (MK_N_LAUNCHES == 1) { a.ph_lo = 0; a.ph_hi = NPH; hipLaunchKernelGGL(fwd, dim3(grid), dim3(NTHR), LDS_BYTES, stream, a); }
    else for (int k = 0; k < NPH; ++k) { a.ph_lo = k; a.ph_hi = k + 1; hipLaunchKernelGGL(fwd, dim3(grid), dim3(NTHR), LDS_BYTES, stream, a);
#ifdef REPMASK
        { const int bit = k < 2 ? k : 2 + (k - 2) % NPL; if ((REPMASK >> bit) & 1u) hipLaunchKernelGGL(fwd, dim3(grid), dim3(NTHR), LDS_BYTES, stream, a); }
#endif
    }
    const hipError_t le = hipPeekAtLastError();
    if (le != hipSuccess) fprintf(stderr, "kernel_launch: launch failed: %s\n", hipGetErrorName(le));
}
```
